# Optimizing an MI355X kernel written in HIP

```python
import jax, jax.numpy as jnp
from jax import lax
import numpy as np

D_MODEL = 2048
BATCH = 4
SEQ = 4096
DEPTH = 1

N_MEM = 256
EPS = 1e-6
CHUNK = 64

GLA_HEADS = 4
GLA_DK = 128
GLA_DV = 256
GLA_K = GLA_HEADS * GLA_DK
GLA_V = GLA_HEADS * GLA_DV
GLA_RANK = 16
GLA_TAU = 16.0

MLSTM_HEADS = 4
MLSTM_DH = 256
MLSTM_W = MLSTM_HEADS * MLSTM_DH
CONV_WIDTH = 5

IN_SIZES = (GLA_K, GLA_K, GLA_V, GLA_V, GLA_RANK, GLA_RANK,
            MLSTM_W, MLSTM_W, 4 * MLSTM_HEADS, D_MODEL, D_MODEL)
IN_TOTAL = sum(IN_SIZES)

XATTN_HEADS = 4
XATTN_DH = D_MODEL // XATTN_HEADS

N_GROUPS = 4
EXPERTS_PER_GROUP = 8
N_EXPERTS = N_GROUPS * EXPERTS_PER_GROUP
TOP_K_IN_GROUP = 2
D_EXPERT = 512
MOE_BLOCK = 128

kernel_name = 'hybrid_gla_mlstm_xattn_hmoe_encoder'


def rmsnorm(x, g):
    xf = x.astype(jnp.float32)
    y = xf * lax.rsqrt(jnp.mean(xf * xf, axis=-1, keepdims=True) + EPS)
    return (y * g.astype(jnp.float32)).astype(x.dtype)


def _flip(t):
    return jnp.flip(t, axis=1)


def _chunk(t):
    b, s, h, d = t.shape
    return t.reshape(b, s // CHUNK, CHUNK, h, d).transpose(1, 0, 3, 2, 4)


def _unchunk(t):
    n, b, h, c, d = t.shape
    return t.transpose(1, 0, 3, 2, 4).reshape(b, n * c, h, d)


def _chunk_gate(t):
    b, s, h = t.shape
    return t.reshape(b, s // CHUNK, CHUNK, h).transpose(1, 0, 3, 2)


def gla_scan(q, k, v, log_a):
    bsz, seq, nh, dk = q.shape
    dv = v.shape[-1]
    qc, kc, vc = _chunk(q), _chunk(k), _chunk(v)
    bc = jnp.cumsum(_chunk(log_a), axis=3)
    mask = jnp.tril(jnp.ones((CHUNK, CHUNK), bool))[:, :, None]

    def step(state, xs):
        q_, k_, v_, b_ = xs
        inter = jnp.einsum('bhtd,bhde->bhte', q_ * jnp.exp(b_), state)
        diff = jnp.where(mask, b_[:, :, :, None, :] - b_[:, :, None, :, :], -jnp.inf)
        scores = jnp.einsum('bhtd,bhsd,bhtsd->bhts', q_, k_, jnp.exp(diff))
        intra = jnp.einsum('bhts,bhse->bhte', scores, v_)
        b_last = b_[:, :, -1:, :]
        k_dec = k_ * jnp.exp(b_last - b_)
        new_state = (jnp.exp(b_last[:, :, 0, :, None]) * state
                     + jnp.einsum('bhsd,bhse->bhde', k_dec, v_))
        return new_state, inter + intra

    s0 = jnp.zeros((bsz, nh, dk, dv), jnp.float32)
    _, out = lax.scan(step, s0, (qc, kc, vc, bc))
    return _unchunk(out)


def mlstm_scan(q, k, v, i_pre, f_pre):
    bsz, seq, nh, dh = q.shape
    qc, kc, vc = _chunk(q), _chunk(k), _chunk(v)
    ic = _chunk_gate(i_pre)
    bc = jnp.cumsum(_chunk_gate(jax.nn.log_sigmoid(f_pre)), axis=-1)
    mask = jnp.tril(jnp.ones((CHUNK, CHUNK), bool))

    def step(carry, xs):
        c_st, n_st, m_st = carry
        q_, k_, v_, i_, b_ = xs
        dmat = jnp.where(mask, b_[..., :, None] - b_[..., None, :] + i_[..., None, :], -jnp.inf)
        inter_log = b_ + m_st[..., None]
        m_t = jnp.maximum(inter_log, jnp.max(dmat, axis=-1))
        w_intra = jnp.exp(dmat - m_t[..., None])
        w_inter = jnp.exp(inter_log - m_t)
        s = jnp.einsum('bhtd,bhsd->bhts', q_, k_) * w_intra
        num = (w_inter[..., None] * jnp.einsum('bhtd,bhde->bhte', q_, c_st)
               + jnp.einsum('bhts,bhse->bhte', s, v_))
        den = w_inter * jnp.einsum('bhtd,bhd->bht', q_, n_st) + jnp.sum(s, axis=-1)
        h = num / jnp.maximum(jnp.abs(den), jnp.exp(-m_t))[..., None]
        b_last = b_[..., -1]
        upd_log = b_last[..., None] - b_ + i_
        m_new = jnp.maximum(b_last + m_st, jnp.max(upd_log, axis=-1))
        w_old = jnp.exp(b_last + m_st - m_new)
        kw = k_ * jnp.exp(upd_log - m_new[..., None])[..., None]
        c_new = w_old[..., None, None] * c_st + jnp.einsum('bhsd,bhse->bhde', kw, v_)
        n_new = w_old[..., None] * n_st + jnp.sum(kw, axis=-2)
        return (c_new, n_new, m_new), h

    init = (jnp.zeros((bsz, nh, dh, dh), jnp.float32),
            jnp.zeros((bsz, nh, dh), jnp.float32),
            jnp.zeros((bsz, nh), jnp.float32))
    _, out = lax.scan(step, init, (qc, kc, vc, ic, bc))
    return _unchunk(out)


def hybrid_mixer(xn, w_in, gla_w_lr_f, gla_b_lr_f, gla_w_lr_b, gla_b_lr_b, gla_norm,
                 conv_w, conv_b, m_wq, m_wk, m_wv, m_gate_bias, m_norm,
                 w_branch_a, w_branch_b, w_mix_out):
    bsz, seq, _ = xn.shape
    dt = xn.dtype
    proj = xn @ w_in
    offsets = [int(o) for o in np.cumsum(IN_SIZES)[:-1]]
    (gq, gk, gv, gg, lr_f, lr_b, mx, mz, mgates, gate_a, gate_b) = jnp.split(proj, offsets, axis=-1)

    f32 = jnp.float32
    q = gq.astype(f32).reshape(bsz, seq, GLA_HEADS, GLA_DK) * (GLA_DK ** -0.5)
    k = gk.astype(f32).reshape(bsz, seq, GLA_HEADS, GLA_DK)
    v = gv.astype(f32).reshape(bsz, seq, GLA_HEADS, GLA_DV)
    la_f = (jax.nn.log_sigmoid((lr_f @ gla_w_lr_f + gla_b_lr_f).astype(f32)) / GLA_TAU
            ).reshape(bsz, seq, GLA_HEADS, GLA_DK)
    la_b = (jax.nn.log_sigmoid((lr_b @ gla_w_lr_b + gla_b_lr_b).astype(f32)) / GLA_TAU
            ).reshape(bsz, seq, GLA_HEADS, GLA_DK)
    o_a = gla_scan(q, k, v, la_f) + _flip(gla_scan(_flip(q), _flip(k), _flip(v), _flip(la_b)))
    y_a = rmsnorm(o_a, gla_norm.reshape(GLA_HEADS, GLA_DV)).reshape(bsz, seq, GLA_V)
    y_a = (y_a * jax.nn.silu(gg.astype(f32))).astype(dt)

    xc = lax.conv_general_dilated(mx, conv_w, window_strides=(1,),
                                  padding=[(CONV_WIDTH // 2, CONV_WIDTH // 2)],
                                  dimension_numbers=('NWC', 'WIO', 'NWC'),
                                  feature_group_count=MLSTM_W) + conv_b
    xc = jax.nn.silu(xc.astype(f32)).reshape(bsz, seq, MLSTM_HEADS, MLSTM_DH)
    qm = jnp.einsum('bshd,hde->bshe', xc, m_wq.astype(f32))
    km = jnp.einsum('bshd,hde->bshe', xc, m_wk.astype(f32)) * (MLSTM_DH ** -0.5)
    vm = jnp.einsum('bshd,hde->bshe', mx.astype(f32).reshape(bsz, seq, MLSTM_HEADS, MLSTM_DH),
                    m_wv.astype(f32))
    gates = mgates.astype(f32).reshape(bsz, seq, 4, MLSTM_HEADS) + m_gate_bias.astype(f32)
    h_f = mlstm_scan(qm, km, vm, gates[:, :, 0], gates[:, :, 1])
    h_b = _flip(mlstm_scan(_flip(qm), _flip(km), _flip(vm),
                           _flip(gates[:, :, 2]), _flip(gates[:, :, 3])))
    y_b = rmsnorm(h_f + h_b, m_norm.reshape(MLSTM_HEADS, MLSTM_DH)).reshape(bsz, seq, MLSTM_W)
    y_b = (y_b * jax.nn.sigmoid(mz.astype(f32))).astype(dt)

    merged = (jax.nn.sigmoid(gate_a) * (y_a @ w_branch_a)
              + jax.nn.sigmoid(gate_b) * (y_b @ w_branch_b))
    return merged @ w_mix_out


def cross_attention(xn, mem_n, w_xq, w_xkv, w_xo):
    bsz, seq, _ = xn.shape
    q = (xn @ w_xq).reshape(bsz, seq, XATTN_HEADS, XATTN_DH)
    k, v = jnp.split(mem_n @ w_xkv, 2, axis=-1)
    k = k.reshape(bsz, N_MEM, XATTN_HEADS, XATTN_DH)
    v = v.reshape(bsz, N_MEM, XATTN_HEADS, XATTN_DH)
    scores = jnp.einsum('bshd,bmhd->bhsm', q, k).astype(jnp.float32) * (XATTN_DH ** -0.5)
    probs = jax.nn.softmax(scores, axis=-1).astype(xn.dtype)
    out = jnp.einsum('bhsm,bmhd->bshd', probs, v).reshape(bsz, seq, D_MODEL)
    return out @ w_xo


def hier_moe(xn, w_group, b_group, w_router, b_router, w_gate, w_up, w_down):
    bsz, seq, d = xn.shape
    n_tok = bsz * seq
    xt = xn.reshape(n_tok, d)
    g_prob = jax.nn.softmax((xt @ w_group).astype(jnp.float32) + b_group.astype(jnp.float32), axis=-1)
    g_sel = jnp.argmax(g_prob, axis=-1)
    p_g = jnp.take_along_axis(g_prob, g_sel[:, None], axis=-1)[:, 0]
    e_all = jnp.einsum('td,gde->tge', xt, w_router).astype(jnp.float32) + b_router.astype(jnp.float32)
    e_logits = jnp.take_along_axis(e_all, g_sel[:, None, None], axis=1)[:, 0]
    e_prob = jax.nn.softmax(e_logits, axis=-1)
    top_p, top_i = lax.top_k(e_prob, TOP_K_IN_GROUP)
    weights = p_g[:, None] * top_p / jnp.sum(top_p, axis=-1, keepdims=True)
    expert = g_sel[:, None] * EXPERTS_PER_GROUP + top_i

    n_asg = n_tok * TOP_K_IN_GROUP
    flat_e = expert.reshape(-1)
    flat_w = weights.reshape(-1)
    flat_t = jnp.repeat(jnp.arange(n_tok, dtype=jnp.int32), TOP_K_IN_GROUP)
    order = jnp.argsort(flat_e)
    se = flat_e[order]
    counts = jnp.bincount(flat_e, length=N_EXPERTS)
    padded = ((counts + MOE_BLOCK - 1) // MOE_BLOCK) * MOE_BLOCK
    starts = jnp.cumsum(counts) - counts
    pends = jnp.cumsum(padded)
    pstarts = pends - padded
    dest = pstarts[se] + (jnp.arange(n_asg) - starts[se])
    n_rows = n_asg + N_EXPERTS * MOE_BLOCK
    n_blocks = n_rows // MOE_BLOCK
    row_tok = jnp.full((n_rows,), n_tok, jnp.int32).at[dest].set(flat_t[order])
    row_w = jnp.zeros((n_rows,), jnp.float32).at[dest].set(flat_w[order])
    blk_e = jnp.clip(jnp.searchsorted(pends, jnp.arange(n_blocks) * MOE_BLOCK, side='right'),
                     0, N_EXPERTS - 1)
    x_pad = jnp.concatenate([xt, jnp.zeros((1, d), xt.dtype)], axis=0)
    x_rows = x_pad[row_tok].reshape(n_blocks, MOE_BLOCK, d)

    def expert_block(args):
        xb, e = args
        return (jax.nn.silu(xb @ w_gate[e]) * (xb @ w_up[e])) @ w_down[e]

    y_rows = lax.map(expert_block, (x_rows, blk_e)).reshape(n_rows, d)
    y_rows = (y_rows.astype(jnp.float32) * row_w[:, None]).astype(xt.dtype)
    y = jax.ops.segment_sum(y_rows, row_tok, num_segments=n_tok + 1)[:n_tok]
    return y.reshape(bsz, seq, d)


def setup_inputs(seed: int = 0) -> dict:
    key = jax.random.key(seed)
    ks = jax.random.split(key, 40)
    f32 = jnp.float32
    L = DEPTH

    def nrm(k, shape, scale):
        return jax.random.normal(k, shape, f32) * scale

    def gain(k, shape):
        return 1.0 + 0.02 * jax.random.normal(k, shape, f32)

    fb = jnp.linspace(3.0, 6.0, MLSTM_HEADS, dtype=f32)
    zb = jnp.zeros((MLSTM_HEADS,), f32)
    gate_base = jnp.stack([zb, fb, zb, fb])[None]
    return {
        'x': jax.random.normal(ks[0], (BATCH, SEQ, D_MODEL), f32),
        'mem': jax.random.normal(ks[1], (BATCH, N_MEM, D_MODEL), f32),
        'norm_mix': gain(ks[2], (L, D_MODEL)),
        'w_in': nrm(ks[3], (L, D_MODEL, IN_TOTAL), D_MODEL ** -0.5),
        'gla_w_lr_f': nrm(ks[4], (L, GLA_RANK, GLA_K), GLA_RANK ** -0.5),
        'gla_b_lr_f': nrm(ks[5], (L, GLA_K), 0.1),
        'gla_w_lr_b': nrm(ks[6], (L, GLA_RANK, GLA_K), GLA_RANK ** -0.5),
        'gla_b_lr_b': nrm(ks[7], (L, GLA_K), 0.1),
        'gla_norm': gain(ks[8], (L, GLA_V)),
        'conv_w': nrm(ks[9], (L, CONV_WIDTH, 1, MLSTM_W), CONV_WIDTH ** -0.5),
        'conv_b': nrm(ks[10], (L, MLSTM_W), 0.02),
        'm_wq': nrm(ks[11], (L, MLSTM_HEADS, MLSTM_DH, MLSTM_DH), MLSTM_DH ** -0.5),
        'm_wk': nrm(ks[12], (L, MLSTM_HEADS, MLSTM_DH, MLSTM_DH), MLSTM_DH ** -0.5),
        'm_wv': nrm(ks[13], (L, MLSTM_HEADS, MLSTM_DH, MLSTM_DH), MLSTM_DH ** -0.5),
        'm_gate_bias': gate_base + nrm(ks[14], (L, 4, MLSTM_HEADS), 0.1),
        'm_norm': gain(ks[15], (L, MLSTM_W)),
        'w_branch_a': nrm(ks[16], (L, GLA_V, D_MODEL), GLA_V ** -0.5),
        'w_branch_b': nrm(ks[17], (L, MLSTM_W, D_MODEL), MLSTM_W ** -0.5),
        'w_mix_out': nrm(ks[18], (L, D_MODEL, D_MODEL), D_MODEL ** -0.5),
        'norm_xattn': gain(ks[19], (L, D_MODEL)),
        'norm_mem': gain(ks[20], (L, D_MODEL)),
        'w_xq': nrm(ks[21], (L, D_MODEL, D_MODEL), D_MODEL ** -0.5),
        'w_xkv': nrm(ks[22], (L, D_MODEL, 2 * D_MODEL), D_MODEL ** -0.5),
        'w_xo': nrm(ks[23], (L, D_MODEL, D_MODEL), D_MODEL ** -0.5),
        'norm_ffn': gain(ks[24], (L, D_MODEL)),
        'w_group': nrm(ks[25], (L, D_MODEL, N_GROUPS), D_MODEL ** -0.5),
        'b_group': nrm(ks[26], (L, N_GROUPS), 0.01),
        'w_router': nrm(ks[27], (L, N_GROUPS, D_MODEL, EXPERTS_PER_GROUP), D_MODEL ** -0.5),
        'b_router': nrm(ks[28], (L, N_GROUPS, EXPERTS_PER_GROUP), 0.01),
        'w_gate': nrm(ks[29], (L, N_EXPERTS, D_MODEL, D_EXPERT), D_MODEL ** -0.5),
        'w_up': nrm(ks[30], (L, N_EXPERTS, D_MODEL, D_EXPERT), D_MODEL ** -0.5),
        'w_down': nrm(ks[31], (L, N_EXPERTS, D_EXPERT, D_MODEL), D_EXPERT ** -0.5),
        'norm_final': gain(ks[32], (D_MODEL,)),
    }


def reference(x, mem, norm_mix, w_in, gla_w_lr_f, gla_b_lr_f, gla_w_lr_b, gla_b_lr_b, gla_norm,
              conv_w, conv_b, m_wq, m_wk, m_wv, m_gate_bias, m_norm,
              w_branch_a, w_branch_b, w_mix_out,
              norm_xattn, norm_mem, w_xq, w_xkv, w_xo,
              norm_ffn, w_group, b_group, w_router, b_router, w_gate, w_up, w_down,
              norm_final):
    h = x
    for l in range(DEPTH):
        h = h + hybrid_mixer(rmsnorm(h, norm_mix[l]), w_in[l],
                             gla_w_lr_f[l], gla_b_lr_f[l], gla_w_lr_b[l], gla_b_lr_b[l], gla_norm[l],
                             conv_w[l], conv_b[l], m_wq[l], m_wk[l], m_wv[l], m_gate_bias[l], m_norm[l],
                             w_branch_a[l], w_branch_b[l], w_mix_out[l])
        h = h + cross_attention(rmsnorm(h, norm_xattn[l]), rmsnorm(mem, norm_mem[l]),
                                w_xq[l], w_xkv[l], w_xo[l])
        h = h + hier_moe(rmsnorm(h, norm_ffn[l]), w_group[l], b_group[l], w_router[l], b_router[l],
                         w_gate[l], w_up[l], w_down[l])
    return rmsnorm(h, norm_final)
```

```cpp
#include <hip/hip_runtime.h>
#include <hip/hip_cooperative_groups.h>
namespace cg = cooperative_groups;
#include <cstdint>
#include <cstdio>

#define DI __device__ __forceinline__
typedef unsigned short bf16_t;
typedef short bf16x8 __attribute__((ext_vector_type(8)));
typedef float f32x4 __attribute__((ext_vector_type(4)));
typedef float f32x2 __attribute__((ext_vector_type(2)));
typedef unsigned u32x4 __attribute__((ext_vector_type(4)));
typedef unsigned u32x2 __attribute__((ext_vector_type(2)));

constexpr int DM = 2048, NB = 4, SEQ = 4096, MTOK = NB * SEQ;
constexpr int NMEM = 256;
constexpr int CH = 64, NCH = SEQ / CH;
constexpr int IN_TOTAL = 9264;
constexpr int NEXP = 32, DEXP = 512;
constexpr int NTHR = 512, NWG = 256;
constexpr float EPS = 1e-6f;
constexpr int O_GQ = 0, O_GK = 512, O_GV = 1024, O_GG = 2048, O_LRF = 3072, O_LRB = 3088, O_MX = 3104, O_MZ = 4128, O_MG = 5152, O_GA = 5168, O_GB = 7216;
constexpr int WIN_ROWS = 9472;

constexpr size_t MiB = 1u << 20;
constexpr size_t WS_CTL = 0;
constexpr size_t WS_WA = 1 * MiB;
constexpr size_t WS_WB = 5 * MiB;
constexpr size_t WS_WMIX = 9 * MiB;
constexpr size_t WS_WXQ = 17 * MiB;
constexpr size_t WS_WXKV = 25 * MiB;
constexpr size_t WS_WXO = 41 * MiB;
constexpr size_t WS_WMQK = 49 * MiB;
constexpr size_t WS_WMV = 50 * MiB;
constexpr size_t WS_WR = 51 * MiB;
constexpr size_t WS_SMALL = 52 * MiB;
constexpr size_t WS_MSC = 55 * MiB;
constexpr size_t WS_MCH = 57 * MiB;
constexpr size_t WS_GDEC = 58 * MiB;
constexpr size_t WS_SS1 = 59 * MiB;
constexpr size_t WS_SS2 = 61 * MiB;
constexpr size_t WS_MEMN = 63 * MiB;
constexpr size_t WS_KMEM = 67 * MiB;
constexpr size_t WS_VTMEM = 71 * MiB;
constexpr size_t WS_LOGIT = 75 * MiB;
constexpr size_t WS_ROUTE = 79 * MiB;
constexpr size_t WS_GG = 80 * MiB, WS_MZ = 112 * MiB, WS_GA = 144 * MiB, WS_GB = 208 * MiB;
constexpr size_t WS_QF = 272 * MiB, WS_QB = 288 * MiB, WS_KF = 304 * MiB, WS_KB = 320 * MiB;
constexpr size_t WS_KTF = 336 * MiB, WS_KTB = 352 * MiB, WS_VTG = 368 * MiB;
constexpr size_t WS_QM = 400 * MiB, WS_KM = 432 * MiB, WS_KMT = 464 * MiB, WS_VMT = 496 * MiB;
constexpr size_t WS_GQ = 528 * MiB, WS_GK = 544 * MiB, WS_KTG = 560 * MiB, WS_MX = 576 * MiB, WS_XC = 608 * MiB;
constexpr size_t WS_WIN = 400 * MiB;
constexpr size_t WS_XN = 440 * MiB;
constexpr size_t WS_YA = 272 * MiB, WS_YB = 304 * MiB;
constexpr size_t WS_MERGED = 336 * MiB;
constexpr size_t WS_ATTQ = 80 * MiB;
constexpr size_t WS_H = 80 * MiB;
constexpr size_t WS_SC = 144 * MiB;
constexpr size_t WS_P = 208 * MiB;
constexpr size_t WS_WKT = 400 * MiB;
constexpr size_t WS_VWT = 416 * MiB;
constexpr size_t WS_ATTO = 336 * MiB;
constexpr size_t WS_WGU = 528 * MiB;
constexpr size_t WS_WD = 592 * MiB;
constexpr size_t WS_XROWS = 272 * MiB;
constexpr size_t WS_ETOK = 432 * MiB;
constexpr size_t WS_ERS = 434 * MiB;
constexpr size_t WS_EW = 436 * MiB;
constexpr int ECAP = 16384;
constexpr size_t WS_HID = 440 * MiB;
constexpr size_t WS_YROWS = 272 * MiB;
constexpr size_t WS_PREP = 656 * MiB;
constexpr size_t WS_PRET = 672 * MiB;
constexpr size_t WS_PRES = 674 * MiB;
constexpr size_t WS_WIN8 = 272 * MiB;
constexpr int PX = 2048 + 128;
constexpr int P8 = 2048 + 128;
constexpr size_t WS_XN8 = 304 * MiB;
constexpr int MAXROWS = 40960;
constexpr int RT_TOKE = 0;
constexpr int RT_TOKI = 32768;
constexpr int RT_TOKW = 65536;
constexpr int RT_ROWRS = 98304;
constexpr int RT_ROWW = 98304 + MAXROWS;
constexpr int RT_TOKRS = 98304 + 2 * MAXROWS;
constexpr int CW_CNT = 1024;

struct Params {
    const float* in[33];
    float* out;
    unsigned char* ws;
};

DI float bf2f(bf16_t v) { return __uint_as_float(((unsigned)v) << 16); }
DI bf16_t f2bf(float f) { unsigned u = __float_as_uint(f); return (bf16_t)((u + 0x7fffu + ((u >> 16) & 1u)) >> 16); }
DI unsigned pk2(float lo, float hi) { return (unsigned)f2bf(lo) | ((unsigned)f2bf(hi) << 16); }
DI float frcp(float x) { return __builtin_amdgcn_rcpf(x); }
DI float sigmoidf_(float x) { return frcp(1.f + __expf(-x)); }
DI float siluf_(float x) { return x * frcp(1.f + __expf(-x)); }
DI float logsigmoidf_(float z) { return fminf(z, 0.f) - __logf(1.f + __expf(-fabsf(z))); }
DI float wave_sum(float v) {
#pragma unroll
    for (int o = 1; o < 64; o <<= 1) v += __shfl_xor(v, o);
    return v;
}
#define WSP(T, off) ((T*)(P.ws + (off)))

DI unsigned pk4_f8(float a, float b, float c, float d) { unsigned p = 0; p = __builtin_amdgcn_cvt_pk_fp8_f32(a, b, p, false); p = __builtin_amdgcn_cvt_pk_fp8_f32(c, d, p, true); return p; }
template <int F8 = 0>
DI void tr_item(const float* W, int ldw, int K, int ncols, bf16_t* dst, float* scr, int item, int lane, int dp) {
    const int nblk = (ncols + 31) / 32, kb = item / nblk, nb = item % nblk, k0 = 64 * kb, n0 = 32 * nb;
    const bool nok = (n0 + (lane & 31)) < ncols;
    float tv[32];
#pragma unroll
    for (int i = 0; i < 32; ++i) { const int kk = 2 * i + (lane >> 5); tv[i] = nok ? W[(size_t)(k0 + kk) * ldw + n0 + (lane & 31)] : 0.f; }
#pragma unroll
    for (int i = 0; i < 32; ++i) { const int kk = 2 * i + (lane >> 5); scr[kk * 33 + (lane & 31)] = tv[i]; }
    asm volatile("s_waitcnt lgkmcnt(0)" ::: "memory");
    const int c = lane & 7;
#pragma unroll
    for (int j = 0; j < 4; ++j) { const int n = (lane >> 3) + 8 * j; const float* s = scr + (8 * c) * 33 + n;
        if (F8 > 0) { constexpr float SC = (float)(F8 > 0 ? F8 : 1); u32x2 o; o.x = pk4_f8(s[0] * SC, s[33] * SC, s[66] * SC, s[99] * SC); o.y = pk4_f8(s[132] * SC, s[165] * SC, s[198] * SC, s[231] * SC);
            if (n0 + n < ncols) *(u32x2*)((unsigned char*)dst + (size_t)(n0 + n) * dp + k0 + 8 * c) = o; }
        else { u32x4 o; o.x = pk2(s[0], s[33]); o.y = pk2(s[66], s[99]); o.z = pk2(s[132], s[165]); o.w = pk2(s[198], s[231]);
            if (n0 + n < ncols) *(u32x4*)(dst + (size_t)(n0 + n) * dp + k0 + 8 * c) = o; } }
    asm volatile("s_waitcnt lgkmcnt(0)" ::: "memory");
}
struct SegRun { int gw, ngw, off; float* scr; int lane; };
template <int F8 = 0>
DI void tr_seg(SegRun& R, const float* W, int ldw, int K, int ncols, bf16_t* dst, int dp = 0) {
    const int nitems = (K / 64) * ((ncols + 31) / 32);
    int first = (R.gw - (R.off % R.ngw) + R.ngw) % R.ngw;
    for (int it = first; it < nitems; it += R.ngw) tr_item<F8>(W, ldw, K, ncols, dst, R.scr, it, R.lane, dp ? dp : K);
    R.off += nitems;
}
DI void rms_row_bf16(const float* xrow, const float* g, bf16_t* orow, int lane) {
    f32x4 v[8]; float s = 0.f;
#pragma unroll
    for (int j = 0; j < 8; ++j) { v[j] = *(const f32x4*)(xrow + 256 * j + 4 * lane); s += v[j].x * v[j].x + v[j].y * v[j].y + v[j].z * v[j].z + v[j].w * v[j].w; }
    const float rstd = rsqrtf(wave_sum(s) * (1.f / DM) + EPS);
#pragma unroll
    for (int j = 0; j < 8; ++j) { const f32x4 gg = *(const f32x4*)(g + 256 * j + 4 * lane);
        u32x2 o; o.x = pk2(v[j].x * rstd * gg.x, v[j].y * rstd * gg.y); o.y = pk2(v[j].z * rstd * gg.z, v[j].w * rstd * gg.w);
        *(u32x2*)(orow + 256 * j + 4 * lane) = o; }
}
enum { I_X = 0, I_MEM, I_NMIX, I_WIN, I_LRWF, I_LRBF, I_LRWB, I_LRBB, I_GNORM, I_CONVW, I_CONVB, I_MWQ, I_MWK, I_MWV, I_MGB, I_MNORM, I_WBA, I_WBB, I_WMIX,
       I_NXA, I_NMEM, I_WXQ, I_WXKV, I_WXO, I_NFFN, I_WGRP, I_BGRP, I_WRT, I_BRT, I_WGATE, I_WUP, I_WDOWN, I_NFIN };

DI void p0_prologue(const Params& P, float* lds, int bid, int nb, int part) {
    const int tid = threadIdx.x, lane = tid & 63, wave = tid >> 6;
    SegRun R; R.gw = bid * 8 + wave; R.ngw = nb * 8; R.off = 0; R.scr = lds + wave * (64 * 33); R.lane = lane;
    if (part == 0) {
        bf16_t* win = WSP(bf16_t, WS_WIN); const float* w = P.in[I_WIN];
        tr_seg(R, w + O_GQ, IN_TOTAL, DM, 512, win + (size_t)0 * PX, PX);
        tr_seg(R, w + O_GK, IN_TOTAL, DM, 512, win + (size_t)512 * PX, PX);
        tr_seg(R, w + O_GV, IN_TOTAL, DM, 1024, win + (size_t)1024 * PX, PX);
        tr_seg<64>(R, w + O_GG, IN_TOTAL, DM, 1024, (bf16_t*)(WSP(unsigned char, WS_WIN8) + (size_t)2048 * P8), P8);
        tr_seg(R, w + O_MX, IN_TOTAL, DM, 1024, win + (size_t)3072 * PX, PX);
        tr_seg<64>(R, w + O_MZ, IN_TOTAL, DM, 1024, (bf16_t*)(WSP(unsigned char, WS_WIN8) + (size_t)4096 * P8), P8);
        tr_seg<64>(R, w + O_GA, IN_TOTAL, DM, 2048, (bf16_t*)(WSP(unsigned char, WS_WIN8) + (size_t)5120 * P8), P8);
        tr_seg<64>(R, w + O_GB, IN_TOTAL, DM, 2048, (bf16_t*)(WSP(unsigned char, WS_WIN8) + (size_t)7168 * P8), P8);
        tr_seg(R, w + O_LRF, IN_TOTAL, DM, 16, win + (size_t)9216 * PX, PX);
        tr_seg(R, w + O_LRB, IN_TOTAL, DM, 16, win + (size_t)9232 * PX, PX);
        tr_seg(R, w + O_MG, IN_TOTAL, DM, 16, win + (size_t)9248 * PX, PX);
        tr_seg(R, P.in[I_WXKV], 2 * DM, DM, 2 * DM, WSP(bf16_t, WS_WXKV));
        for (int h = 0; h < 4; ++h) {
            tr_seg(R, P.in[I_MWQ] + (size_t)h * 65536, 256, 256, 256, WSP(bf16_t, WS_WMQK) + (size_t)h * 512 * 256);
            tr_seg(R, P.in[I_MWK] + (size_t)h * 65536, 256, 256, 256, WSP(bf16_t, WS_WMQK) + (size_t)h * 512 * 256 + 256 * 256);
            tr_seg(R, P.in[I_MWV] + (size_t)h * 65536, 256, 256, 256, WSP(bf16_t, WS_WMV) + (size_t)h * 256 * 256);
        }
        {
            const float* g = P.in[I_NMIX]; f32x4 gg[8];
#pragma unroll
            for (int j = 0; j < 8; ++j) gg[j] = *(const f32x4*)(g + 512 * (j >> 1) + 8 * lane + 4 * (j & 1));
            for (int m = R.gw; m < MTOK; m += 2 * R.ngw) {
                const int m1 = m + R.ngw; const bool has1 = m1 < MTOK;
                const float* x0 = P.in[I_X] + (size_t)m * DM; const float* x1 = P.in[I_X] + (size_t)(has1 ? m1 : m) * DM;
                f32x4 v0[8], v1[8]; float s0 = 0.f, s1 = 0.f;
#pragma unroll
                for (int j = 0; j < 8; ++j) { v0[j] = *(const f32x4*)(x0 + 512 * (j >> 1) + 8 * lane + 4 * (j & 1)); v1[j] = *(const f32x4*)(x1 + 512 * (j >> 1) + 8 * lane + 4 * (j & 1)); }
#pragma unroll
                for (int j = 0; j < 8; ++j) { s0 += v0[j].x * v0[j].x + v0[j].y * v0[j].y + v0[j].z * v0[j].z + v0[j].w * v0[j].w; s1 += v1[j].x * v1[j].x + v1[j].y * v1[j].y + v1[j].z * v1[j].z + v1[j].w * v1[j].w; }
                const float r0 = rsqrtf(wave_sum(s0) * (1.f / DM) + EPS), r1 = rsqrtf(wave_sum(s1) * (1.f / DM) + EPS);
                bf16_t* o0 = WSP(bf16_t, WS_XN) + (size_t)m * PX; bf16_t* o1 = WSP(bf16_t, WS_XN) + (size_t)m1 * PX;
#pragma unroll
                for (int j = 0; j < 4; ++j) {
                    const f32x4 a = v0[2 * j] * r0 * gg[2 * j], b = v0[2 * j + 1] * r0 * gg[2 * j + 1];
                    u32x4 o; o.x = pk2(a.x, a.y); o.y = pk2(a.z, a.w); o.z = pk2(b.x, b.y); o.w = pk2(b.z, b.w); *(u32x4*)(o0 + 512 * j + 8 * lane) = o;
                    u32x2 e; e.x = pk4_f8(a.x, a.y, a.z, a.w); e.y = pk4_f8(b.x, b.y, b.z, b.w); *(u32x2*)(WSP(unsigned char, WS_XN8) + (size_t)m * P8 + 512 * j + 8 * lane) = e;
                    if (has1) { const f32x4 c = v1[2 * j] * r1 * gg[2 * j], d = v1[2 * j + 1] * r1 * gg[2 * j + 1];
                        u32x4 q; q.x = pk2(c.x, c.y); q.y = pk2(c.z, c.w); q.z = pk2(d.x, d.y); q.w = pk2(d.z, d.w); *(u32x4*)(o1 + 512 * j + 8 * lane) = q;
                        u32x2 f; f.x = pk4_f8(c.x, c.y, c.z, c.w); f.y = pk4_f8(d.x, d.y, d.z, d.w); *(u32x2*)(WSP(unsigned char, WS_XN8) + (size_t)m1 * P8 + 512 * j + 8 * lane) = f; } }
            }
        }
        for (int m = R.gw; m < NB * NMEM; m += R.ngw) rms_row_bf16(P.in[I_MEM] + (size_t)m * DM, P.in[I_NMEM], WSP(bf16_t, WS_MEMN) + (size_t)m * DM, lane);
    } else if (part == 1) {
        tr_seg(R, P.in[I_WBA], DM, 1024, DM, WSP(bf16_t, WS_WA));
        tr_seg(R, P.in[I_WBB], DM, 1024, DM, WSP(bf16_t, WS_WB));
        tr_seg<64>(R, P.in[I_WMIX], DM, DM, DM, WSP(bf16_t, WS_WMIX), P8);
        { const int gt = bid * NTHR + tid, ngt = nb * NTHR; const float* s = P.in[I_WXQ]; bf16_t* d = WSP(bf16_t, WS_WXQ);
          for (int i = gt; i < DM * DM / 8; i += ngt) { const f32x4 a = *(const f32x4*)(s + (size_t)i * 8), c = *(const f32x4*)(s + (size_t)i * 8 + 4);
              u32x4 o; o.x = pk2(a.x, a.y); o.y = pk2(a.z, a.w); o.z = pk2(c.x, c.y); o.w = pk2(c.z, c.w); *(u32x4*)(d + (size_t)i * 8) = o; } }
        tr_seg(R, P.in[I_WXO], DM, DM, DM, WSP(bf16_t, WS_WXO));
        for (int g = 0; g < 4; ++g) tr_seg(R, P.in[I_WRT] + (size_t)g * DM * 8, 8, DM, 8, WSP(bf16_t, WS_WR) + (size_t)(g * 8) * DM);
        tr_seg(R, P.in[I_WGRP], 4, DM, 4, WSP(bf16_t, WS_WR) + (size_t)32 * DM);
        { const int gt = bid * NTHR + tid, ngt = nb * NTHR; u32x4 z = {0u, 0u, 0u, 0u};
          u32x4* p2 = (u32x4*)(WSP(bf16_t, WS_WR) + (size_t)36 * DM); for (int i = gt; i < 220 * DM / 8; i += ngt) p2[i] = z; }
        for (int e = 0; e < NEXP; ++e) {
            const float* wg = P.in[I_WGATE] + (size_t)e * DM * DEXP; const float* wu = P.in[I_WUP] + (size_t)e * DM * DEXP;
            unsigned char* d = WSP(unsigned char, WS_WGU) + (size_t)e * 1024 * DM;
            for (int pn = 0; pn < 4; ++pn) {
                tr_seg<64>(R, wg + pn * 128, DEXP, DM, 128, (bf16_t*)(d + (size_t)(pn * 256) * DM));
                tr_seg<64>(R, wu + pn * 128, DEXP, DM, 128, (bf16_t*)(d + (size_t)(pn * 256 + 128) * DM));
            }
        }
    } else {
        for (int e = 0; e < NEXP; ++e) tr_seg<32>(R, P.in[I_WDOWN] + (size_t)e * DEXP * DM, DM, DEXP, DM, (bf16_t*)(WSP(unsigned char, WS_WD) + (size_t)e * DM * DEXP));
    }
}

struct Unit { const bf16_t* A; const bf16_t* B; int lda, ldb; int kind, pm, pn, aux; bool keep; int ebase; };
typedef f32x4 Acc[2][2][4][2];
#define ACC_FOREACH(ai, bj, m, n) _Pragma("unroll") for (int ai = 0; ai < 2; ++ai) _Pragma("unroll") for (int bj = 0; bj < 2; ++bj) _Pragma("unroll") for (int m = 0; m < 4; ++m) _Pragma("unroll") for (int n = 0; n < 2; ++n)
#define ACC_ROW(ai, m) ((ai) * 128 + wr * 64 + (m) * 16 + fr)
#define ACC_COL(bj, n) ((bj) * 128 + wc * 32 + (n) * 16 + fq * 4)

constexpr int SG_BK = 32, SG_LD = 40;
template <class Sched, class Epi>
DI void gemm_simple(float* ldsf, int K, const Sched& S, const Epi& E) {
    bf16_t* sA = (bf16_t*)ldsf; bf16_t* sB = sA + 256 * SG_LD;
    const int tid = threadIdx.x, wid = tid >> 6, lane = tid & 63, wr = wid >> 2, wc = wid & 3, fr = lane & 15, fq = lane >> 4;
    Acc acc;
    ACC_FOREACH(ai, bj, m, n) acc[ai][bj][m][n] = (f32x4){0.f, 0.f, 0.f, 0.f};
    Unit u;
    for (int ui = 0; S.next(ui, u); ++ui) {
        for (int k0 = 0; k0 < K; k0 += SG_BK) {
#pragma unroll
            for (int i = 0; i < 2; ++i) { const int p = tid + i * 512, r = p >> 2, c = (p & 3) * 8;
                const u32x4 va = *(const u32x4*)(u.A + (size_t)r * u.lda + k0 + c);
                const u32x4 vb = *(const u32x4*)(u.B + (size_t)r * u.ldb + k0 + c);
                *(u32x4*)(sA + r * SG_LD + c) = va; *(u32x4*)(sB + r * SG_LD + c) = vb; }
            __syncthreads();
            bf16x8 af[2][4], bfr[2][2];
#pragma unroll
            for (int ai = 0; ai < 2; ++ai)
#pragma unroll
                for (int m = 0; m < 4; ++m) af[ai][m] = *(const bf16x8*)(sA + (ai * 128 + wr * 64 + m * 16 + fr) * SG_LD + fq * 8);
#pragma unroll
            for (int bj = 0; bj < 2; ++bj)
#pragma unroll
                for (int n = 0; n < 2; ++n) bfr[bj][n] = *(const bf16x8*)(sB + (bj * 128 + wc * 32 + n * 16 + fr) * SG_LD + fq * 8);
            ACC_FOREACH(ai, bj, m, n) acc[ai][bj][m][n] = __builtin_amdgcn_mfma_f32_16x16x32_bf16(bfr[bj][n], af[ai][m], acc[ai][bj][m][n], 0, 0, 0);
            __syncthreads();
        }
        E(acc, u, wr, wc, fr, fq);
        if (!u.keep) { ACC_FOREACH(ai, bj, m, n) acc[ai][bj][m][n] = (f32x4){0.f, 0.f, 0.f, 0.f}; }
    }
}
#define LAS __attribute__((address_space(3)))
namespace pg8 {
constexpr int BK = 64, HALF = 128, HTB = HALF * BK * 2, STAGE_BYTES = 8 * HTB;
DI int lds_byte(int r, int c) { return (r >> 3) * 1024 + (r & 7) * 128 + ((((c >> 3) ^ (r >> 1)) & 7) << 4) + (c & 7) * 2; }
DI void stage_rc(int b, int& R, int& C) { const int slot = (b & 1023) >> 4; R = (b >> 10) * 8 + (slot >> 3); C = ((slot ^ (R >> 1)) & 7) * 8; }
typedef int v4i_t __attribute__((ext_vector_type(4)));
typedef int v8i_t __attribute__((ext_vector_type(8)));
DI f32x4 mfma_f8(bf16x8 a0, bf16x8 a1, bf16x8 b0, bf16x8 b1, f32x4 c) {
    const v8i_t a = __builtin_shufflevector(__builtin_bit_cast(v4i_t, a0), __builtin_bit_cast(v4i_t, a1), 0, 1, 2, 3, 4, 5, 6, 7);
    const v8i_t b = __builtin_shufflevector(__builtin_bit_cast(v4i_t, b0), __builtin_bit_cast(v4i_t, b1), 0, 1, 2, 3, 4, 5, 6, 7);
    return __builtin_amdgcn_mfma_scale_f32_16x16x128_f8f6f4(a, b, c, 0, 0, 0, 0x7F7F7F7F, 0, 0x7F7F7F7F);
}
template <class Epi, class Sched, bool AFTER = false, bool FP8 = false, bool GATHER = false>
DI void gemm_phase(LAS unsigned char* lds, const int K, const int lda, const int ldb, const Sched& S, const Epi& E) {
    const int tid = threadIdx.x, wid = __builtin_amdgcn_readfirstlane(tid >> 6), lane = tid & 63, wr = wid >> 2, wc = wid & 3, fr = lane & 15, fq = lane >> 4;
    int Kop = K; asm volatile("" : "+s"(Kop));
    constexpr int ESZ = FP8 ? 1 : 2;
    const int nt = Kop / (FP8 ? 2 * BK : BK);
    unsigned voffA[2], voffB[2];
#pragma unroll
    for (int i = 0; i < 2; ++i) { int R, C; stage_rc(tid * 16 + i * 8192, R, C); voffA[i] = (unsigned)(R * lda * ESZ + C * 2); voffB[i] = (unsigned)(R * ldb * ESZ + C * 2); }
    unsigned gAc[2][2], gAn[2][2];
#define PG8_GOFF(dst, U) do { if constexpr (GATHER) { _Pragma("unroll") for (int _h = 0; _h < 2; ++_h) _Pragma("unroll") for (int _i = 0; _i < 2; ++_i) { int R_, C_; stage_rc(tid * 16 + _i * 8192, R_, C_); dst[_h][_i] = S.rowoff(U, R_ + 128 * _h) + (unsigned)(C_ * 2); } } } while (0)
#define PG8_STAGE_A(b, h, abase, nextu) do { if constexpr (GATHER) { unsigned vv_[2]; vv_[0] = (nextu) ? gAn[h][0] : gAc[h][0]; vv_[1] = (nextu) ? gAn[h][1] : gAc[h][1]; PG8_STAGE(PG8_SA(b, h), abase, vv_); } \
        else PG8_STAGE(PG8_SA(b, h), (abase) + ((h) ? hstepA : (size_t)0), voffA); } while (0)
    const size_t kstep = (size_t)(BK * 2);
    const size_t hstepA = (size_t)HALF * lda * ESZ, hstepB = (size_t)HALF * ldb * ESZ;
    const unsigned ldsw = (unsigned)wid * 1024u;
    const int aoff = lds_byte(wr * 64 + fr, fq * 8), boff = lds_byte(wc * 32 + fr, fq * 8), aoff1 = lds_byte(wr * 64 + fr, 32 + fq * 8), boff1 = lds_byte(wc * 32 + fr, 32 + fq * 8);
#define PG8_SA(b, h) (((b) * 2 + (h)) * HTB)
#define PG8_SB(b, h) ((4 + (b) * 2 + (h)) * HTB)
#define PG8_STAGE(bufoff, gbase, voff) do { _Pragma("unroll") for (int _i = 0; _i < 2; ++_i) \
        __builtin_amdgcn_global_load_lds((const unsigned*)((const char*)(gbase) + (voff)[_i]), (LAS unsigned*)(lds + (bufoff) + ldsw + _i * 8192), 16, 0, 0); } while (0)
#define PG8_CAT(p, q) __builtin_shufflevector(__builtin_bit_cast(v4i_t, *(const LAS bf16x8*)(p)), __builtin_bit_cast(v4i_t, *(const LAS bf16x8*)(q)), 0, 1, 2, 3, 4, 5, 6, 7)
#define PG8_LDA(dst, b, h) do { if constexpr (FP8) { _Pragma("unroll") for (int m = 0; m < 4; ++m) dst##8[m] = PG8_CAT(lds + PG8_SA(b, h) + aoff + m * 2048, lds + PG8_SA(b, h) + aoff1 + m * 2048); } \
        else { _Pragma("unroll") for (int m = 0; m < 4; ++m) _Pragma("unroll") for (int k = 0; k < 2; ++k) dst[m][k] = *(const LAS bf16x8*)(lds + PG8_SA(b, h) + (k ? aoff1 : aoff) + m * 2048); } } while (0)
#define PG8_LDB(dst, b, h) do { if constexpr (FP8) { _Pragma("unroll") for (int n = 0; n < 2; ++n) dst##8[n] = PG8_CAT(lds + PG8_SB(b, h) + boff + n * 2048, lds + PG8_SB(b, h) + boff1 + n * 2048); } \
        else { _Pragma("unroll") for (int n = 0; n < 2; ++n) _Pragma("unroll") for (int k = 0; k < 2; ++k) dst[n][k] = *(const LAS bf16x8*)(lds + PG8_SB(b, h) + (k ? boff1 : boff) + n * 2048); } } while (0)
#define PG8_MMA(ai, bj, At, Bt) do { __builtin_amdgcn_s_setprio(1); _Pragma("unroll") for (int m = 0; m < 4; ++m) _Pragma("unroll") for (int n = 0; n < 2; ++n) { \
        if constexpr (FP8) asm volatile("v_mfma_scale_f32_16x16x128_f8f6f4 %0, %1, %2, %0, %3, %3 op_sel_hi:[0,0,0]" : "+v"(acc[ai][bj][m][n]) : "v"(Bt##8[n]), "v"(At##8[m]), "v"(f8scale)); \
        else { _Pragma("unroll") for (int k = 0; k < 2; ++k) acc[ai][bj][m][n] = __builtin_amdgcn_mfma_f32_16x16x32_bf16(Bt[n][k], At[m][k], acc[ai][bj][m][n], 0, 0, 0); } } \
        __builtin_amdgcn_s_setprio(0); } while (0)
#define PG8_WAIT_V(n) asm volatile("s_waitcnt vmcnt(" #n ")" ::: "memory")
#define PG8_WAIT_L(n) asm volatile("s_waitcnt lgkmcnt(" #n ")" ::: "memory")
#define PG8_BAR __builtin_amdgcn_s_barrier()
#define PG8_SCHED __builtin_amdgcn_sched_barrier(0)
    Unit cur, nxt; int ui = 0;
    if (!S.next(0, cur)) return;
    Acc acc;
    ACC_FOREACH(a_, b_, m_, n_) acc[a_][b_][m_][n_] = (f32x4){0.f, 0.f, 0.f, 0.f};
    const unsigned f8scale = 0x7F7F7F7Fu;
    bf16x8 At[FP8 ? 1 : 4][2], B0[FP8 ? 1 : 2][2], B1[FP8 ? 1 : 2][2];
    v8i_t At8[FP8 ? 4 : 1], B08[FP8 ? 2 : 1], B18[FP8 ? 2 : 1];
    const char* cA = (const char*)cur.A; const char* cB = (const char*)cur.B;
    PG8_GOFF(gAc, cur);
    PG8_STAGE(PG8_SB(0, 0), cB, voffB); PG8_STAGE(PG8_SB(0, 1), cB + hstepB, voffB); PG8_STAGE_A(0, 0, cA, false); PG8_STAGE_A(0, 1, cA, false);
    if (wr == 1) PG8_BAR;
    PG8_WAIT_V(2); PG8_BAR;
    PG8_STAGE(PG8_SB(1, 0), cB + kstep, voffB); PG8_STAGE_A(1, 0, cA + kstep, false); PG8_STAGE(PG8_SB(1, 1), cB + hstepB + kstep, voffB);
    PG8_WAIT_V(6); PG8_BAR;
    for (;;) {
        const bool has_next = S.next(ui + 1, nxt);
        const char* nA = has_next ? (const char*)nxt.A : cA; const char* nB = has_next ? (const char*)nxt.B : cB;
        if (has_next) PG8_GOFF(gAn, nxt); else { if constexpr (GATHER) { gAn[0][0] = gAc[0][0]; gAn[0][1] = gAc[0][1]; gAn[1][0] = gAc[1][0]; gAn[1][1] = gAc[1][1]; } }
        for (int t = 0; t < nt; t += 2) {
            const bool last = (t == nt - 2);
            const char* a1 = cA + (size_t)(t + 1) * kstep;
            const char* a2 = last ? nA : cA + (size_t)(t + 2) * kstep; const char* b2 = last ? nB : cB + (size_t)(t + 2) * kstep;
            const char* a3 = a2 + kstep; const char* b3 = b2 + kstep;
            PG8_LDB(B0, 0, 0); PG8_LDB(B1, 0, 1); PG8_SCHED; PG8_LDA(At, 0, 0); PG8_STAGE_A(1, 1, a1, false);
            PG8_WAIT_V(8); PG8_WAIT_L(0); PG8_BAR; PG8_MMA(0, 0, At, B0); PG8_MMA(0, 1, At, B1); PG8_BAR; PG8_SCHED;
            PG8_LDA(At, 0, 1); PG8_STAGE(PG8_SB(0, 0), b2, voffB); PG8_STAGE(PG8_SB(0, 1), b2 + hstepB, voffB); PG8_STAGE_A(0, 0, a2, last);
            PG8_WAIT_V(8); PG8_WAIT_L(0); PG8_BAR; PG8_MMA(1, 0, At, B0); PG8_MMA(1, 1, At, B1); PG8_BAR; PG8_SCHED;
            PG8_LDB(B0, 1, 0); PG8_LDB(B1, 1, 1); PG8_SCHED; PG8_LDA(At, 1, 0); PG8_STAGE_A(0, 1, a2, last);
            PG8_WAIT_V(8); PG8_WAIT_L(0); PG8_BAR; PG8_MMA(0, 0, At, B0); PG8_MMA(0, 1, At, B1); PG8_BAR; PG8_SCHED;
            PG8_LDA(At, 1, 1); PG8_STAGE(PG8_SB(1, 0), b3, voffB); PG8_STAGE(PG8_SB(1, 1), b3 + hstepB, voffB); PG8_STAGE_A(1, 0, a3, last);
            PG8_WAIT_V(8); PG8_WAIT_L(0); PG8_BAR; PG8_MMA(1, 0, At, B0); PG8_MMA(1, 1, At, B1); PG8_BAR; PG8_SCHED;
        }
        if (wr == 0) PG8_BAR;
        if constexpr (FP8) asm volatile("s_nop 15\n\ts_nop 15" ::: "memory");
        if constexpr (!AFTER) E(acc, cur, wr, wc, fr, fq);
        if (!has_next) break;
        if (!cur.keep) { ACC_FOREACH(a_, b_, m_, n_) acc[a_][b_][m_][n_] = (f32x4){0.f, 0.f, 0.f, 0.f}; }
        cur = nxt; cA = nA; cB = nB; ++ui;
        if constexpr (GATHER) { gAc[0][0] = gAn[0][0]; gAc[0][1] = gAn[0][1]; gAc[1][0] = gAn[1][0]; gAc[1][1] = gAn[1][1]; }
        if (wr == 1) PG8_BAR;
    }
    PG8_WAIT_V(0);
    PG8_BAR;
    if constexpr (AFTER) { if constexpr (FP8) asm volatile("s_nop 15\n\ts_nop 15" ::: "memory"); E.fused(acc, cur, wr, wc, fr, fq, lds); }
#undef PG8_SA
#undef PG8_SB
#undef PG8_STAGE
#undef PG8_STAGE_A
#undef PG8_GOFF
#undef PG8_LDA
#undef PG8_CAT
#undef PG8_LDB
#undef PG8_MMA
#undef PG8_WAIT_V
#undef PG8_WAIT_L
#undef PG8_BAR
#undef PG8_SCHED
}
}
#ifndef USE_ENGINE
#define USE_ENGINE 1
#endif
template <class Sched, class Epi>
DI void gemm_run(float* ldsf, int K, int lda, int ldb, const Sched& S, const Epi& E) {
#if USE_ENGINE
    pg8::gemm_phase<Epi, Sched>((LAS unsigned char*)ldsf, K, lda, ldb, S, E);
#else
    gemm_simple(ldsf, K, S, E);
#endif
}
DI void st_bf4(bf16_t* p, f32x4 v) { u32x2 o; o.x = pk2(v.x, v.y); o.y = pk2(v.z, v.w); *(u32x2*)p = o; }
DI void st_f8x8(unsigned char* p, f32x4 a0, f32x4 a1);
#define ACC_COLW(bj) ((bj) * 128 + wc * 32 + (fq & 1) * 16 + (fq >> 1) * 8)
#define ACC_FOREACH3(ai, bj, m) _Pragma("unroll") for (int ai = 0; ai < 2; ++ai) _Pragma("unroll") for (int bj = 0; bj < 2; ++bj) _Pragma("unroll") for (int m = 0; m < 4; ++m)
DI void st_bf8(bf16_t* p, f32x4 a0, f32x4 a1) {
    const unsigned x0 = pk2(a0.x, a0.y), x1 = pk2(a0.z, a0.w), y0 = pk2(a1.x, a1.y), y1 = pk2(a1.z, a1.w);
    const auto r0 = __builtin_amdgcn_permlane16_swap(x0, y0, false, false); const auto r1 = __builtin_amdgcn_permlane16_swap(x1, y1, false, false);
    u32x4 o; o.x = r0[0]; o.y = r1[0]; o.z = r0[1]; o.w = r1[1]; __builtin_nontemporal_store(o, (u32x4*)p);
}
DI void ld_bf8(const bf16_t* p, u32x2& n0, u32x2& n1) {
    const u32x4 L = *(const u32x4*)p; const auto r0 = __builtin_amdgcn_permlane16_swap(L.x, L.z, false, false); const auto r1 = __builtin_amdgcn_permlane16_swap(L.y, L.w, false, false);
    n0.x = r0[0]; n0.y = r1[0]; n1.x = r0[1]; n1.y = r1[1];
}
DI void st_f8x8(unsigned char* p, f32x4 a0, f32x4 a1) {
    const auto r = __builtin_amdgcn_permlane16_swap(pk4_f8(a0.x, a0.y, a0.z, a0.w), pk4_f8(a1.x, a1.y, a1.z, a1.w), false, false);
    u32x2 o; o.x = r[0]; o.y = r[1]; *(u32x2*)p = o;
}

struct SchedP1 {
    const Params* P; int bid, nb;
    DI bool next(int i, Unit& u) const {
        const int L = i * nb + bid; if (L >= 768) return false;
        const bf16_t* xn = (const bf16_t*)(P->ws + WS_XN); const bf16_t* win = (const bf16_t*)(P->ws + WS_WIN);
        u.lda = PX; u.ldb = PX; u.keep = false; u.aux = 0;
        if (L < 512) { int t = L / 64; u.pm = L % 64; u.pn = t < 4 ? t : t + 8; u.kind = 0;
            u.A = xn + (size_t)u.pm * 256 * PX; u.B = win + (size_t)u.pn * 256 * PX; }
        else { const int l = L - 512; u.pn = 4 + l / 64; u.pm = l % 64; u.kind = 1;
            u.A = win + (size_t)u.pn * 256 * PX; u.B = xn + (size_t)u.pm * 256 * PX; }
        return true;
    }
};
struct SchedP1g {
    const Params* P; int bid, nb;
    DI bool next(int i, Unit& u) const {
        const int L = i * nb + bid; if (L >= 1536) return false;
        const int t = L / 64; u.pm = L % 64; u.pn = t < 4 ? 8 + t : 12 + t; u.kind = 0; u.lda = P8; u.ldb = P8; u.keep = false; u.aux = 1;
        u.A = (const bf16_t*)(P->ws + WS_XN8 + (size_t)u.pm * 256 * P8); u.B = (const bf16_t*)(P->ws + WS_WIN8 + (size_t)u.pn * 256 * P8);
        return true;
    }
};
struct SchedKV {
    const Params* P; int l;
    DI bool next(int i, Unit& u) const {
        if (i > 0 || l >= 64) return false;
        u.lda = DM; u.ldb = DM; u.keep = false; u.aux = 0; u.pm = l / 16; u.pn = l % 16;
        const bf16_t* mn = (const bf16_t*)(P->ws + WS_MEMN); const bf16_t* wkv = (const bf16_t*)(P->ws + WS_WXKV);
        u.kind = u.pn < 8 ? 2 : 3; u.A = mn + (size_t)u.pm * 256 * DM; u.B = wkv + (size_t)u.pn * 256 * DM;
        return true;
    }
};
struct EpiP1 {
    const Params* Pp;
    DI void operator()(Acc& acc, const Unit& u, int wr, int wc, int fr, int fq) const {
        const Params& P = *Pp;
        bf16_t* dst; int ld; size_t base;
        if (u.kind == 0) {
            const int pn = u.pn;
            if (pn == 36) {
                float* sm = WSP(float, WS_SMALL);
                ACC_FOREACH(ai, bj, m, n) { const int c = ACC_COL(bj, n); if (c < 48) *(f32x4*)(sm + (size_t)(u.pm * 256 + ACC_ROW(ai, m)) * 48 + c) = acc[ai][bj][m][n]; }
                return;
            }
            if (pn < 2) { dst = WSP(bf16_t, WS_GQ); ld = 512; base = (size_t)pn * 256; }
            else if (pn < 4) { dst = WSP(bf16_t, WS_GK); ld = 512; base = (size_t)(pn - 2) * 256; }
            else if (pn < 12) { dst = WSP(bf16_t, WS_GG); ld = 1024; base = (size_t)(pn - 8) * 256; }
            else if (pn < 16) { dst = WSP(bf16_t, WS_MX); ld = 1024; base = (size_t)(pn - 12) * 256; }
            else if (pn < 20) { dst = WSP(bf16_t, WS_MZ); ld = 1024; base = (size_t)(pn - 16) * 256; }
            else if (pn < 28) { dst = WSP(bf16_t, WS_GA); ld = 2048; base = (size_t)(pn - 20) * 256; }
            else { dst = WSP(bf16_t, WS_GB); ld = 2048; base = (size_t)(pn - 28) * 256; }
            base += (size_t)u.pm * 256 * ld;
        } else if (u.kind == 1) {
            if (u.pn < 4) { dst = WSP(bf16_t, WS_KTG); base = (size_t)(u.pn - 2) * 256 * MTOK; } else { dst = WSP(bf16_t, WS_VTG); base = (size_t)(u.pn - 4) * 256 * MTOK; }
            ld = MTOK; base += (size_t)u.pm * 256;
        } else if (u.kind == 2) { dst = WSP(bf16_t, WS_KMEM); ld = DM; base = (size_t)u.pm * 256 * DM + (size_t)u.pn * 256; }
        else { dst = WSP(bf16_t, WS_VTMEM); ld = DM; base = (size_t)u.pm * 256 * DM + (size_t)(u.pn - 8) * 256; }
        const float sc = u.aux ? (1.f / 64.f) : 1.f;
        ACC_FOREACH3(ai, bj, m) st_bf8(dst + base + (size_t)ACC_ROW(ai, m) * ld + ACC_COLW(bj), acc[ai][bj][m][0] * sc, acc[ai][bj][m][1] * sc);
    }
};

DI float wave_incl_scan_add(float v, int lane) {
#pragma unroll
    for (int o = 1; o < 64; o <<= 1) { const float t = __shfl_up(v, o); if (lane >= o) v += t; }
    return v;
}
DI float wave_incl_scan_max(float v, int lane) {
#pragma unroll
    for (int o = 1; o < 64; o <<= 1) { const float t = __shfl_up(v, o); if (lane >= o) v = fmaxf(v, t); }
    return v;
}
DI void p2_prep(const Params& P, float* lds, int bid, int nb) {
    float* lr = lds + 8 * 64 * 48;
    unsigned char* ktT = (unsigned char*)lds;
    float* wvs = lds + 16384;
    float* part = lds;
    for (int item = bid; item < NB * NCH; item += nb) {
        int tid = threadIdx.x; asm volatile("" : "+v"(tid));
        const int lane = tid & 63, wave = __builtin_amdgcn_readfirstlane(tid >> 6);
        const int b = item / NCH, c = item % NCH; const size_t m0 = (size_t)b * SEQ + (size_t)c * CH;
        __syncthreads();
        {
            const int c16 = lane & 15, kg = lane >> 4;
            const bf16_t* xa = WSP(bf16_t, WS_XN) + (m0 + c16) * PX + wave * 256 + 8 * kg;
            const bf16_t* wb = WSP(bf16_t, WS_WIN) + (size_t)(9216 + c16) * PX + wave * 256 + 8 * kg;
            f32x4 acc[4][3];
#pragma unroll
            for (int mt = 0; mt < 4; ++mt)
#pragma unroll
                for (int nt = 0; nt < 3; ++nt) acc[mt][nt] = (f32x4){0.f, 0.f, 0.f, 0.f};
#pragma unroll 2
            for (int k2 = 0; k2 < 4; ++k2) {
                bf16x8 fa[2][4], fb[2][3];
#pragma unroll
                for (int q = 0; q < 2; ++q) {
#pragma unroll
                    for (int mt = 0; mt < 4; ++mt) fa[q][mt] = *(const bf16x8*)(xa + (size_t)(16 * mt) * PX + (2 * k2 + q) * 32);
#pragma unroll
                    for (int nt = 0; nt < 3; ++nt) fb[q][nt] = *(const bf16x8*)(wb + (size_t)(16 * nt) * PX + (2 * k2 + q) * 32);
                }
#pragma unroll
                for (int q = 0; q < 2; ++q)
#pragma unroll
                    for (int mt = 0; mt < 4; ++mt)
#pragma unroll
                        for (int nt = 0; nt < 3; ++nt) acc[mt][nt] = __builtin_amdgcn_mfma_f32_16x16x32_bf16(fa[q][mt], fb[q][nt], acc[mt][nt], 0, 0, 0);
            }
#pragma unroll
            for (int mt = 0; mt < 4; ++mt)
#pragma unroll
                for (int nt = 0; nt < 3; ++nt)
#pragma unroll
                    for (int i = 0; i < 4; ++i) part[(wave * 64 + 16 * mt + 4 * kg + i) * 48 + 16 * nt + c16] = acc[mt][nt][i];
        }
        f32x4 wpre[4];
#pragma unroll
        for (int i = 0; i < 4; ++i) wpre[i] = ((const f32x4*)P.in[I_LRWF])[tid + 512 * i];
        __syncthreads();
        for (int i = tid; i < 64 * 48; i += NTHR) { float s = 0.f;
#pragma unroll
            for (int w8 = 0; w8 < 8; ++w8) s += part[w8 * 3072 + i];
            lr[i] = s; }
        __syncthreads();
        {
            const float qs = 0.08838834764831845f;
#pragma unroll 1
            for (int dir = 0; dir < 2; ++dir) {
                __syncthreads();
#pragma unroll
                for (int i = 0; i < 4; ++i) ((f32x4*)wvs)[tid + 512 * i] = wpre[i];
                float z[8][8];
                { const float* bsrc = (dir ? P.in[I_LRBB] : P.in[I_LRBF]) + 8 * lane; const f32x4 b0 = *(const f32x4*)bsrc, b1 = *(const f32x4*)(bsrc + 4);
#pragma unroll
                  for (int i = 0; i < 8; ++i) { z[i][0] = b0.x; z[i][1] = b0.y; z[i][2] = b0.z; z[i][3] = b0.w; z[i][4] = b1.x; z[i][5] = b1.y; z[i][6] = b1.z; z[i][7] = b1.w; } }
                __syncthreads();
#pragma unroll 1
                for (int rb = 0; rb < 4; ++rb) {
                    f32x4 l[8];
#pragma unroll
                    for (int i = 0; i < 8; ++i) l[i] = *(const f32x4*)(lr + (8 * wave + i) * 48 + dir * 16 + 4 * rb);
#pragma unroll
                    for (int rr = 0; rr < 4; ++rr) {
                        const f32x4 w0 = *(const f32x4*)(wvs + (4 * rb + rr) * 512 + 8 * lane), w1 = *(const f32x4*)(wvs + (4 * rb + rr) * 512 + 8 * lane + 4);
#pragma unroll
                        for (int i = 0; i < 8; ++i) { const float lv = l[i][rr];
                            z[i][0] += lv * w0.x; z[i][1] += lv * w0.y; z[i][2] += lv * w0.z; z[i][3] += lv * w0.w; z[i][4] += lv * w1.x; z[i][5] += lv * w1.y; z[i][6] += lv * w1.z; z[i][7] += lv * w1.w; }
                    }
                }
                if (dir == 0) {
#pragma unroll
                    for (int i = 0; i < 4; ++i) wpre[i] = ((const f32x4*)P.in[I_LRWB])[tid + 512 * i]; }
                u32x4 qr[8], kr[8];
#pragma unroll
                for (int i = 0; i < 8; ++i) { qr[i] = *(const u32x4*)(WSP(bf16_t, WS_GQ) + (m0 + 8 * wave + i) * 512 + 8 * lane); kr[i] = *(const u32x4*)(WSP(bf16_t, WS_GK) + (m0 + 8 * wave + i) * 512 + 8 * lane); }
                float tot[8];
#pragma unroll
                for (int j = 0; j < 8; ++j) {
#pragma unroll
                    for (int i = 0; i < 8; ++i) z[i][j] = logsigmoidf_(z[i][j]) * (1.f / 16.f);
                    if (dir == 0) {
#pragma unroll
                        for (int i = 1; i < 8; ++i) z[i][j] += z[i - 1][j];
                        tot[j] = z[7][j];
                    } else {
#pragma unroll
                        for (int i = 6; i >= 0; --i) z[i][j] += z[i + 1][j];
                        tot[j] = z[0][j];
                    }
                }
                __syncthreads();
                *(f32x4*)(wvs + wave * 512 + 8 * lane) = (f32x4){tot[0], tot[1], tot[2], tot[3]}; *(f32x4*)(wvs + wave * 512 + 8 * lane + 4) = (f32x4){tot[4], tot[5], tot[6], tot[7]};
                __syncthreads();
                float off[8];
#pragma unroll
                for (int j = 0; j < 8; ++j) off[j] = 0.f;
#pragma unroll
                for (int g = 0; g < 8; ++g) if (dir ? g > wave : g < wave) {
                    const f32x4 t0 = *(const f32x4*)(wvs + g * 512 + 8 * lane), t1 = *(const f32x4*)(wvs + g * 512 + 8 * lane + 4);
                    off[0] += t0.x; off[1] += t0.y; off[2] += t0.z; off[3] += t0.w; off[4] += t1.x; off[5] += t1.y; off[6] += t1.z; off[7] += t1.w; }
                if (wave == (dir ? 0 : 7)) {
                    float* gd = WSP(float, WS_GDEC) + ((size_t)(dir * NB + b) * NCH + c) * 512 + 8 * lane;
                    *(f32x4*)gd = (f32x4){__expf(off[0] + tot[0]), __expf(off[1] + tot[1]), __expf(off[2] + tot[2]), __expf(off[3] + tot[3])};
                    *(f32x4*)(gd + 4) = (f32x4){__expf(off[4] + tot[4]), __expf(off[5] + tot[5]), __expf(off[6] + tot[6]), __expf(off[7] + tot[7])}; }
                bf16_t* qo = (dir ? WSP(bf16_t, WS_QB) : WSP(bf16_t, WS_QF)) + (m0 + 8 * wave) * 512 + 8 * lane; bf16_t* ko = (dir ? WSP(bf16_t, WS_KB) : WSP(bf16_t, WS_KF)) + (m0 + 8 * wave) * 512 + 8 * lane;
#pragma unroll
                for (int i = 0; i < 8; ++i) {
                    float cum[8];
#pragma unroll
                    for (int j = 0; j < 8; ++j) cum[j] = off[j] + z[i][j];
                    const u32x4 q = qr[i], k = kr[i]; u32x4 o;
                    o.x = pk2(bf2f(q.x & 0xffff) * qs * __expf(cum[0]), bf2f(q.x >> 16) * qs * __expf(cum[1])); o.y = pk2(bf2f(q.y & 0xffff) * qs * __expf(cum[2]), bf2f(q.y >> 16) * qs * __expf(cum[3]));
                    o.z = pk2(bf2f(q.z & 0xffff) * qs * __expf(cum[4]), bf2f(q.z >> 16) * qs * __expf(cum[5])); o.w = pk2(bf2f(q.w & 0xffff) * qs * __expf(cum[6]), bf2f(q.w >> 16) * qs * __expf(cum[7]));
                    *(u32x4*)(qo + (size_t)i * 512) = o;
                    z[i][0] = bf2f(k.x & 0xffff) * __expf(-cum[0]); z[i][1] = bf2f(k.x >> 16) * __expf(-cum[1]); z[i][2] = bf2f(k.y & 0xffff) * __expf(-cum[2]); z[i][3] = bf2f(k.y >> 16) * __expf(-cum[3]);
                    z[i][4] = bf2f(k.z & 0xffff) * __expf(-cum[4]); z[i][5] = bf2f(k.z >> 16) * __expf(-cum[5]); z[i][6] = bf2f(k.w & 0xffff) * __expf(-cum[6]); z[i][7] = bf2f(k.w >> 16) * __expf(-cum[7]);
                    o.x = pk2(z[i][0], z[i][1]); o.y = pk2(z[i][2], z[i][3]); o.z = pk2(z[i][4], z[i][5]); o.w = pk2(z[i][6], z[i][7]);
                    *(u32x4*)(ko + (size_t)i * 512) = o;
                }
#pragma unroll
                for (int j = 0; j < 8; ++j) { u32x4 o; o.x = pk2(z[0][j], z[1][j]); o.y = pk2(z[2][j], z[3][j]); o.z = pk2(z[4][j], z[5][j]); o.w = pk2(z[6][j], z[7][j]);
                    *(u32x4*)(ktT + (8 * lane + j) * 128 + ((wave ^ (lane & 7)) << 4)) = o; }
                __syncthreads();
                bf16_t* ktg = (dir ? WSP(bf16_t, WS_KTB) : WSP(bf16_t, WS_KTF)) + m0;
#pragma unroll
                for (int it = 0; it < 8; ++it) { const int idx = it * 512 + tid, d = idx >> 3, s = idx & 7;
                    *(u32x4*)(ktg + (size_t)d * MTOK + 8 * s) = *(const u32x4*)(ktT + d * 128 + ((s ^ ((d >> 3) & 7)) << 4)); }
            }
        }
        {
            const int ch = 8 * (tid & 127), tq = tid >> 7, s0 = c * CH + 16 * tq;
            f32x4 w[5][2];
#pragma unroll
            for (int j = 0; j < 5; ++j) { w[j][0] = *(const f32x4*)(P.in[I_CONVW] + j * 1024 + ch); w[j][1] = *(const f32x4*)(P.in[I_CONVW] + j * 1024 + ch + 4); }
            const f32x4 cb0 = *(const f32x4*)(P.in[I_CONVB] + ch), cb1 = *(const f32x4*)(P.in[I_CONVB] + ch + 4);
            const bf16_t* mx = WSP(bf16_t, WS_MX) + (size_t)b * SEQ * 1024 + ch; bf16_t* xc = WSP(bf16_t, WS_XC) + (m0 + 16 * tq) * 1024 + ch;
            u32x4 xr[20];
#pragma unroll
            for (int r = 0; r < 20; ++r) { const int s = s0 - 2 + r; xr[r] = (u32x4){0u, 0u, 0u, 0u}; if (s >= 0 && s < SEQ) xr[r] = *(const u32x4*)(mx + (size_t)s * 1024); }
#pragma unroll
            for (int i = 0; i < 16; ++i) {
                f32x4 a0 = cb0, a1 = cb1;
#pragma unroll
                for (int k = 0; k < 5; ++k) { const u32x4 x = xr[i + k];
                    a0 += w[k][0] * (f32x4){bf2f(x.x & 0xffff), bf2f(x.x >> 16), bf2f(x.y & 0xffff), bf2f(x.y >> 16)}; a1 += w[k][1] * (f32x4){bf2f(x.z & 0xffff), bf2f(x.z >> 16), bf2f(x.w & 0xffff), bf2f(x.w >> 16)}; }
                u32x4 o; o.x = pk2(siluf_(a0.x), siluf_(a0.y)); o.y = pk2(siluf_(a0.z), siluf_(a0.w)); o.z = pk2(siluf_(a1.x), siluf_(a1.y)); o.w = pk2(siluf_(a1.z), siluf_(a1.w));
                *(u32x4*)(xc + (size_t)i * 1024) = o;
            }
        }
        {
            const int dir = wave >> 2, h = wave & 3;
            const float ipre = lr[lane * 48 + 32 + (dir * 2 + 0) * 4 + h] + P.in[I_MGB][(dir * 2 + 0) * 4 + h];
            const float fpre = lr[lane * 48 + 32 + (dir * 2 + 1) * 4 + h] + P.in[I_MGB][(dir * 2 + 1) * 4 + h];
            const float lf = logsigmoidf_(fpre);
            const float pre = wave_incl_scan_add(lf, lane); const float tot = __shfl(pre, 63);
            float Bv, Av, CMv;
            if (dir == 0) { Bv = pre; Av = ipre - Bv; CMv = wave_incl_scan_max(Av, lane); }
            else { Bv = tot - pre + lf; Av = ipre - Bv;
                const float ar = __shfl(Av, 63 - lane); const float pm = wave_incl_scan_max(ar, lane); CMv = __shfl(pm, 63 - lane); }
            float* msc = WSP(float, WS_MSC);
            const size_t o = ((size_t)(dir * 4 + h)) * MTOK + m0 + lane;
            msc[o] = Bv; msc[(size_t)8 * MTOK + o] = Av; msc[(size_t)16 * MTOK + o] = CMv;
            const float cmlast = dir == 0 ? __shfl(CMv, 63) : __shfl(CMv, 0);
            if (lane == 0) { float* mch = WSP(float, WS_MCH); const int ci = ((dir * 4 + b) * 4 + h) * 64 + c; mch[ci] = tot; mch[2048 + ci] = cmlast; }
        }
    }
}

struct SchedP3 {
    const Params* P; int bid, nb, part;
    DI bool next(int i, Unit& u) const {
        const int L = i * nb + bid; if (L >= 512) return false;
        const int which = part * 2 + (L >> 8), l = L & 255; u.pm = l >> 2; u.pn = l & 3; u.kind = which; u.keep = false; u.aux = 0;
        const bf16_t* xc = (const bf16_t*)(P->ws + WS_XC) + (size_t)u.pm * 256 * 1024 + u.pn * 256;
        const bf16_t* mx = (const bf16_t*)(P->ws + WS_MX) + (size_t)u.pm * 256 * 1024 + u.pn * 256;
        const bf16_t* wqk = (const bf16_t*)(P->ws + WS_WMQK) + (size_t)u.pn * 512 * 256; const bf16_t* wv = (const bf16_t*)(P->ws + WS_WMV) + (size_t)u.pn * 256 * 256;
        if (which == 0) { u.A = xc; u.lda = 1024; u.B = wqk; u.ldb = 256; }
        else if (which == 1) { u.A = xc; u.lda = 1024; u.B = wqk + 256 * 256; u.ldb = 256; }
        else if (which == 2) { u.A = wqk + 256 * 256; u.lda = 256; u.B = xc; u.ldb = 1024; }
        else { u.A = wv; u.lda = 256; u.B = mx; u.ldb = 1024; }
        return true;
    }
};
template <int PART> struct EpiP3 {
    const Params* Pp;
    DI void operator()(Acc& acc, const Unit& u, int wr, int wc, int fr, int fq) const {
        const Params& P = *Pp;
        if (PART == 0) {
            bf16_t* dst = (u.kind == 0 ? WSP(bf16_t, WS_QM) : WSP(bf16_t, WS_KM)) + (size_t)u.pm * 256 * 1024 + u.pn * 256; const float sc = u.kind == 0 ? 1.f : 0.0625f;
            ACC_FOREACH3(ai, bj, m) st_bf8(dst + (size_t)ACC_ROW(ai, m) * 1024 + ACC_COLW(bj), acc[ai][bj][m][0] * sc, acc[ai][bj][m][1] * sc);
        } else {
            bf16_t* dst = (u.kind == 2 ? WSP(bf16_t, WS_KMT) : WSP(bf16_t, WS_VMT)) + (size_t)u.pn * 256 * MTOK + (size_t)u.pm * 256; const float sc = u.kind == 2 ? 0.0625f : 1.f;
            ACC_FOREACH3(ai, bj, m) st_bf8(dst + (size_t)ACC_ROW(ai, m) * MTOK + ACC_COLW(bj), acc[ai][bj][m][0] * sc, acc[ai][bj][m][1] * sc);
        }
    }
};

DI bf16_t* obuf(const Params& P, int which) { return (bf16_t*)P.out + (size_t)which * MTOK * 1024; }
DI void naive_gla(const Params& P, float* lds, int item) {
    float* sa = lds; float* sq = lds + 128; float* sk = lds + 256; float* part = lds + 384;
    const int dir = item & 1, h = (item >> 1) & 3, b = item >> 3, tid = threadIdx.x, e = tid & 255, half = tid >> 8;
    float S[64];
#pragma unroll
    for (int d = 0; d < 64; ++d) S[d] = 0.f;
    const float* small = WSP(float, WS_SMALL);
    const float* wl = dir ? P.in[I_LRWB] : P.in[I_LRWF]; const float* bl = dir ? P.in[I_LRBB] : P.in[I_LRBF];
    const bf16_t* gq = WSP(bf16_t, WS_GQ); const bf16_t* gk = WSP(bf16_t, WS_GK); const bf16_t* vt = WSP(bf16_t, WS_VTG);
    bf16_t* o = obuf(P, dir);
    for (int step = 0; step < SEQ; ++step) {
        const int s = dir ? SEQ - 1 - step : step; const size_t m = (size_t)b * SEQ + s;
        __syncthreads();
        if (tid < 128) { const int d = h * 128 + tid; float z = bl[d];
            for (int r = 0; r < 16; ++r) z += small[m * 48 + dir * 16 + r] * wl[r * 512 + d];
            sa[tid] = __expf(logsigmoidf_(z) * (1.f / 16.f)); sq[tid] = bf2f(gq[m * 512 + d]) * 0.08838834764831845f; sk[tid] = bf2f(gk[m * 512 + d]); }
        __syncthreads();
        const float v = bf2f(vt[(size_t)(h * 256 + e) * MTOK + m]);
        float acc = 0.f;
#pragma unroll
        for (int d = 0; d < 64; ++d) { S[d] = sa[half * 64 + d] * S[d] + sk[half * 64 + d] * v; acc += sq[half * 64 + d] * S[d]; }
        part[tid] = acc;
        __syncthreads();
        if (tid < 256) o[m * 1024 + h * 256 + tid] = f2bf(part[tid] + part[tid + 256]);
    }
}
DI void naive_mlstm(const Params& P, float* lds, int item) {
    float* sq = lds; float* sk = lds + 256; float* sn = lds + 512; float* part = lds + 768; float* sden = lds + 1280;
    const int dir = item & 1, h = (item >> 1) & 3, b = item >> 3, tid = threadIdx.x, e = tid & 255, half = tid >> 8;
    float C[128];
#pragma unroll
    for (int d = 0; d < 128; ++d) C[d] = 0.f;
    if (tid < 256) sn[tid] = 0.f;
    const float* small = WSP(float, WS_SMALL);
    const bf16_t* qm = WSP(bf16_t, WS_QM); const bf16_t* km = WSP(bf16_t, WS_KM); const bf16_t* vt = WSP(bf16_t, WS_VMT);
    bf16_t* o = obuf(P, 2 + dir);
    const float bi = P.in[I_MGB][(dir * 2 + 0) * 4 + h], bfz = P.in[I_MGB][(dir * 2 + 1) * 4 + h];
    for (int step = 0; step < SEQ; ++step) {
        const int s = dir ? SEQ - 1 - step : step; const size_t m = (size_t)b * SEQ + s;
        const float ig = __expf(small[m * 48 + 32 + (dir * 2 + 0) * 4 + h] + bi);
        const float fg = sigmoidf_(small[m * 48 + 32 + (dir * 2 + 1) * 4 + h] + bfz);
        __syncthreads();
        if (tid < 256) { sq[tid] = bf2f(qm[m * 1024 + h * 256 + tid]); const float k = bf2f(km[m * 1024 + h * 256 + tid]); sk[tid] = k; sn[tid] = fg * sn[tid] + ig * k; }
        __syncthreads();
        const float v = bf2f(vt[(size_t)(h * 256 + e) * MTOK + m]) * ig;
        float acc = 0.f;
#pragma unroll
        for (int d = 0; d < 128; ++d) { C[d] = fg * C[d] + sk[half * 128 + d] * v; acc += sq[half * 128 + d] * C[d]; }
        part[tid] = acc;
        if (tid < 64) { float dsum = 0.f; for (int d = tid; d < 256; d += 64) dsum += sq[d] * sn[d]; dsum = wave_sum(dsum); if (tid == 0) sden[0] = dsum; }
        __syncthreads();
        if (tid < 256) { const float num = part[tid] + part[tid + 256]; o[m * 1024 + h * 256 + tid] = f2bf(num / fmaxf(fabsf(sden[0]), 1.f)); }
    }
}
typedef float f32x16 __attribute__((ext_vector_type(16)));
typedef __bf16 bf16x2_t __attribute__((ext_vector_type(2)));
DI unsigned cvtpk(float lo, float hi) { f32x2 v = {lo, hi}; bf16x2_t b = __builtin_convertvector(v, bf16x2_t); return __builtin_bit_cast(unsigned, b); }
DI f32x16 mfma32(bf16x8 a, bf16x8 b, f32x16 c) { return __builtin_amdgcn_mfma_f32_32x32x16_bf16(a, b, c, 0, 0, 0); }
DI int crow(int reg, int hh) { return (reg & 3) + 8 * (reg >> 2) + 4 * hh; }
DI bf16x8 pack8(const f32x16& x, int s) { u32x4 p; p.x = cvtpk(x[8 * s], x[8 * s + 1]); p.y = cvtpk(x[8 * s + 2], x[8 * s + 3]); p.z = cvtpk(x[8 * s + 4], x[8 * s + 5]); p.w = cvtpk(x[8 * s + 6], x[8 * s + 7]); return __builtin_bit_cast(bf16x8, p); }
#define LRD(T, base, off) (*(const LAS T*)((base) + (off)))
#define LWR(T, base, off) (*(LAS T*)((base) + (off)))
template <int DK, bool ML>
DI void scan_fast(const Params& P, float* ldsf, int item) {
    constexpr int NDT = DK / 32, QLD = DK + 8, TLD = 72, FT = ML ? 1024 : 512;
    constexpr int QB_ = QLD * 2, TB_ = TLD * 2;
    LAS unsigned char* L0 = (LAS unsigned char*)ldsf;
    LAS unsigned char* Qs = L0; LAS unsigned char* Ks = Qs + 64 * QB_; LAS unsigned char* KTs = Ks + 64 * QB_; LAS unsigned char* Ps = KTs + DK * TB_;
    LAS unsigned char* tab = Ps + 64 * TB_;
    constexpr int T_A = 0, T_CM = 256, T_B = 512, T_W = 768, T_WI = 1024, T_FL = 1280, T_D1 = 1536, T_DS = 1792, T_G = 2304, T_N = 2816;
    const int dir = item & 1, h = (item >> 1) & 3, b = item >> 3;
    const bf16_t* qg = (ML ? WSP(bf16_t, WS_QM) : (dir ? WSP(bf16_t, WS_QB) : WSP(bf16_t, WS_QF))) + h * DK;
    const bf16_t* kg = (ML ? WSP(bf16_t, WS_KM) : (dir ? WSP(bf16_t, WS_KB) : WSP(bf16_t, WS_KF))) + h * DK;
    const bf16_t* ktg = (ML ? WSP(bf16_t, WS_KMT) : (dir ? WSP(bf16_t, WS_KTB) : WSP(bf16_t, WS_KTF))) + (size_t)h * DK * MTOK;
    const bf16_t* vtg0 = (ML ? WSP(bf16_t, WS_VMT) : WSP(bf16_t, WS_VTG)) + (size_t)(h * 256) * MTOK;
    bf16_t* og0 = obuf(P, (ML ? 2 : 0) + dir) + h * 256;
    const float* msc = WSP(float, WS_MSC) + (size_t)(dir * 4 + h) * MTOK; const float* mch = WSP(float, WS_MCH) + ((dir * 4 + b) * 4 + h) * 64;
    f32x16 S[NDT];
#pragma unroll
    for (int dt = 0; dt < NDT; ++dt)
#pragma unroll
        for (int i = 0; i < 16; ++i) S[dt][i] = 0.f;
    if (ML && threadIdx.x < 256) LWR(float, tab, T_N + threadIdx.x * 4) = 0.f;
    float m_prev = 0.f;
    for (int ci = 0; ci < NCH; ++ci) {
        const int c = dir ? NCH - 1 - ci : ci; const size_t m0 = (size_t)b * SEQ + (size_t)c * CH;
        int tid = threadIdx.x; asm volatile("" : "+v"(tid));
        const int lane = tid & 63, w = __builtin_amdgcn_readfirstlane(tid >> 6), r = lane & 31, hh = lane >> 5;
        const bf16_t* vtg = vtg0 + (size_t)(32 * w + r) * MTOK + 8 * hh;
        bf16_t* og = og0 + 32 * w + r;
        LAS unsigned char* qfrag = Qs + r * QB_ + hh * 8;
        LAS unsigned char* pfrag = Ps + r * TB_ + hh * 16;
        LAS unsigned char* ktfrag = KTs + r * TB_ + hh * 16;
        LAS unsigned char* tabh = tab + hh * 16;
        __syncthreads();
        for (int p = tid; p < 64 * DK / 8; p += NTHR) { const int row = p / (DK / 8), c8 = p % (DK / 8);
            LWR(u32x4, Qs, row * QB_ + c8 * 16) = *(const u32x4*)(qg + (m0 + row) * FT + c8 * 8);
            LWR(u32x4, Ks, row * QB_ + c8 * 16) = *(const u32x4*)(kg + (m0 + row) * FT + c8 * 8); }
        for (int p = tid; p < DK * 8; p += NTHR) { const int d = p >> 3, c8 = p & 7; LWR(u32x4, KTs, d * TB_ + c8 * 16) = *(const u32x4*)(ktg + (size_t)d * MTOK + m0 + c8 * 8); }
        bf16x8 Bv[4];
#pragma unroll
        for (int ks = 0; ks < 4; ++ks) Bv[ks] = *(const bf16x8*)(vtg + m0 + 16 * ks);
        float Mx = 0.f, w_old = 1.f, Btot = 0.f;
        if (ML) {
            if (tid < 64) { LWR(float, tab, T_B + tid * 4) = msc[m0 + tid]; LWR(float, tab, T_A + tid * 4) = msc[(size_t)8 * MTOK + m0 + tid]; LWR(float, tab, T_CM + tid * 4) = msc[(size_t)16 * MTOK + m0 + tid]; }
            Btot = mch[c]; const float cml = mch[2048 + c]; Mx = fmaxf(m_prev, cml); w_old = __expf(m_prev - Mx);
        } else {
            if (tid < 128) LWR(float, tab, T_G + tid * 4) = WSP(float, WS_GDEC)[((size_t)(dir * NB + b) * NCH + c) * 512 + h * 128 + tid];
        }
        __syncthreads();
        if (w < 4) {
            const int si = w >> 1, ti = w & 1;
            LAS unsigned char* ka = Ks + (32 * si + r) * QB_ + hh * 16; LAS unsigned char* qa = Qs + (32 * ti + r) * QB_ + hh * 16;
            f32x16 X;
#pragma unroll
            for (int i = 0; i < 16; ++i) X[i] = 0.f;
#pragma unroll
            for (int ks = 0; ks < DK / 16; ++ks) { X = mfma32(LRD(bf16x8, ka, ks * 32), LRD(bf16x8, qa, ks * 32), X); if (ML && (ks & 3) == 3) __builtin_amdgcn_sched_barrier(0); }
            const int t = 32 * ti + r;
            float cmt = 0.f; if (ML) cmt = fmaxf(m_prev, LRD(float, tab, T_CM + t * 4));
            float rs = 0.f;
            LAS unsigned char* prow = Ps + t * TB_ + (32 * si + 4 * hh) * 2;
            LAS unsigned char* arow = tab + T_A + (32 * si + 4 * hh) * 4;
#pragma unroll
            for (int g = 0; g < 4; ++g) {
                float v[4]; f32x4 av = {0.f, 0.f, 0.f, 0.f}; if (ML) av = LRD(f32x4, arow, g * 32);
#pragma unroll
                for (int i = 0; i < 4; ++i) { const int s = 32 * si + 8 * g + 4 * hh + i; const bool keep = dir ? (s >= t) : (s <= t);
                    float x = X[4 * g + i]; if (ML) x *= __expf(av[i] - cmt); v[i] = keep ? x : 0.f; rs += v[i]; }
                u32x2 pk; pk.x = cvtpk(v[0], v[1]); pk.y = cvtpk(v[2], v[3]);
                LWR(u32x2, prow, g * 16) = pk;
            }
            if (ML) { rs += __shfl_xor(rs, 32); if (hh == 0) LWR(float, tab, T_DS + (si * 64 + t) * 4) = rs; }
        } else if (ML) {
            const int j = tid - 256, t = j >> 2, part = j & 3;
            LAS unsigned char* qrow = Qs + t * QB_ + part * (DK / 4) * 2; LAS unsigned char* nrow = tab + T_N + part * (DK / 4) * 4;
            float a = 0.f;
#pragma unroll
            for (int d8 = 0; d8 < DK / 32; ++d8) { const u32x4 qv = LRD(u32x4, qrow, d8 * 16); const f32x4 n0 = LRD(f32x4, nrow, d8 * 32), n1 = LRD(f32x4, nrow, d8 * 32 + 16);
                a += __uint_as_float(qv.x << 16) * n0.x + __uint_as_float(qv.x & 0xffff0000u) * n0.y + __uint_as_float(qv.y << 16) * n0.z + __uint_as_float(qv.y & 0xffff0000u) * n0.w
                   + __uint_as_float(qv.z << 16) * n1.x + __uint_as_float(qv.z & 0xffff0000u) * n1.y + __uint_as_float(qv.w << 16) * n1.z + __uint_as_float(qv.w & 0xffff0000u) * n1.w; }
            a += __shfl_xor(a, 1); a += __shfl_xor(a, 2);
            if (part == 0) LWR(float, tab, T_D1 + t * 4) = a;
            if (j < 64) { const float cmt = fmaxf(m_prev, LRD(float, tab, T_CM + j * 4));
                LWR(float, tab, T_WI + j * 4) = __expf(m_prev - cmt); LWR(float, tab, T_FL + j * 4) = __expf(-(LRD(float, tab, T_B + j * 4) + cmt)); LWR(float, tab, T_W + j * 4) = __expf(LRD(float, tab, T_A + j * 4) - Mx); }
        }
        __syncthreads();
#pragma unroll
        for (int tt = 0; tt < 2; ++tt) {
            f32x16 O;
#pragma unroll
            for (int i = 0; i < 16; ++i) O[i] = 0.f;
#pragma unroll
            for (int dt = 0; dt < NDT; ++dt)
#pragma unroll
                for (int sp = 0; sp < 2; ++sp) {
                    const bf16x8 bs = pack8(S[dt], sp);
                    const u32x2 lo = LRD(u32x2, qfrag, tt * 32 * QB_ + dt * 64 + sp * 32), hi = LRD(u32x2, qfrag, tt * 32 * QB_ + dt * 64 + sp * 32 + 16);
                    const u32x4 av = {lo.x, lo.y, hi.x, hi.y};
                    O = mfma32(__builtin_bit_cast(bf16x8, av), bs, O);
                    if (ML) __builtin_amdgcn_sched_barrier(0);
                }
            if (ML) {
#pragma unroll
                for (int g = 0; g < 4; ++g) { const f32x4 wi = LRD(f32x4, tabh, T_WI + (32 * tt + 8 * g) * 4);
                    O[4 * g] *= wi.x; O[4 * g + 1] *= wi.y; O[4 * g + 2] *= wi.z; O[4 * g + 3] *= wi.w; }
            }
#pragma unroll
            for (int ks = 0; ks < 4; ++ks) O = mfma32(LRD(bf16x8, pfrag, tt * 32 * TB_ + ks * 32), Bv[ks], O);
            bf16_t* orow = og + (m0 + 32 * tt + 4 * hh) * 1024;
#pragma unroll
            for (int g = 0; g < 4; ++g) {
                f32x4 rd = {1.f, 1.f, 1.f, 1.f};
                if (ML) { const int to = (32 * tt + 8 * g) * 4;
                    const f32x4 wi = LRD(f32x4, tabh, T_WI + to), d1 = LRD(f32x4, tabh, T_D1 + to), ds0 = LRD(f32x4, tabh, T_DS + to), ds1 = LRD(f32x4, tabh, T_DS + 256 + to), fl = LRD(f32x4, tabh, T_FL + to);
                    const f32x4 den = wi * d1 + ds0 + ds1;
                    rd.x = 1.f / fmaxf(fabsf(den.x), fl.x); rd.y = 1.f / fmaxf(fabsf(den.y), fl.y); rd.z = 1.f / fmaxf(fabsf(den.z), fl.z); rd.w = 1.f / fmaxf(fabsf(den.w), fl.w); }
#pragma unroll
                for (int i = 0; i < 4; ++i) orow[(8 * g + i) * 1024] = f2bf(O[4 * g + i] * rd[i]);
            }
            __builtin_amdgcn_sched_barrier(0);
        }
        if (ML) {
#pragma unroll
            for (int ks = 0; ks < 4; ++ks) {
                const f32x4 w0 = LRD(f32x4, tab, T_W + (16 * ks + 8 * hh) * 4), w1 = LRD(f32x4, tab, T_W + (16 * ks + 8 * hh + 4) * 4);
                const u32x4 bv = __builtin_bit_cast(u32x4, Bv[ks]); u32x4 o;
                o.x = cvtpk(__uint_as_float(bv.x << 16) * w0.x, __uint_as_float(bv.x & 0xffff0000u) * w0.y);
                o.y = cvtpk(__uint_as_float(bv.y << 16) * w0.z, __uint_as_float(bv.y & 0xffff0000u) * w0.w);
                o.z = cvtpk(__uint_as_float(bv.z << 16) * w1.x, __uint_as_float(bv.z & 0xffff0000u) * w1.y);
                o.w = cvtpk(__uint_as_float(bv.w << 16) * w1.z, __uint_as_float(bv.w & 0xffff0000u) * w1.w);
                Bv[ks] = __builtin_bit_cast(bf16x8, o);
            }
        }
#pragma unroll
        for (int dt = 0; dt < NDT; ++dt) {
            if (ML) {
#pragma unroll
                for (int i = 0; i < 16; ++i) S[dt][i] *= w_old;
            }
#pragma unroll
            for (int ks = 0; ks < 4; ++ks) S[dt] = mfma32(LRD(bf16x8, ktfrag, dt * 32 * TB_ + ks * 32), Bv[ks], S[dt]);
            if (ML) __builtin_amdgcn_sched_barrier(0);
            if (!ML) {
#pragma unroll
                for (int g = 0; g < 4; ++g) { const f32x4 gg = LRD(f32x4, tabh, T_G + (32 * dt + 8 * g) * 4);
                    S[dt][4 * g] *= gg.x; S[dt][4 * g + 1] *= gg.y; S[dt][4 * g + 2] *= gg.z; S[dt][4 * g + 3] *= gg.w; }
            }
        }
        if (ML) {
            if (tid < 256) { float a = 0.f; LAS unsigned char* krow = KTs + tid * TB_;
#pragma unroll
                for (int s8 = 0; s8 < 8; ++s8) { const u32x4 kv = LRD(u32x4, krow, s8 * 16); const f32x4 w0 = LRD(f32x4, tab, T_W + s8 * 32), w1 = LRD(f32x4, tab, T_W + s8 * 32 + 16);
                    a += __uint_as_float(kv.x << 16) * w0.x + __uint_as_float(kv.x & 0xffff0000u) * w0.y + __uint_as_float(kv.y << 16) * w0.z + __uint_as_float(kv.y & 0xffff0000u) * w0.w
                       + __uint_as_float(kv.z << 16) * w1.x + __uint_as_float(kv.z & 0xffff0000u) * w1.y + __uint_as_float(kv.w << 16) * w1.z + __uint_as_float(kv.w & 0xffff0000u) * w1.w; }
                LWR(float, tab, T_N + tid * 4) = w_old * LRD(float, tab, T_N + tid * 4) + a; }
            m_prev = Btot + Mx;
        }
    }
}
DI f32x4 mfma16(bf16x8 a, bf16x8 b, f32x4 c) { return __builtin_amdgcn_mfma_f32_16x16x32_bf16(a, b, c, 0, 0, 0); }
template <int DK, bool ML, bool PRE>
DI void scan16(const Params& P, float* ldsf, int item, int skip = 0) {
    constexpr int NDT = DK / 16, NJ = DK / 32, QLD = DK + 8, TLD = 72, FT = ML ? 1024 : 512;
    constexpr int QB_ = QLD * 2, TB_ = TLD * 2;
    LAS unsigned char* L0 = (LAS unsigned char*)ldsf;
    LAS unsigned char* Qs = L0; LAS unsigned char* Ks = Qs + 64 * QB_; LAS unsigned char* KTs = Ks + 64 * QB_; LAS unsigned char* Ps = KTs + DK * TB_;
    LAS unsigned char* tab = Ps + 64 * TB_;
    constexpr int T_A = 0, T_CM = 256, T_B = 512, T_W = 768, T_WI = 1024, T_FL = 1280, T_D1 = 1536, T_DS = 1792, T_G = 2816, T_N = 3328, T_BT = 4352, T_CL = 4608;
    const int eh = item & 1, dir = (item >> 1) & 1, h = (item >> 2) & 3, b = item >> 4;
    const bf16_t* qg = (ML ? WSP(bf16_t, WS_QM) : (dir ? WSP(bf16_t, WS_QB) : WSP(bf16_t, WS_QF))) + h * DK;
    const bf16_t* kg_ = (ML ? WSP(bf16_t, WS_KM) : (dir ? WSP(bf16_t, WS_KB) : WSP(bf16_t, WS_KF))) + h * DK;
    const bf16_t* ktg = (ML ? WSP(bf16_t, WS_KMT) : (dir ? WSP(bf16_t, WS_KTB) : WSP(bf16_t, WS_KTF))) + (size_t)h * DK * MTOK;
    const bf16_t* vtg0 = (ML ? WSP(bf16_t, WS_VMT) : WSP(bf16_t, WS_VTG)) + (size_t)(h * 256 + 128 * eh) * MTOK;
    bf16_t* og0 = obuf(P, (ML ? 2 : 0) + dir) + h * 256 + 128 * eh;
    const float* msc = WSP(float, WS_MSC) + (size_t)(dir * 4 + h) * MTOK; const float* mch = WSP(float, WS_MCH) + ((dir * 4 + b) * 4 + h) * 64;
    f32x4 S[NDT];
#pragma unroll
    for (int dt = 0; dt < NDT; ++dt) S[dt] = (f32x4){0.f, 0.f, 0.f, 0.f};
    if (ML && threadIdx.x < 256) LWR(float, tab, T_N + threadIdx.x * 4) = 0.f;
    const int sidx = (dir * 4 + b) * 4 + h;
    if (ML && !PRE && threadIdx.x < 64) { LWR(float, tab, T_BT + threadIdx.x * 4) = mch[threadIdx.x]; LWR(float, tab, T_CL + threadIdx.x * 4) = mch[2048 + threadIdx.x]; }
    if (PRE && threadIdx.x < 64) LWR(float, tab, T_BT + threadIdx.x * 4) = WSP(float, WS_PRES)[sidx * 64 + threadIdx.x];
    __syncthreads();
    float m_prev = 0.f;
    constexpr int NQ = 64 * DK / 8 / NTHR, NKT = DK * 8 / NTHR;
    u32x4 rq[NQ], rk[NQ], rkt[NKT]; bf16x8 Bn[2]; float rt0 = 0.f, rt1 = 0.f, rt2 = 0.f;
    constexpr unsigned QSTEP = (unsigned)(NTHR / (DK / 8)) * FT * 2u, KTSTEP = 64u * MTOK * 2u;
#define SCAN16_TID() unsigned t0_ = threadIdx.x; asm volatile("" : "+v"(t0_))
#define SCAN16_VOQ() (((t0_ / (DK / 8)) * FT + (t0_ % (DK / 8)) * 8) * 2u)
#define SCAN16_VOKT() ((t0_ >> 3) * (unsigned)(MTOK * 2) + (t0_ & 7) * 16u)
#define SCAN16_VOV() ((16 * (t0_ >> 6) + (t0_ & 15)) * (unsigned)(MTOK * 2) + ((t0_ & 63) >> 4) * 16u)
#define LDG(T, ubase, voff) (*(const T*)((const char*)(ubase) + (voff)))
#define SCAN16_LOAD(cc) do { const size_t m0n = (size_t)b * SEQ + (size_t)(cc) * CH; SCAN16_TID(); const unsigned voq = SCAN16_VOQ(), vov = SCAN16_VOV(); \
        const char* qb_ = (const char*)(qg + m0n * FT); const char* kb_ = (const char*)(kg_ + m0n * FT); \
        _Pragma("unroll") for (int i = 0; i < NQ; ++i) { rq[i] = LDG(u32x4, qb_ + (size_t)i * QSTEP, voq); if (!PRE) rk[i] = LDG(u32x4, kb_ + (size_t)i * QSTEP, voq); } \
        if (PRE) { rk[0] = LDG(u32x4, (const char*)(WSP(bf16_t, WS_PREP) + (size_t)(sidx * 64 + (cc)) * 4096), t0_ * 16u); } \
        { const char* vb_ = (const char*)(vtg0 + m0n); Bn[0] = LDG(bf16x8, vb_, vov); Bn[1] = LDG(bf16x8, vb_ + 64, vov); } \
        if (PRE) { if (t0_ < 256) rt0 = WSP(float, WS_PRET)[(size_t)(sidx * 64 + (cc)) * 256 + t0_]; } \
        else if (ML) { if (t0_ < 64) { rt0 = msc[m0n + t0_]; rt1 = msc[(size_t)8 * MTOK + m0n + t0_]; rt2 = msc[(size_t)16 * MTOK + m0n + t0_]; } } \
        else { if (t0_ < 128) rt0 = WSP(float, WS_GDEC)[((size_t)(dir * NB + b) * NCH + (cc)) * 512 + h * 128 + t0_]; } } while (0)
#define SCAN16_LOADKT(cc) do { const size_t m0n = (size_t)b * SEQ + (size_t)(cc) * CH; SCAN16_TID(); const unsigned vokt = SCAN16_VOKT(); const char* tb_ = (const char*)(ktg + m0n); \
        _Pragma("unroll") for (int i = 0; i < NKT; ++i) rkt[i] = LDG(u32x4, tb_ + (size_t)i * KTSTEP, vokt); } while (0)
    SCAN16_LOAD(dir ? NCH - 1 : 0); SCAN16_LOADKT(dir ? NCH - 1 : 0);
    for (int ci = 0; ci < NCH; ++ci) {
        const int c = dir ? NCH - 1 - ci : ci; const size_t m0 = (size_t)b * SEQ + (size_t)c * CH;
        int tid = threadIdx.x; asm volatile("" : "+v"(tid));
        const int lane = tid & 63, w = __builtin_amdgcn_readfirstlane(tid >> 6), c16 = lane & 15, kg = lane >> 4;
        LAS unsigned char* qfrag = Qs + c16 * QB_ + kg * 16;
        LAS unsigned char* pfrag = Ps + c16 * TB_ + kg * 16;
        LAS unsigned char* ktfrag = KTs + c16 * TB_ + kg * 16;
        LAS unsigned char* tabk = tab + kg * 16;
        __syncthreads();
#pragma unroll
        for (int i = 0; i < NQ; ++i) { const int p = tid + i * NTHR, row = p / (DK / 8), c8 = p % (DK / 8);
            const int wq = c8 & 3, off = row * QB_ + (c8 >> 2) * 64 + ((wq & 1) * 16 + (wq >> 1) * 4) * 2;
            LWR(u32x2, Qs, off) = (u32x2){rq[i].x, rq[i].y}; LWR(u32x2, Qs, off + 16) = (u32x2){rq[i].z, rq[i].w};
            if (!PRE) { LWR(u32x2, Ks, off) = (u32x2){rk[i].x, rk[i].y}; LWR(u32x2, Ks, off + 16) = (u32x2){rk[i].z, rk[i].w}; } }
        if (PRE) LWR(u32x4, Ps, (tid >> 3) * TB_ + (tid & 7) * 16) = rk[0];
#pragma unroll
        for (int i = 0; i < NKT; ++i) { const int p = tid + i * NTHR, d = p >> 3, c8 = p & 7; LWR(u32x4, KTs, d * TB_ + c8 * 16) = rkt[i]; }
        bf16x8 Bv[2]; Bv[0] = Bn[0]; Bv[1] = Bn[1];
        float Mx = 0.f, w_old = 1.f, Btot = 0.f;
        if (PRE) {
            if (tid < 256) LWR(float, tab, (tid < 192 ? T_W + tid * 4 : T_DS + (tid - 192) * 4)) = rt0;
            w_old = LRD(float, tab, T_BT + c * 4);
        } else if (ML) {
            if (tid < 64) { LWR(float, tab, T_B + tid * 4) = rt0; LWR(float, tab, T_A + tid * 4) = rt1; LWR(float, tab, T_CM + tid * 4) = rt2; }
            Btot = LRD(float, tab, T_BT + c * 4); const float cml = LRD(float, tab, T_CL + c * 4); Mx = fmaxf(m_prev, cml); w_old = __expf(m_prev - Mx);
        } else {
            if (tid < 128) LWR(float, tab, T_G + tid * 4) = rt0;
        }
        __syncthreads();
        if (ci + 1 < NCH) SCAN16_LOAD(dir ? NCH - 2 - ci : ci + 1);
#define SB() __builtin_amdgcn_sched_barrier(0)
        if (!PRE && !(skip & 1)) {
            constexpr int NS = DK / 64;
            const int idx0 = 2 * w, si0 = idx0 >> 2, ti0 = idx0 & 3, si1 = (idx0 + 1) >> 2, ti1 = (idx0 + 1) & 3;
            const bool dead0 = dir ? (si0 < ti0) : (si0 > ti0), dead1 = dir ? (si1 < ti1) : (si1 > ti1);
            LAS unsigned char* ka0 = Ks + (16 * si0 + c16) * QB_ + kg * 16; LAS unsigned char* qa0 = Qs + (16 * ti0 + c16) * QB_ + kg * 16;
            LAS unsigned char* ka1 = Ks + (16 * si1 + c16) * QB_ + kg * 16; LAS unsigned char* qa1 = Qs + (16 * ti1 + c16) * QB_ + kg * 16;
            f32x4 X0 = {0.f, 0.f, 0.f, 0.f}, X1 = {0.f, 0.f, 0.f, 0.f};
            if (!ML) {
                bf16x8 fa[2][2], fb[2][2];
                fa[0][0] = LRD(bf16x8, ka0, 0); fb[0][0] = LRD(bf16x8, qa0, 0); fa[0][1] = LRD(bf16x8, ka0, 64); fb[0][1] = LRD(bf16x8, qa0, 64);
#pragma unroll
                for (int st = 0; st < 2 * NS; ++st) {
                    if (st + 1 < 2 * NS) {
                        const int sn = st + 1, nb_ = sn & 1, ko = (sn % NS) * 2;
                        LAS unsigned char* kan = (sn < NS) ? ka0 : ka1; LAS unsigned char* qan = (sn < NS) ? qa0 : qa1;
                        fa[nb_][0] = LRD(bf16x8, kan, ko * 64); fb[nb_][0] = LRD(bf16x8, qan, ko * 64); fa[nb_][1] = LRD(bf16x8, kan, (ko + 1) * 64); fb[nb_][1] = LRD(bf16x8, qan, (ko + 1) * 64);
                    }
                    SB();
                    if (st < NS) { if (!dead0) { X0 = mfma16(fa[st & 1][0], fb[st & 1][0], X0); X0 = mfma16(fa[st & 1][1], fb[st & 1][1], X0); } }
                    else { if (!dead1) { X1 = mfma16(fa[st & 1][0], fb[st & 1][0], X1); X1 = mfma16(fa[st & 1][1], fb[st & 1][1], X1); } }
                    SB();
                }
            } else {
#pragma unroll
                for (int st = 0; st < 2 * NS; ++st) {
                    const int ko = (st % NS) * 2; LAS unsigned char* kan = (st < NS) ? ka0 : ka1; LAS unsigned char* qan = (st < NS) ? qa0 : qa1;
                    const bool dd = (st < NS) ? dead0 : dead1;
                    if (!dd) {
                        const bf16x8 a0 = LRD(bf16x8, kan, ko * 64), b0 = LRD(bf16x8, qan, ko * 64), a1 = LRD(bf16x8, kan, (ko + 1) * 64), b1 = LRD(bf16x8, qan, (ko + 1) * 64);
                        if (st < NS) { X0 = mfma16(a0, b0, X0); X0 = mfma16(a1, b1, X0); } else { X1 = mfma16(a0, b0, X1); X1 = mfma16(a1, b1, X1); }
                    }
                    SB();
                }
            }
#pragma unroll
            for (int q2 = 0; q2 < 2; ++q2) {
                const int si = q2 ? si1 : si0, ti = q2 ? ti1 : ti0; const f32x4 X = q2 ? X1 : X0;
                const int t = 16 * ti + c16;
                float cmt = 0.f; if (ML) cmt = fmaxf(m_prev, LRD(float, tab, T_CM + t * 4));
                f32x4 av = {0.f, 0.f, 0.f, 0.f}; if (ML) av = LRD(f32x4, tab, T_A + (16 * si + 4 * kg) * 4);
                float v[4], rs = 0.f;
#pragma unroll
                for (int i = 0; i < 4; ++i) { const int s = 16 * si + 4 * kg + i; const bool keep = dir ? (s >= t) : (s <= t);
                    float x = X[i]; if (ML) x *= __expf(av[i] - cmt); v[i] = keep ? x : 0.f; rs += v[i]; }
                u32x2 pk; pk.x = cvtpk(v[0], v[1]); pk.y = cvtpk(v[2], v[3]);
                LWR(u32x2, Ps, t * TB_ + (16 * si + 4 * kg) * 2) = pk;
                if (ML) { rs += __shfl_xor(rs, 16); rs += __shfl_xor(rs, 32); if (kg == 0) LWR(float, tab, T_DS + (si * 64 + t) * 4) = rs; }
            }
        }
        if (ML && !(skip & 1)) {
            const int t = tid >> 3, part = tid & 7;
            LAS unsigned char* qrow = Qs + t * QB_ + part * (DK / 8) * 2; LAS unsigned char* nrow = tab + T_N + part * (DK / 8) * 4;
            u32x4 qv[DK / 64]; f32x4 n0[DK / 64], n1[DK / 64];
#pragma unroll
            for (int d8 = 0; d8 < DK / 64; ++d8) { qv[d8] = LRD(u32x4, qrow, d8 * 16); n0[d8] = LRD(f32x4, nrow, d8 * 32); n1[d8] = LRD(f32x4, nrow, d8 * 32 + 16); }
            float cmv = 0.f, bvv = 0.f, avv = 0.f;
            if (!PRE && tid < 64) { cmv = LRD(float, tab, T_CM + tid * 4); bvv = LRD(float, tab, T_B + tid * 4); avv = LRD(float, tab, T_A + tid * 4); }
            SB();
            float a = 0.f;
#pragma unroll
            for (int d8 = 0; d8 < DK / 64; ++d8) {
                a += __uint_as_float(qv[d8].x << 16) * n0[d8].x + __uint_as_float(qv[d8].x & 0xffff0000u) * n0[d8].y + __uint_as_float(qv[d8].y << 16) * n0[d8].z + __uint_as_float(qv[d8].y & 0xffff0000u) * n0[d8].w
                   + __uint_as_float(qv[d8].z << 16) * n1[d8].x + __uint_as_float(qv[d8].z & 0xffff0000u) * n1[d8].y + __uint_as_float(qv[d8].w << 16) * n1[d8].z + __uint_as_float(qv[d8].w & 0xffff0000u) * n1[d8].w; }
            a += __shfl_xor(a, 1); a += __shfl_xor(a, 2); a += __shfl_xor(a, 4);
            if (part == 0) LWR(float, tab, T_D1 + t * 4) = a;
            if (!PRE && tid < 64) { const float cmt = fmaxf(m_prev, cmv);
                LWR(float, tab, T_WI + tid * 4) = __expf(m_prev - cmt); LWR(float, tab, T_FL + tid * 4) = __expf(-(bvv + cmt)); LWR(float, tab, T_W + tid * 4) = __expf(avv - Mx); }
        }
        __syncthreads();
        bf16x8 qa[2][4];
#pragma unroll
        for (int tt = 0; tt < 4; ++tt) qa[0][tt] = LRD(bf16x8, qfrag, tt * 16 * QB_);
        f32x4 O[4];
#pragma unroll
        for (int tt = 0; tt < 4; ++tt) O[tt] = (f32x4){0.f, 0.f, 0.f, 0.f};
        if (!(skip & 2))
#pragma unroll
        for (int j = 0; j < NJ; ++j) {
            if (j + 1 < NJ) {
#pragma unroll
                for (int tt = 0; tt < 4; ++tt) qa[(j + 1) & 1][tt] = LRD(bf16x8, qfrag, tt * 16 * QB_ + (j + 1) * 64);
            }
            SB();
            u32x4 bp; bp.x = cvtpk(S[2 * j][0], S[2 * j][1]); bp.y = cvtpk(S[2 * j][2], S[2 * j][3]); bp.z = cvtpk(S[2 * j + 1][0], S[2 * j + 1][1]); bp.w = cvtpk(S[2 * j + 1][2], S[2 * j + 1][3]);
            const bf16x8 bs = __builtin_bit_cast(bf16x8, bp);
#pragma unroll
            for (int tt = 0; tt < 4; ++tt) O[tt] = mfma16(bs, qa[j & 1][tt], O[tt]);
        }
        if (ci + 1 < NCH) SCAN16_LOADKT(dir ? NCH - 2 - ci : ci + 1);
        bf16x8 kt[2][2];
        kt[0][0] = LRD(bf16x8, ktfrag, 0); kt[0][1] = LRD(bf16x8, ktfrag, 64);
        unsigned opk[4][2];
#pragma unroll
        for (int tt = 0; tt < 4; ++tt) {
            const bf16x8 p0 = LRD(bf16x8, pfrag, tt * 16 * TB_), p1 = LRD(bf16x8, pfrag, tt * 16 * TB_ + 64);
            float wi = 1.f, d1 = 0.f, fl = 0.f, ds = 0.f;
            if (ML) { const int to = (16 * tt + c16) * 4;
                wi = LRD(float, tab, T_WI + to); d1 = LRD(float, tab, T_D1 + to); fl = LRD(float, tab, T_FL + to);
                ds = LRD(float, tab, T_DS + to); if (!PRE) ds += LRD(float, tab, T_DS + 256 + to) + LRD(float, tab, T_DS + 512 + to) + LRD(float, tab, T_DS + 768 + to); }
            SB();
            float rd = 1.f;
            if (ML) { O[tt] = O[tt] * wi; rd = frcp(fmaxf(fabsf(wi * d1 + ds), fl)); }
            O[tt] = mfma16(Bv[0], p0, O[tt]); O[tt] = mfma16(Bv[1], p1, O[tt]);
            opk[tt][0] = cvtpk(O[tt][0] * rd, O[tt][1] * rd); opk[tt][1] = cvtpk(O[tt][2] * rd, O[tt][3] * rd);
        }
#pragma unroll
        for (int tp = 0; tp < 2; ++tp) {
            const auto r0 = __builtin_amdgcn_permlane16_swap(opk[2 * tp][0], opk[2 * tp + 1][0], false, false); const auto r1 = __builtin_amdgcn_permlane16_swap(opk[2 * tp][1], opk[2 * tp + 1][1], false, false);
            u32x4 o; o.x = r0[0]; o.y = r1[0]; o.z = r0[1]; o.w = r1[1];
            if (!(skip & 8)) *(u32x4*)(og0 + (m0 + 16 * (2 * tp + (kg & 1)) + c16) * 1024 + 16 * w + 8 * (kg >> 1)) = o;
        }
        if (ML) {
            const f32x4 wv0 = LRD(f32x4, tab, T_W + (8 * kg) * 4), wv1 = LRD(f32x4, tab, T_W + (8 * kg + 4) * 4), wv2 = LRD(f32x4, tab, T_W + (32 + 8 * kg) * 4), wv3 = LRD(f32x4, tab, T_W + (32 + 8 * kg + 4) * 4);
            { const u32x4 bv = __builtin_bit_cast(u32x4, Bv[0]); u32x4 o;
              o.x = cvtpk(__uint_as_float(bv.x << 16) * wv0.x, __uint_as_float(bv.x & 0xffff0000u) * wv0.y); o.y = cvtpk(__uint_as_float(bv.y << 16) * wv0.z, __uint_as_float(bv.y & 0xffff0000u) * wv0.w);
              o.z = cvtpk(__uint_as_float(bv.z << 16) * wv1.x, __uint_as_float(bv.z & 0xffff0000u) * wv1.y); o.w = cvtpk(__uint_as_float(bv.w << 16) * wv1.z, __uint_as_float(bv.w & 0xffff0000u) * wv1.w);
              Bv[0] = __builtin_bit_cast(bf16x8, o); }
            { const u32x4 bv = __builtin_bit_cast(u32x4, Bv[1]); u32x4 o;
              o.x = cvtpk(__uint_as_float(bv.x << 16) * wv2.x, __uint_as_float(bv.x & 0xffff0000u) * wv2.y); o.y = cvtpk(__uint_as_float(bv.y << 16) * wv2.z, __uint_as_float(bv.y & 0xffff0000u) * wv2.w);
              o.z = cvtpk(__uint_as_float(bv.z << 16) * wv3.x, __uint_as_float(bv.z & 0xffff0000u) * wv3.y); o.w = cvtpk(__uint_as_float(bv.w << 16) * wv3.z, __uint_as_float(bv.w & 0xffff0000u) * wv3.w);
              Bv[1] = __builtin_bit_cast(bf16x8, o); }
        }
        f32x4 gdec[NDT];
        if (!ML) {
#pragma unroll
            for (int dt = 0; dt < NDT; ++dt) gdec[dt] = LRD(f32x4, tabk, T_G + dt * 64);
        }
        if (!(skip & 4))
#pragma unroll
        for (int dt = 0; dt < NDT; ++dt) {
            if (dt + 1 < NDT) { kt[(dt + 1) & 1][0] = LRD(bf16x8, ktfrag, (dt + 1) * 16 * TB_); kt[(dt + 1) & 1][1] = LRD(bf16x8, ktfrag, (dt + 1) * 16 * TB_ + 64); }
            SB();
            if (ML) S[dt] = S[dt] * w_old;
            S[dt] = mfma16(kt[dt & 1][0], Bv[0], S[dt]); S[dt] = mfma16(kt[dt & 1][1], Bv[1], S[dt]);
            if (!ML) S[dt] = S[dt] * gdec[dt];
        }
        if (ML) {
            if (tid < 256) { float a = 0.f; LAS unsigned char* krow = KTs + tid * TB_;
                const int dd = tid & 31, npos = (tid & ~31) + 8 * ((dd & 15) >> 2) + 4 * (dd >> 4) + (dd & 3);
                u32x4 kv[8]; f32x4 w0[8], w1[8];
#pragma unroll
                for (int s8 = 0; s8 < 8; ++s8) { kv[s8] = LRD(u32x4, krow, s8 * 16); w0[s8] = LRD(f32x4, tab, T_W + s8 * 32); w1[s8] = LRD(f32x4, tab, T_W + s8 * 32 + 16); }
                const float nold = LRD(float, tab, T_N + npos * 4);
                SB();
#pragma unroll
                for (int s8 = 0; s8 < 8; ++s8) {
                    a += __uint_as_float(kv[s8].x << 16) * w0[s8].x + __uint_as_float(kv[s8].x & 0xffff0000u) * w0[s8].y + __uint_as_float(kv[s8].y << 16) * w0[s8].z + __uint_as_float(kv[s8].y & 0xffff0000u) * w0[s8].w
                       + __uint_as_float(kv[s8].z << 16) * w1[s8].x + __uint_as_float(kv[s8].z & 0xffff0000u) * w1[s8].y + __uint_as_float(kv[s8].w << 16) * w1[s8].z + __uint_as_float(kv[s8].w & 0xffff0000u) * w1[s8].w; }
                LWR(float, tab, T_N + npos * 4) = w_old * nold + a; }
            m_prev = Btot + Mx;
        }
    }
#undef SB
}
#undef SCAN16_LOAD
#undef SCAN16_LOADKT
#undef LDG
#undef SCAN16_TID
#undef SCAN16_VOQ
#undef SCAN16_VOKT
#undef SCAN16_VOV
DI void p3b_ml_pre(const Params& P, float* ldsf, int bid, int nb) {
    constexpr int DK = 256, QB_ = (DK + 8) * 2;
    LAS unsigned char* L0 = (LAS unsigned char*)ldsf;
    LAS unsigned char* Qs = L0; LAS unsigned char* Ks = Qs + 64 * QB_; LAS unsigned char* tab = Ks + 64 * QB_;
    constexpr int T_A = 0, T_CM = 256, T_B = 512, T_DS = 768, T_BT = 1792, T_CL = 2048;
    const int tid = threadIdx.x, lane = tid & 63, w = __builtin_amdgcn_readfirstlane(tid >> 6), c16 = lane & 15, kg = lane >> 4;
    for (int item = bid; item < 256; item += nb) {
        const int o = item & 7, dir = (item >> 3) & 1, h = (item >> 4) & 3, b = item >> 6, sidx = (dir * 4 + b) * 4 + h;
        const bf16_t* qg = WSP(bf16_t, WS_QM) + h * DK; const bf16_t* kg_ = WSP(bf16_t, WS_KM) + h * DK;
        const float* msc = WSP(float, WS_MSC) + (size_t)(dir * 4 + h) * MTOK; const float* mch = WSP(float, WS_MCH) + sidx * 64;
        __syncthreads();
        if (tid < 64) { LWR(float, tab, T_BT + tid * 4) = mch[tid]; LWR(float, tab, T_CL + tid * 4) = mch[2048 + tid]; }
        __syncthreads();
        float m_prev = 0.f;
        for (int ci = 0; ci < 8 * o; ++ci) { const int c = dir ? NCH - 1 - ci : ci; m_prev = LRD(float, tab, T_BT + c * 4) + fmaxf(m_prev, LRD(float, tab, T_CL + c * 4)); }
        u32x4 rq[4], rk[4]; float r0 = 0.f, r1 = 0.f, r2 = 0.f;
#define PRE_LOAD(cc) do { const size_t m0n = (size_t)b * SEQ + (size_t)(cc) * CH; \
        _Pragma("unroll") for (int i = 0; i < 4; ++i) { const int p = tid + i * NTHR, row = p >> 5, c8 = p & 31; \
            rq[i] = *(const u32x4*)(qg + (m0n + row) * 1024 + c8 * 8); rk[i] = *(const u32x4*)(kg_ + (m0n + row) * 1024 + c8 * 8); } \
        if (tid < 64) { r0 = msc[m0n + tid]; r1 = msc[(size_t)8 * MTOK + m0n + tid]; r2 = msc[(size_t)16 * MTOK + m0n + tid]; } } while (0)
        PRE_LOAD(dir ? NCH - 1 - 8 * o : 8 * o);
        for (int k8 = 0; k8 < 8; ++k8) {
            const int ci = 8 * o + k8, c = dir ? NCH - 1 - ci : ci;
            __syncthreads();
#pragma unroll
            for (int i = 0; i < 4; ++i) { const int p = tid + i * NTHR, row = p >> 5, c8 = p & 31; LWR(u32x4, Qs, row * QB_ + c8 * 16) = rq[i]; LWR(u32x4, Ks, row * QB_ + c8 * 16) = rk[i]; }
            if (tid < 64) { LWR(float, tab, T_B + tid * 4) = r0; LWR(float, tab, T_A + tid * 4) = r1; LWR(float, tab, T_CM + tid * 4) = r2; }
            const float Btot = LRD(float, tab, T_BT + c * 4), cml = LRD(float, tab, T_CL + c * 4), Mx = fmaxf(m_prev, cml), w_old = __expf(m_prev - Mx);
            __syncthreads();
            if (k8 + 1 < 8) PRE_LOAD(dir ? NCH - 2 - ci : ci + 1);
            bf16_t* pg = WSP(bf16_t, WS_PREP) + (size_t)(sidx * 64 + c) * 4096;
#pragma unroll
            for (int q2 = 0; q2 < 2; ++q2) {
                const int idx = 2 * w + q2, si = idx >> 2, ti = idx & 3;
                const bool dead = dir ? (si < ti) : (si > ti);
                f32x4 X = {0.f, 0.f, 0.f, 0.f};
                if (!dead) {
                    LAS unsigned char* ka = Ks + (16 * si + c16) * QB_ + kg * 16; LAS unsigned char* qa = Qs + (16 * ti + c16) * QB_ + kg * 16;
#pragma unroll
                    for (int ks = 0; ks < DK / 32; ++ks) X = mfma16(LRD(bf16x8, ka, ks * 64), LRD(bf16x8, qa, ks * 64), X);
                }
                const int t = 16 * ti + c16;
                const float cmt = fmaxf(m_prev, LRD(float, tab, T_CM + t * 4));
                const f32x4 av = LRD(f32x4, tab, T_A + (16 * si + 4 * kg) * 4);
                float v[4], rs = 0.f;
#pragma unroll
                for (int i = 0; i < 4; ++i) { const int s = 16 * si + 4 * kg + i; const bool keep = dir ? (s >= t) : (s <= t);
                    const float x = X[i] * __expf(av[i] - cmt); v[i] = keep ? x : 0.f; rs += v[i]; }
                u32x2 pk; pk.x = cvtpk(v[0], v[1]); pk.y = cvtpk(v[2], v[3]);
                *(u32x2*)(pg + t * 64 + 16 * si + 4 * kg) = pk;
                rs += __shfl_xor(rs, 16); rs += __shfl_xor(rs, 32);
                if (kg == 0) LWR(float, tab, T_DS + (si * 64 + t) * 4) = rs;
            }
            __syncthreads();
            if (tid < 64) {
                const float cmt = fmaxf(m_prev, LRD(float, tab, T_CM + tid * 4));
                float* tg = WSP(float, WS_PRET) + (size_t)(sidx * 64 + c) * 256;
                tg[tid] = __expf(LRD(float, tab, T_A + tid * 4) - Mx);
                tg[64 + tid] = __expf(m_prev - cmt);
                tg[128 + tid] = __expf(-(LRD(float, tab, T_B + tid * 4) + cmt));
                tg[192 + tid] = (LRD(float, tab, T_DS + tid * 4) + LRD(float, tab, T_DS + 256 + tid * 4)) + (LRD(float, tab, T_DS + 512 + tid * 4) + LRD(float, tab, T_DS + 768 + tid * 4));
                if (tid == 0) WSP(float, WS_PRES)[sidx * 64 + c] = w_old;
            }
            m_prev = Btot + Mx;
        }
#undef PRE_LOAD
    }
}

#ifndef FAST_GLA
#define FAST_GLA 1
#endif
#ifndef FAST_ML
#define FAST_ML 0
#endif
DI void p4_scans(const Params& P, float* lds, int bid, int nb, int skip = 0) {
    if (nb >= 256 && bid >= 128) {
        if (!skip) { { SchedKV S{&P, bid - 128}; EpiP1 E{&P}; gemm_run(lds, DM, DM, DM, S, E); } __syncthreads(); p0_prologue(P, lds, bid - 128, nb - 128, 1); }
        return; }
    for (int it = bid; it < 128; it += nb) {
        __syncthreads();
        if (it & 1) scan16<256, true, true>(P, lds, it >> 1, skip);
        else { scan16<128, false, false>(P, lds, it >> 1, skip); if (!skip) { __syncthreads(); p0_prologue(P, lds, it >> 1, 64, 2); } }
    }
    if (nb < 256) { for (int l = bid; l < 64; l += nb) { SchedKV S{&P, l}; EpiP1 E{&P}; gemm_run(lds, DM, DM, DM, S, E); __syncthreads(); } p0_prologue(P, lds, bid, nb, 1); }
}

DI void p5_combine(const Params& P, int bid, int nb) {
    const int lane = threadIdx.x & 63, gw = bid * 8 + (threadIdx.x >> 6), ngw = nb * 8;
    for (int m = gw; m < MTOK; m += ngw) {
        u32x2 a[2][4], bq[2][4], gt[2][4];
#pragma unroll
        for (int mixer = 0; mixer < 2; ++mixer)
#pragma unroll
            for (int h = 0; h < 4; ++h) { const size_t off = (size_t)m * 1024 + h * 256 + lane * 4;
                a[mixer][h] = *(const u32x2*)(obuf(P, mixer * 2) + off); bq[mixer][h] = *(const u32x2*)(obuf(P, mixer * 2 + 1) + off);
                gt[mixer][h] = *(const u32x2*)((mixer ? WSP(bf16_t, WS_MZ) : WSP(bf16_t, WS_GG)) + off); }
#pragma unroll
        for (int mixer = 0; mixer < 2; ++mixer) {
            const float* gn = mixer ? P.in[I_MNORM] : P.in[I_GNORM];
            bf16_t* y = (mixer ? WSP(bf16_t, WS_YB) : WSP(bf16_t, WS_YA)) + (size_t)m * 1024;
#pragma unroll
            for (int h = 0; h < 4; ++h) {
                const int c0 = h * 256 + lane * 4; const u32x2 av = a[mixer][h], bv = bq[mixer][h], gv = gt[mixer][h];
                float v[4], g[4];
                v[0] = bf2f(av.x & 0xffff) + bf2f(bv.x & 0xffff); v[1] = bf2f(av.x >> 16) + bf2f(bv.x >> 16); v[2] = bf2f(av.y & 0xffff) + bf2f(bv.y & 0xffff); v[3] = bf2f(av.y >> 16) + bf2f(bv.y >> 16);
                g[0] = bf2f(gv.x & 0xffff); g[1] = bf2f(gv.x >> 16); g[2] = bf2f(gv.y & 0xffff); g[3] = bf2f(gv.y >> 16);
                const float ss = wave_sum(v[0] * v[0] + v[1] * v[1] + v[2] * v[2] + v[3] * v[3]);
                const float rstd = rsqrtf(ss * (1.f / 256.f) + EPS);
                const f32x4 nw = *(const f32x4*)(gn + c0);
                f32x4 o;
                o.x = v[0] * rstd * nw.x * (mixer ? sigmoidf_(g[0]) : siluf_(g[0])); o.y = v[1] * rstd * nw.y * (mixer ? sigmoidf_(g[1]) : siluf_(g[1]));
                o.z = v[2] * rstd * nw.z * (mixer ? sigmoidf_(g[2]) : siluf_(g[2])); o.w = v[3] * rstd * nw.w * (mixer ? sigmoidf_(g[3]) : siluf_(g[3]));
                st_bf4(y + c0, o);
            }
        }
    }
}

struct SchedP6 {
    const Params* P; int bid, nb;
    DI bool next(int i, Unit& u) const {
        const int L2 = (i >> 1) * nb + bid; if (L2 >= 512) return false;
        const int part = i & 1; u.pm = L2 >> 3; u.pn = L2 & 7; u.kind = part; u.keep = (part == 0); u.aux = 0; u.lda = 1024; u.ldb = 1024;
        u.A = (const bf16_t*)(P->ws + (part ? WS_YB : WS_YA)) + (size_t)u.pm * 256 * 1024;
        u.B = (const bf16_t*)(P->ws + (part ? WS_WB : WS_WA)) + (size_t)u.pn * 256 * 1024;
        return true;
    }
};
struct EpiP6 {
    const Params* Pp;
    DI void operator()(Acc& acc, const Unit& u, int wr, int wc, int fr, int fq) const {
        const Params& P = *Pp;
        const bf16_t* ga = WSP(bf16_t, WS_GA); const bf16_t* gb = WSP(bf16_t, WS_GB); bf16_t* mg = WSP(bf16_t, WS_MERGED);
        ACC_FOREACH3(ai, bj, m) {
            const size_t offw = (size_t)(u.pm * 256 + ACC_ROW(ai, m)) * DM + u.pn * 256 + ACC_COLW(bj);
            u32x2 bb[2]; ld_bf8(gb + offw, bb[0], bb[1]);
            if (u.kind == 0) {
                u32x2 aa[2]; ld_bf8(ga + offw, aa[0], aa[1]);
#pragma unroll
                for (int n = 0; n < 2; ++n) {
                    const u32x2 a = aa[n], b = bb[n];
                    const float eb0 = __expf(-bf2f(b.x & 0xffff)), eb1 = __expf(-bf2f(b.x >> 16)), eb2 = __expf(-bf2f(b.y & 0xffff)), eb3 = __expf(-bf2f(b.y >> 16));
                    const float ea0 = __expf(-bf2f(a.x & 0xffff)), ea1 = __expf(-bf2f(a.x >> 16)), ea2 = __expf(-bf2f(a.y & 0xffff)), ea3 = __expf(-bf2f(a.y >> 16));
                    f32x4& v = acc[ai][bj][m][n];
                    v.x *= (1.f + eb0) * frcp(1.f + ea0); v.y *= (1.f + eb1) * frcp(1.f + ea1); v.z *= (1.f + eb2) * frcp(1.f + ea2); v.w *= (1.f + eb3) * frcp(1.f + ea3);
                }
            } else {
                f32x4 v[2];
#pragma unroll
                for (int n = 0; n < 2; ++n) {
                    const u32x2 b = bb[n];
                    const float eb0 = __expf(-bf2f(b.x & 0xffff)), eb1 = __expf(-bf2f(b.x >> 16)), eb2 = __expf(-bf2f(b.y & 0xffff)), eb3 = __expf(-bf2f(b.y >> 16));
                    v[n] = acc[ai][bj][m][n];
                    v[n].x *= frcp(1.f + eb0); v[n].y *= frcp(1.f + eb1); v[n].z *= frcp(1.f + eb2); v[n].w *= frcp(1.f + eb3);
                }
                st_f8x8((unsigned char*)mg + (size_t)(u.pm * 256 + ACC_ROW(ai, m)) * P8 + u.pn * 256 + ACC_COLW(bj), v[0] * 8.f, v[1] * 8.f);
            }
        }
    }
};

struct SchedRes {
    const Params* P; int bid, nb; size_t a_off, w_off;
    DI bool next(int i, Unit& u) const {
        const int L = i * nb + bid; if (L >= 512) return false;
        u.pm = L >> 3; u.pn = L & 7; u.kind = 0; u.keep = false; u.aux = 0; u.lda = DM; u.ldb = DM;
        u.A = (const bf16_t*)(P->ws + a_off) + (size_t)u.pm * 256 * DM; u.B = (const bf16_t*)(P->ws + w_off) + (size_t)u.pn * 256 * DM;
        return true;
    }
};
template <bool F8AN>
struct EpiResT {
    const Params* Pp; const float* base; const float* gnext; size_t ss_off; float ascale;
    DI void operator()(Acc& acc, const Unit& u, int wr, int wc, int fr, int fq) const {
        const Params& P = *Pp; bf16_t* hb = WSP(bf16_t, WS_H); bf16_t* an = WSP(bf16_t, WS_XN); float* ss = WSP(float, ss_off);
        f32x4 gw[2][2];
#pragma unroll
        for (int bj = 0; bj < 2; ++bj)
#pragma unroll
            for (int n = 0; n < 2; ++n) gw[bj][n] = *(const f32x4*)(gnext + u.pn * 256 + ACC_COL(bj, n));
#pragma unroll
        for (int ai = 0; ai < 2; ++ai)
#pragma unroll
            for (int m = 0; m < 4; ++m) {
                const int row = u.pm * 256 + ACC_ROW(ai, m); float sq = 0.f;
#pragma unroll
                for (int bj = 0; bj < 2; ++bj) {
                    const size_t offw = (size_t)row * DM + u.pn * 256 + ACC_COLW(bj);
                    f32x4 h0, h1;
                    if (F8AN) { h0 = *(const f32x4*)(base + (size_t)row * DM + u.pn * 256 + ACC_COL(bj, 0)); h1 = *(const f32x4*)(base + (size_t)row * DM + u.pn * 256 + ACC_COL(bj, 1)); }
                    else { u32x2 p0, p1; ld_bf8(hb + offw, p0, p1);
                        h0 = (f32x4){bf2f(p0.x & 0xffff), bf2f(p0.x >> 16), bf2f(p0.y & 0xffff), bf2f(p0.y >> 16)}; h1 = (f32x4){bf2f(p1.x & 0xffff), bf2f(p1.x >> 16), bf2f(p1.y & 0xffff), bf2f(p1.y >> 16)}; }
                    h0 += acc[ai][bj][m][0] * ascale; h1 += acc[ai][bj][m][1] * ascale;
                    sq += h0.x * h0.x + h0.y * h0.y + h0.z * h0.z + h0.w * h0.w; sq += h1.x * h1.x + h1.y * h1.y + h1.z * h1.z + h1.w * h1.w;
                    const f32x4 a0 = h0 * gw[bj][0], a1 = h1 * gw[bj][1];
                    if (F8AN) st_f8x8((unsigned char*)an + offw, a0, a1); else st_bf8(an + offw, a0, a1);
                    st_bf8(hb + offw, h0, h1);
                }
                sq += __shfl_xor(sq, 16); sq += __shfl_xor(sq, 32);
                if (fq == 0) ss[(size_t)row * 32 + u.pn * 4 + wc] = sq;
            }
    }
};
DI float row_rstd(const float* ss, int row) {
    float s = 0.f;
#pragma unroll
    for (int i = 0; i < 32; i += 4) { const f32x4 v = *(const f32x4*)(ss + (size_t)row * 32 + i); s += (v.x + v.y) + (v.z + v.w); }
    return rsqrtf(s * (1.f / DM) + EPS);
}

struct EpiQ {
    const Params* Pp;
    DI void operator()(Acc& acc, const Unit& u, int wr, int wc, int fr, int fq) const {
        const Params& P = *Pp; bf16_t* q = WSP(bf16_t, WS_ATTQ); const float* ss = WSP(float, WS_SS1);
#pragma unroll
        for (int ai = 0; ai < 2; ++ai)
#pragma unroll
            for (int m = 0; m < 4; ++m) {
                const int row = u.pm * 256 + ACC_ROW(ai, m); const float sc = row_rstd(ss, row) * 0.04419417382415922f;
#pragma unroll
                for (int bj = 0; bj < 2; ++bj)
#pragma unroll
                    for (int n = 0; n < 2; ++n) st_bf4(q + (size_t)row * DM + u.pn * 256 + ACC_COL(bj, n), acc[ai][bj][m][n] * sc);
            }
    }
};
struct SchedSc {
    const Params* P; int bid, nb;
    DI bool next(int i, Unit& u) const {
        const int L = i * nb + bid; if (L >= 256) return false;
        u.pm = L >> 2; u.pn = L & 3; u.kind = 0; u.keep = false; u.aux = L; u.lda = DM; u.ldb = DM;
        u.A = (const bf16_t*)(P->ws + WS_ATTQ) + (size_t)u.pm * 256 * DM + u.pn * 512;
        u.B = (const bf16_t*)(P->ws + WS_KMEM) + (size_t)(u.pm >> 4) * 256 * DM + u.pn * 512;
        return true;
    }
};
struct EpiSc {
    const Params* Pp;
    DI void operator()(Acc& acc, const Unit& u, int wr, int wc, int fr, int fq) const {
        const Params& P = *Pp; float* sc = WSP(float, WS_SC) + (size_t)u.aux * 65536;
        ACC_FOREACH(ai, bj, m, n) *(f32x4*)(sc + (size_t)ACC_ROW(ai, m) * 256 + ACC_COL(bj, n)) = acc[ai][bj][m][n];
    }
};
DI void p10_softmax(const Params& P, int bid, int nb) {
    const int lane = threadIdx.x & 63, gw = bid * 8 + (threadIdx.x >> 6), ngw = nb * 8;
    for (int r = gw; r < 65536; r += ngw) {
        const f32x4 v = *(const f32x4*)(WSP(float, WS_SC) + (size_t)r * 256 + lane * 4);
        float mx = fmaxf(fmaxf(v.x, v.y), fmaxf(v.z, v.w));
#pragma unroll
        for (int o = 1; o < 64; o <<= 1) mx = fmaxf(mx, __shfl_xor(mx, o));
        f32x4 e; e.x = __expf(v.x - mx); e.y = __expf(v.y - mx); e.z = __expf(v.z - mx); e.w = __expf(v.w - mx);
        const float inv = frcp(wave_sum(e.x + e.y + e.z + e.w));
        st_bf4(WSP(bf16_t, WS_P) + (size_t)r * 256 + lane * 4, e * inv);
    }
}
struct SchedPV {
    const Params* P; int bid, nb;
    DI bool next(int i, Unit& u) const {
        const int L = i * nb + bid; if (L >= 512) return false;
        const int su = L >> 1, nt = L & 1; u.pm = su >> 2; u.pn = (su & 3) * 2 + nt; u.kind = 0; u.keep = false; u.aux = 0; u.lda = 256; u.ldb = 256;
        u.A = (const bf16_t*)(P->ws + WS_P) + (size_t)su * 65536;
        u.B = (const bf16_t*)(P->ws + WS_VTMEM) + (size_t)(u.pm >> 4) * DM * 256 + (size_t)u.pn * 256 * 256;
        return true;
    }
};
struct EpiPV {
    const Params* Pp;
    DI void operator()(Acc& acc, const Unit& u, int wr, int wc, int fr, int fq) const {
        const Params& P = *Pp; bf16_t* o = WSP(bf16_t, WS_ATTO);
        ACC_FOREACH(ai, bj, m, n) st_bf4(o + (size_t)(u.pm * 256 + ACC_ROW(ai, m)) * DM + u.pn * 256 + ACC_COL(bj, n), acc[ai][bj][m][n]);
    }
};

struct SchedFold {
    const Params* P; int bid, nb;
    DI bool next(int i, Unit& u) const {
        const int L = i * nb + bid; if (L >= 256) return false;
        u.keep = false; u.lda = DM; u.ldb = DM; u.aux = 0;
        if (L < 128) { const int b = L >> 5, h = (L >> 3) & 3, kt = L & 7; u.kind = 0; u.pm = b * 4 + h; u.pn = kt;
            u.A = (const bf16_t*)(P->ws + WS_KMEM) + (size_t)(b * 256) * DM + h * 512; u.B = (const bf16_t*)(P->ws + WS_WXQ) + (size_t)(kt * 256) * DM + h * 512; }
        else { const int l = L - 128, b = l >> 5, dt = (l >> 2) & 7, h = l & 3; u.kind = 1; u.pm = b * 8 + dt; u.pn = h;
            u.A = (const bf16_t*)(P->ws + WS_WXO) + (size_t)(dt * 256) * DM + h * 512; u.B = (const bf16_t*)(P->ws + WS_VTMEM) + (size_t)(b * 256) * DM + h * 512; }
        return true;
    }
};
struct EpiFold {
    const Params* Pp;
    DI void operator()(Acc& acc, const Unit& u, int wr, int wc, int fr, int fq) const {
        const Params& P = *Pp;
        if (u.kind == 0) { unsigned char* d = WSP(unsigned char, WS_WKT) + (size_t)u.pm * 256 * DM + u.pn * 256;
            ACC_FOREACH3(ai, bj, m) st_f8x8(d + (size_t)ACC_ROW(ai, m) * DM + ACC_COLW(bj), acc[ai][bj][m][0], acc[ai][bj][m][1]); }
        else { unsigned char* d = WSP(unsigned char, WS_VWT) + (size_t)u.pm * 256 * 1024 + u.pn * 256;
            ACC_FOREACH3(ai, bj, m) st_f8x8(d + (size_t)ACC_ROW(ai, m) * 1024 + ACC_COLW(bj), acc[ai][bj][m][0], acc[ai][bj][m][1]); }
    }
};
struct SchedSc2 {
    const Params* P; int bid, nb;
    DI bool next(int i, Unit& u) const {
        const int L = i * nb + bid; if (L >= 256) return false;
        u.pm = L >> 2; u.pn = L & 3; u.kind = 0; u.keep = false; u.aux = L; u.lda = DM; u.ldb = DM;
        u.A = (const bf16_t*)(P->ws + WS_XN) + (size_t)u.pm * 256 * DM;
        u.B = (const bf16_t*)(P->ws + WS_WKT) + (size_t)((u.pm >> 4) * 4 + u.pn) * 256 * DM;
        return true;
    }
};
struct EpiSc2 {
    const Params* Pp;
    DI void operator()(Acc& acc, const Unit& u, int wr, int wc, int fr, int fq) const {
        const Params& P = *Pp; float* sc = WSP(float, WS_SC) + (size_t)u.aux * 65536; const float* ss = WSP(float, WS_SS1);
#pragma unroll
        for (int ai = 0; ai < 2; ++ai)
#pragma unroll
            for (int m = 0; m < 4; ++m) {
                const int r = ACC_ROW(ai, m); const float s = row_rstd(ss, u.pm * 256 + r) * 0.04419417382415922f;
#pragma unroll
                for (int bj = 0; bj < 2; ++bj)
#pragma unroll
                    for (int n = 0; n < 2; ++n) *(f32x4*)(sc + (size_t)r * 256 + ACC_COL(bj, n)) = acc[ai][bj][m][n] * s;
            }
    }
};
struct SchedSc1u { const Params* P; int su;
    DI bool next(int i, Unit& u) const {
        if (i > 0) return false;
        u.pm = su >> 2; u.pn = su & 3; u.kind = 0; u.keep = false; u.aux = su; u.lda = DM; u.ldb = DM;
        u.A = (const bf16_t*)(P->ws + WS_XN + (size_t)u.pm * 256 * DM);
        u.B = (const bf16_t*)(P->ws + WS_WKT + (size_t)((u.pm >> 4) * 4 + u.pn) * 256 * DM);
        return true; } };
struct EpiScSoftmax {
    const Params* Pp;
    DI void operator()(Acc&, const Unit&, int, int, int, int) const {}
    DI void fused(Acc& acc, const Unit& u, int wr, int wc, int fr, int fq, LAS unsigned char* lds) const {
        const Params& P = *Pp; const float* ss = WSP(float, WS_SS1);
        LAS float* X = (LAS float*)lds;
        LAS float* R = (LAS float*)(lds + 4096);
        { const int t = threadIdx.x; const float* p = ss + (size_t)(u.pm * 256 + (t >> 1)) * 32 + (t & 1) * 16;
          const f32x4 a = *(const f32x4*)p, b = *(const f32x4*)(p + 4), c = *(const f32x4*)(p + 8), d = *(const f32x4*)(p + 12);
          float s = ((a.x + a.y) + (a.z + a.w)) + ((b.x + b.y) + (b.z + b.w)) + ((c.x + c.y) + (c.z + c.w)) + ((d.x + d.y) + (d.z + d.w));
          s += __shfl_xor(s, 1);
          if (!(t & 1)) R[t >> 1] = rsqrtf(s * (1.f / DM) + EPS) * 0.04419417382415922f; }
        asm volatile("s_waitcnt lgkmcnt(0)" ::: "memory"); __builtin_amdgcn_s_barrier(); asm volatile("" ::: "memory");
        float rmax[2][4];
#pragma unroll
        for (int ai = 0; ai < 2; ++ai)
#pragma unroll
            for (int m = 0; m < 4; ++m) {
                const int r = ACC_ROW(ai, m); const float s = R[r];
                float mx = -INFINITY;
#pragma unroll
                for (int bj = 0; bj < 2; ++bj)
#pragma unroll
                    for (int n = 0; n < 2; ++n) { f32x4& v = acc[ai][bj][m][n]; v = v * s; mx = fmaxf(mx, fmaxf(fmaxf(v.x, v.y), fmaxf(v.z, v.w))); }
                mx = fmaxf(mx, __shfl_xor(mx, 16)); mx = fmaxf(mx, __shfl_xor(mx, 32));
                if (fq == 0) X[r * 4 + wc] = mx;
                rmax[ai][m] = mx;
            }
        asm volatile("s_waitcnt lgkmcnt(0)" ::: "memory"); __builtin_amdgcn_s_barrier(); asm volatile("" ::: "memory");
        float rsum[2][4];
#pragma unroll
        for (int ai = 0; ai < 2; ++ai)
#pragma unroll
            for (int m = 0; m < 4; ++m) {
                const int r = ACC_ROW(ai, m); const f32x4 q = *(const LAS f32x4*)(X + r * 4); const float mx = fmaxf(fmaxf(q.x, q.y), fmaxf(q.z, q.w));
                float sm = 0.f;
#pragma unroll
                for (int bj = 0; bj < 2; ++bj)
#pragma unroll
                    for (int n = 0; n < 2; ++n) { f32x4& v = acc[ai][bj][m][n]; v.x = __expf(v.x - mx); v.y = __expf(v.y - mx); v.z = __expf(v.z - mx); v.w = __expf(v.w - mx); sm += (v.x + v.y) + (v.z + v.w); }
                sm += __shfl_xor(sm, 16); sm += __shfl_xor(sm, 32);
                rsum[ai][m] = sm;
            }
        asm volatile("s_waitcnt lgkmcnt(0)" ::: "memory"); __builtin_amdgcn_s_barrier(); asm volatile("" ::: "memory");
#pragma unroll
        for (int ai = 0; ai < 2; ++ai)
#pragma unroll
            for (int m = 0; m < 4; ++m) if (fq == 0) X[ACC_ROW(ai, m) * 4 + wc] = rsum[ai][m];
        asm volatile("s_waitcnt lgkmcnt(0)" ::: "memory"); __builtin_amdgcn_s_barrier(); asm volatile("" ::: "memory");
        unsigned char* pc = WSP(unsigned char, WS_P) + (size_t)(u.pm * 256) * 1024 + u.pn * 256;
#pragma unroll
        for (int ai = 0; ai < 2; ++ai)
#pragma unroll
            for (int m = 0; m < 4; ++m) {
                const int r = ACC_ROW(ai, m); const f32x4 q = *(const LAS f32x4*)(X + r * 4); const float inv = 256.f * frcp((q.x + q.y) + (q.z + q.w));
#pragma unroll
                for (int bj = 0; bj < 2; ++bj)
                    st_f8x8(pc + (size_t)r * 1024 + ACC_COLW(bj), acc[ai][bj][m][0] * inv, acc[ai][bj][m][1] * inv);
            }
        asm volatile("s_waitcnt lgkmcnt(0)" ::: "memory"); __builtin_amdgcn_s_barrier(); asm volatile("" ::: "memory");
    }
};
DI void p10_softmax_cat(const Params& P, int bid, int nb) {
    const int lane = threadIdx.x & 63, gw = bid * 8 + (threadIdx.x >> 6), ngw = nb * 8;
    for (int r = gw; r < 65536; r += ngw) {
        const int su = r >> 8, rr = r & 255, pm = su >> 2, h = su & 3;
        const f32x4 v = *(const f32x4*)(WSP(float, WS_SC) + (size_t)r * 256 + lane * 4);
        float mx = fmaxf(fmaxf(v.x, v.y), fmaxf(v.z, v.w));
#pragma unroll
        for (int o = 1; o < 64; o <<= 1) mx = fmaxf(mx, __shfl_xor(mx, o));
        f32x4 e; e.x = __expf(v.x - mx); e.y = __expf(v.y - mx); e.z = __expf(v.z - mx); e.w = __expf(v.w - mx);
        const float inv = frcp(wave_sum(e.x + e.y + e.z + e.w));
        st_bf4(WSP(bf16_t, WS_P) + (size_t)(pm * 256 + rr) * 1024 + h * 256 + lane * 4, e * inv);
    }
}
struct SchedMix {
    const Params* P; int bid, nb;
    DI bool next(int i, Unit& u) const {
        const int L = i * nb + bid; if (L >= 512) return false;
        u.pm = L >> 3; u.pn = L & 7; u.kind = 0; u.keep = false; u.aux = 0; u.lda = P8; u.ldb = P8;
        u.A = (const bf16_t*)(P->ws + WS_MERGED + (size_t)u.pm * 256 * P8); u.B = (const bf16_t*)(P->ws + WS_WMIX + (size_t)u.pn * 256 * P8);
        return true;
    }
};
struct SchedO {
    const Params* P; int bid, nb;
    DI bool next(int i, Unit& u) const {
        const int L = i * nb + bid; if (L >= 512) return false;
        u.pm = L >> 3; u.pn = L & 7; u.kind = 0; u.keep = false; u.aux = 0; u.lda = 1024; u.ldb = 1024;
        u.A = (const bf16_t*)(P->ws + WS_P + (size_t)u.pm * 256 * 1024);
        u.B = (const bf16_t*)(P->ws + WS_VWT + ((size_t)(u.pm >> 4) * DM + (size_t)u.pn * 256) * 1024);
        return true;
    }
};

struct SchedRt {
    const Params* P; int bid, nb;
    DI bool next(int i, Unit& u) const {
        const int L = i * nb + bid; if (L >= 256) return false;
        u.pm = L >> 2; u.pn = 0; u.kind = 0; u.keep = false; u.aux = L & 3; u.lda = DM; u.ldb = DM;
        u.A = (const bf16_t*)(P->ws + WS_XN) + (size_t)u.pm * 256 * DM + u.aux * 512; u.B = (const bf16_t*)(P->ws + WS_WR) + u.aux * 512;
        return true;
    }
};
struct EpiRt {
    const Params* Pp;
    DI void operator()(Acc& acc, const Unit& u, int wr, int wc, int fr, int fq) const {
        const Params& P = *Pp; float* lg = WSP(float, WS_SC) + (size_t)u.aux * MTOK * 64; const float* ss = WSP(float, WS_SS2);
#pragma unroll
        for (int ai = 0; ai < 2; ++ai)
#pragma unroll
            for (int m = 0; m < 4; ++m) {
                const int row = u.pm * 256 + ACC_ROW(ai, m); const float rs = row_rstd(ss, row);
#pragma unroll
                for (int n = 0; n < 2; ++n) { const int c = ACC_COL(0, n); if (c < 64) *(f32x4*)(lg + (size_t)row * 64 + c) = acc[ai][0][m][n] * rs; }
            }
    }
};
DI void p13_route_fused(const Params& P, float* lds, int bid, int nb) {
    const int tid = threadIdx.x, lane = tid & 63, wave = tid >> 6, c16 = lane & 15, kg = lane >> 4;
    float* part = lds; float* lg = lds + 8 * 64 * 48;
    unsigned* lcnt = (unsigned*)(lds + 8 * 64 * 48 + 64 * 48); unsigned* lbase = lcnt + 32; float* rsl = (float*)(lbase + 32);
    unsigned* cnt = WSP(unsigned, WS_CTL) + CW_CNT;
    int* toke = WSP(int, WS_ROUTE) + RT_TOKE; int* toki = WSP(int, WS_ROUTE) + RT_TOKI; float* tokw = WSP(float, WS_ROUTE) + RT_TOKW;
    for (int ib = bid; ib < MTOK / 64; ib += nb) {
        const size_t m0 = (size_t)ib * 64;
        __syncthreads();
        if (tid < 32) lcnt[tid] = 0u;
        if (tid < 128) {
            const float* p = WSP(float, WS_SS2) + (m0 + (tid >> 1)) * 32 + (tid & 1) * 16;
            const f32x4 a = *(const f32x4*)p, b = *(const f32x4*)(p + 4), c = *(const f32x4*)(p + 8), d = *(const f32x4*)(p + 12);
            float s = ((a.x + a.y) + (a.z + a.w)) + ((b.x + b.y) + (b.z + b.w)) + ((c.x + c.y) + (c.z + c.w)) + ((d.x + d.y) + (d.z + d.w));
            s += __shfl_xor(s, 1);
            if (!(tid & 1)) { const float r = rsqrtf(s * (1.f / DM) + EPS); rsl[tid >> 1] = r; WSP(float, WS_ROUTE)[RT_TOKRS + m0 + (tid >> 1)] = r; } }
        {
            const bf16_t* xa = WSP(bf16_t, WS_XN) + (m0 + c16) * DM + wave * 256 + 8 * kg;
            const bf16_t* wb = WSP(bf16_t, WS_WR) + (size_t)c16 * DM + wave * 256 + 8 * kg;
            f32x4 acc[4][3];
#pragma unroll
            for (int mt = 0; mt < 4; ++mt)
#pragma unroll
                for (int nt = 0; nt < 3; ++nt) acc[mt][nt] = (f32x4){0.f, 0.f, 0.f, 0.f};
#pragma unroll
            for (int k2 = 0; k2 < 4; ++k2) {
                bf16x8 fa[2][4], fb[2][3];
#pragma unroll
                for (int q = 0; q < 2; ++q) {
#pragma unroll
                    for (int mt = 0; mt < 4; ++mt) fa[q][mt] = *(const bf16x8*)(xa + (size_t)(16 * mt) * DM + (2 * k2 + q) * 32);
#pragma unroll
                    for (int nt = 0; nt < 3; ++nt) fb[q][nt] = *(const bf16x8*)(wb + (size_t)(16 * nt) * DM + (2 * k2 + q) * 32);
#pragma unroll
                    for (int mt = 0; mt < 4; ++mt) {
                        const u32x4 v = __builtin_bit_cast(u32x4, fa[q][mt]); u32x2 o;
                        o.x = pk4_f8(__uint_as_float(v.x << 16), __uint_as_float(v.x & 0xffff0000u), __uint_as_float(v.y << 16), __uint_as_float(v.y & 0xffff0000u));
                        o.y = pk4_f8(__uint_as_float(v.z << 16), __uint_as_float(v.z & 0xffff0000u), __uint_as_float(v.w << 16), __uint_as_float(v.w & 0xffff0000u));
                        *(u32x2*)(WSP(unsigned char, WS_XROWS) + (m0 + c16 + 16 * mt) * DM + wave * 256 + 8 * kg + (2 * k2 + q) * 32) = o; }
                }
#pragma unroll
                for (int q = 0; q < 2; ++q)
#pragma unroll
                    for (int mt = 0; mt < 4; ++mt)
#pragma unroll
                        for (int nt = 0; nt < 3; ++nt) acc[mt][nt] = __builtin_amdgcn_mfma_f32_16x16x32_bf16(fa[q][mt], fb[q][nt], acc[mt][nt], 0, 0, 0);
            }
#pragma unroll
            for (int mt = 0; mt < 4; ++mt)
#pragma unroll
                for (int nt = 0; nt < 3; ++nt)
#pragma unroll
                    for (int i = 0; i < 4; ++i) part[(wave * 64 + 16 * mt + 4 * kg + i) * 48 + 16 * nt + c16] = acc[mt][nt][i];
        }
        __syncthreads();
        for (int i = tid; i < 64 * 48; i += NTHR) { float s = 0.f;
#pragma unroll
            for (int w8 = 0; w8 < 8; ++w8) s += part[w8 * 3072 + i];
            lg[i] = s * rsl[i / 48]; }
        __syncthreads();
        int re0 = 0, re1 = 0; unsigned rk0 = 0u, rk1 = 0u; float rw0 = 0.f, rw1 = 0.f;
        if (tid < 64) {
            const int t = (int)m0 + tid; const float* l = lg + tid * 48;
            float gl[4]; int gs = 0; float gm = -INFINITY;
#pragma unroll
            for (int g = 0; g < 4; ++g) { gl[g] = l[32 + g] + P.in[I_BGRP][g]; if (gl[g] > gm) { gm = gl[g]; gs = g; } }
            float gsum = 0.f;
#pragma unroll
            for (int g = 0; g < 4; ++g) gsum += __expf(gl[g] - gm);
            const float pg = 1.f / gsum;
            float el[8]; float em = -INFINITY;
#pragma unroll
            for (int e = 0; e < 8; ++e) { el[e] = l[gs * 8 + e] + P.in[I_BRT][gs * 8 + e]; em = fmaxf(em, el[e]); }
            int i0 = 0; float p0 = -1.f; float ep[8];
#pragma unroll
            for (int e = 0; e < 8; ++e) ep[e] = __expf(el[e] - em);
#pragma unroll
            for (int e = 0; e < 8; ++e) if (ep[e] > p0) { p0 = ep[e]; i0 = e; }
            int i1 = 0; float p1 = -1.f;
#pragma unroll
            for (int e = 0; e < 8; ++e) if (e != i0 && ep[e] > p1) { p1 = ep[e]; i1 = e; }
            const float w0 = pg * p0 / (p0 + p1), w1 = pg * p1 / (p0 + p1);
            const int e0 = gs * 8 + i0, e1 = gs * 8 + i1;
            toke[t * 2] = e0; toke[t * 2 + 1] = e1; tokw[t * 2] = w0; tokw[t * 2 + 1] = w1;
            re0 = e0; re1 = e1; rw0 = w0; rw1 = w1; rk0 = atomicAdd(&lcnt[e0], 1u); rk1 = atomicAdd(&lcnt[e1], 1u);
        }
        __syncthreads();
        if (tid < 32) { const unsigned n = lcnt[tid]; lbase[tid] = n ? atomicAdd(&cnt[tid * 32], n) : 0u; }
        __syncthreads();
        if (tid < 64) { const int t = (int)m0 + tid; const int s0 = (int)(lbase[re0] + rk0), s1 = (int)(lbase[re1] + rk1); toki[t * 2] = s0; toki[t * 2 + 1] = s1;
            const float rs = rsl[tid];
            WSP(int, WS_ETOK)[re0 * ECAP + s0] = t; WSP(float, WS_ERS)[re0 * ECAP + s0] = rs; WSP(float, WS_EW)[re0 * ECAP + s0] = rw0;
            WSP(int, WS_ETOK)[re1 * ECAP + s1] = t; WSP(float, WS_ERS)[re1 * ECAP + s1] = rs; WSP(float, WS_EW)[re1 * ECAP + s1] = rw1; }
    }
}
DI void p14_route(const Params& P, int bid, int nb) {
    const int gt = bid * NTHR + threadIdx.x, ngt = nb * NTHR;
    unsigned* cnt = WSP(unsigned, WS_CTL) + CW_CNT;
    int* toke = WSP(int, WS_ROUTE) + RT_TOKE; int* toki = WSP(int, WS_ROUTE) + RT_TOKI; float* tokw = WSP(float, WS_ROUTE) + RT_TOKW;
    for (int t = gt; t < MTOK; t += ngt) {
        const float* lg = WSP(float, WS_SC) + (size_t)t * 64; constexpr size_t LP = (size_t)MTOK * 64;
        float gl[4]; int gs = 0; float gm = -INFINITY;
        { const f32x4 g0 = *(const f32x4*)(lg + 32), g1 = *(const f32x4*)(lg + LP + 32), g2 = *(const f32x4*)(lg + 2 * LP + 32), g3 = *(const f32x4*)(lg + 3 * LP + 32);
          const f32x4 gsum4 = (g0 + g1) + (g2 + g3); gl[0] = gsum4.x; gl[1] = gsum4.y; gl[2] = gsum4.z; gl[3] = gsum4.w; }
#pragma unroll
        for (int g = 0; g < 4; ++g) { gl[g] += P.in[I_BGRP][g]; if (gl[g] > gm) { gm = gl[g]; gs = g; } }
        float gsum = 0.f;
#pragma unroll
        for (int g = 0; g < 4; ++g) gsum += __expf(gl[g] - gm);
        const float pg = 1.f / gsum;
        float el[8]; float em = -INFINITY;
#pragma unroll
        for (int e = 0; e < 8; ++e) { const float* q = lg + gs * 8 + e; el[e] = ((q[0] + q[LP]) + (q[2 * LP] + q[3 * LP])) + P.in[I_BRT][gs * 8 + e]; em = fmaxf(em, el[e]); }
        int i0 = 0; float p0 = -1.f, esum = 0.f; float ep[8];
#pragma unroll
        for (int e = 0; e < 8; ++e) { ep[e] = __expf(el[e] - em); esum += ep[e]; }
#pragma unroll
        for (int e = 0; e < 8; ++e) if (ep[e] > p0) { p0 = ep[e]; i0 = e; }
        int i1 = 0; float p1 = -1.f;
#pragma unroll
        for (int e = 0; e < 8; ++e) if (e != i0 && ep[e] > p1) { p1 = ep[e]; i1 = e; }
        const float w0 = pg * p0 / (p0 + p1), w1 = pg * p1 / (p0 + p1);
        const int e0 = gs * 8 + i0, e1 = gs * 8 + i1;
        toke[t * 2] = e0; toke[t * 2 + 1] = e1; tokw[t * 2] = w0; tokw[t * 2 + 1] = w1;
        toki[t * 2] = (int)atomicAdd(&cnt[e0 * 32], 1u); toki[t * 2 + 1] = (int)atomicAdd(&cnt[e1 * 32], 1u);
    }
}
DI LAS int* tstab(float* lds) { return (LAS int*)((LAS unsigned char*)lds + 131072); }
DI void fill_tstab(const Params& P, float* lds) {
    if (threadIdx.x < 64) { const int lane = threadIdx.x; const unsigned* cnt = WSP(unsigned, WS_CTL) + CW_CNT;
        int v = lane < 32 ? (((int)cnt[lane * 32] + 255) >> 8) : 0;
#pragma unroll
        for (int o = 1; o < 64; o <<= 1) { const int t = __shfl_up(v, o); if (lane >= o) v += t; }
        if (lane < 32) tstab(lds)[lane + 1] = v; if (lane == 0) tstab(lds)[0] = 0; }
    __syncthreads();
}
DI void p15_gather(const Params& P, float* lds, int bid, int nb) {
    fill_tstab(P, lds); const LAS int* ts = tstab(lds);
    const int lane = threadIdx.x & 63, gw = bid * 8 + (threadIdx.x >> 6), ngw = nb * 8;
    const unsigned* cnt = WSP(unsigned, WS_CTL) + CW_CNT;
    const int* toke = WSP(int, WS_ROUTE) + RT_TOKE; const int* toki = WSP(int, WS_ROUTE) + RT_TOKI; const float* tokw = WSP(float, WS_ROUTE) + RT_TOKW;
    float* rowrs = WSP(float, WS_ROUTE) + RT_ROWRS; float* roww = WSP(float, WS_ROUTE) + RT_ROWW;
    for (int a = gw; a < MTOK * 2; a += ngw) {
        const int t = a >> 1, e = toke[a];
        const int row = ts[e] * 256 + toki[a];
        const u32x4* src = (const u32x4*)(WSP(bf16_t, WS_XN) + (size_t)t * DM); u32x2* dst = (u32x2*)(WSP(unsigned char, WS_XROWS) + (size_t)row * DM);
        u32x4 v[4];
#pragma unroll
        for (int j = 0; j < 4; ++j) v[j] = src[lane + 64 * j];
#pragma unroll
        for (int j = 0; j < 4; ++j) { u32x2 o;
            o.x = pk4_f8(__uint_as_float(v[j].x << 16), __uint_as_float(v[j].x & 0xffff0000u), __uint_as_float(v[j].y << 16), __uint_as_float(v[j].y & 0xffff0000u));
            o.y = pk4_f8(__uint_as_float(v[j].z << 16), __uint_as_float(v[j].z & 0xffff0000u), __uint_as_float(v[j].w << 16), __uint_as_float(v[j].w & 0xffff0000u));
            dst[lane + 64 * j] = o; }
        if (lane == 0) { rowrs[row] = WSP(float, WS_ROUTE)[RT_TOKRS + t]; roww[row] = tokw[a]; }
    }
}
struct SchedExp {
    const Params* P; int bid, nb; int down; const LAS int* ts;
    DI bool next(int i, Unit& u) const {
        const int npn = down ? 8 : 4; const int L = i * nb + bid; const int T = L / npn; u.pn = L % npn;
        if (T >= ts[32]) return false;
        int e = 0;
#pragma unroll
        for (int s = 16; s > 0; s >>= 1) if (ts[e + s] <= T) e += s;
        while (ts[e + 1] <= T) ++e;
        u.pm = T; u.kind = 0; u.keep = false; u.aux = e; u.ebase = e * ECAP + (T - ts[e]) * 256;
        if (!down) { u.lda = DM; u.ldb = DM; u.A = (const bf16_t*)(P->ws + WS_XROWS); u.B = (const bf16_t*)(P->ws + WS_WGU + ((size_t)e * 1024 + u.pn * 256) * DM); }
        else { u.lda = DEXP; u.ldb = DEXP; u.A = (const bf16_t*)(P->ws + WS_HID + (size_t)T * 256 * DEXP); u.B = (const bf16_t*)(P->ws + WS_WD + ((size_t)e * DM + u.pn * 256) * DEXP); }
        return true;
    }
    DI unsigned rowoff(const Unit& u, int r) const {
        const int slot = u.ebase - u.aux * ECAP + r; const unsigned n = ((const unsigned*)(P->ws + WS_CTL))[CW_CNT + u.aux * 32];
        const int tok = (unsigned)slot < n ? ((const int*)(P->ws + WS_ETOK))[u.ebase + r] : 0;
        return (unsigned)tok * (unsigned)DM;
    }
};
struct EpiGU {
    const Params* Pp;
    DI void operator()(Acc& acc, const Unit& u, int wr, int wc, int fr, int fq) const {
        const Params& P = *Pp; bf16_t* hid = WSP(bf16_t, WS_HID); const float* rowrs = WSP(float, WS_ERS) + u.ebase;
#pragma unroll
        for (int ai = 0; ai < 2; ++ai)
#pragma unroll
            for (int m = 0; m < 4; ++m) {
                const int row = u.pm * 256 + ACC_ROW(ai, m); const float rs = rowrs[ACC_ROW(ai, m)];
                f32x4 o[2];
#pragma unroll
                for (int n = 0; n < 2; ++n) {
                    const f32x4 g = acc[ai][0][m][n] * (rs * (1.f / 64.f)), up = acc[ai][1][m][n] * (rs * (1.f / 64.f));
                    o[n].x = siluf_(g.x) * up.x; o[n].y = siluf_(g.y) * up.y; o[n].z = siluf_(g.z) * up.z; o[n].w = siluf_(g.w) * up.w;
                }
                st_f8x8((unsigned char*)hid + (size_t)row * DEXP + u.pn * 128 + ACC_COLW(0), o[0], o[1]);
            }
    }
};
struct EpiDown {
    const Params* Pp;
    DI void operator()(Acc& acc, const Unit& u, int wr, int wc, int fr, int fq) const {
        const Params& P = *Pp; bf16_t* y = WSP(bf16_t, WS_YROWS); const float* roww = WSP(float, WS_EW) + u.ebase;
#pragma unroll
        for (int ai = 0; ai < 2; ++ai)
#pragma unroll
            for (int m = 0; m < 4; ++m) {
                const int row = u.pm * 256 + ACC_ROW(ai, m); const float w = roww[ACC_ROW(ai, m)] * (1.f / 32.f);
#pragma unroll
                for (int bj = 0; bj < 2; ++bj)
                    st_bf8(y + (size_t)row * DM + u.pn * 256 + ACC_COLW(bj), acc[ai][bj][m][0] * w, acc[ai][bj][m][1] * w);
            }
    }
};
DI void p18_final(const Params& P, float* lds, int bid, int nb) {
    fill_tstab(P, lds); const LAS int* ts = tstab(lds);
    const int lane = threadIdx.x & 63, gw = bid * 8 + (threadIdx.x >> 6), ngw = nb * 8;
    const unsigned* cnt = WSP(unsigned, WS_CTL) + CW_CNT;
    const int* toke = WSP(int, WS_ROUTE) + RT_TOKE; const int* toki = WSP(int, WS_ROUTE) + RT_TOKI;
    f32x4 g[4][2];
#pragma unroll
    for (int j = 0; j < 4; ++j) { g[j][0] = *(const f32x4*)(P.in[I_NFIN] + 512 * j + 8 * lane); g[j][1] = *(const f32x4*)(P.in[I_NFIN] + 512 * j + 8 * lane + 4); }
    for (int t = gw; t < MTOK; t += ngw) {
        const int r0 = ts[toke[2 * t]] * 256 + toki[2 * t], r1 = ts[toke[2 * t + 1]] * 256 + toki[2 * t + 1];
        const bf16_t* y0 = WSP(bf16_t, WS_YROWS) + (size_t)r0 * DM; const bf16_t* y1 = WSP(bf16_t, WS_YROWS) + (size_t)r1 * DM;
        float* o = P.out + (size_t)t * DM; const bf16_t* hb = WSP(bf16_t, WS_H) + (size_t)t * DM;
        f32x4 v[4][2]; float s = 0.f;
#pragma unroll
        for (int j = 0; j < 4; ++j) { const int c = 512 * j + 8 * lane; const u32x4 a = *(const u32x4*)(y0 + c), b = *(const u32x4*)(y1 + c), hh = *(const u32x4*)(hb + c);
            f32x4 h0, h1;
            h0.x = bf2f(hh.x & 0xffff) + bf2f(a.x & 0xffff) + bf2f(b.x & 0xffff); h0.y = bf2f(hh.x >> 16) + bf2f(a.x >> 16) + bf2f(b.x >> 16);
            h0.z = bf2f(hh.y & 0xffff) + bf2f(a.y & 0xffff) + bf2f(b.y & 0xffff); h0.w = bf2f(hh.y >> 16) + bf2f(a.y >> 16) + bf2f(b.y >> 16);
            h1.x = bf2f(hh.z & 0xffff) + bf2f(a.z & 0xffff) + bf2f(b.z & 0xffff); h1.y = bf2f(hh.z >> 16) + bf2f(a.z >> 16) + bf2f(b.z >> 16);
            h1.z = bf2f(hh.w & 0xffff) + bf2f(a.w & 0xffff) + bf2f(b.w & 0xffff); h1.w = bf2f(hh.w >> 16) + bf2f(a.w >> 16) + bf2f(b.w >> 16);
            v[j][0] = h0; v[j][1] = h1; s += h0.x * h0.x + h0.y * h0.y + h0.z * h0.z + h0.w * h0.w + h1.x * h1.x + h1.y * h1.y + h1.z * h1.z + h1.w * h1.w; }
        const float rstd = rsqrtf(wave_sum(s) * (1.f / DM) + EPS);
#pragma unroll
        for (int j = 0; j < 4; ++j) { const int c = 512 * j + 8 * lane; *(f32x4*)(o + c) = v[j][0] * rstd * g[j][0]; *(f32x4*)(o + c + 4) = v[j][1] * rstd * g[j][1]; }
    }
}

constexpr int N_PHASES = 19;
#define XB_TMO      128
#define XB_XCNT(j)  (256  + 64 * (j))
#define XB_XSUB(j)  (1280 + 64 * (j))
#define XB_XGEN(j)  (2304 + 64 * (j))
#define XB_TOP      3328
#define XB_TOPGEN   3392
#define XB_SPIN_CAP (1u << 18)
constexpr int CW_BAR = 4096;
DI unsigned xb_ld(unsigned* p)              { return __hip_atomic_load(p, __ATOMIC_RELAXED, __HIP_MEMORY_SCOPE_AGENT); }
DI unsigned xb_add(unsigned* p, unsigned v) { return __hip_atomic_fetch_add(p, v, __ATOMIC_RELAXED, __HIP_MEMORY_SCOPE_AGENT); }
DI unsigned xb_xcc_id() { return (unsigned)__builtin_amdgcn_s_getreg((3 << 11) | 20) & 0xFu; }
#define XB_SPIN(cond, bar) do { unsigned _sp = 0; while (cond) { __builtin_amdgcn_s_sleep(1); \
    if ((++_sp & 255u) == 0u) { if (xb_ld(&(bar)[XB_TMO])) break; if (_sp > XB_SPIN_CAP) { atomicAdd(&(bar)[XB_TMO], 1u); break; } } } } while (0)
struct XcdBarrier { unsigned* bar; unsigned x; volatile LAS unsigned* st; };
DI XcdBarrier xcd_barrier_post(unsigned* bar, volatile LAS unsigned* st) {
    XcdBarrier b; b.bar = bar; b.x = xb_xcc_id(); b.st = st;
    if (threadIdx.x == 0) (void)xb_add(&bar[XB_XCNT(b.x)], 1u);
    return b;
}
DI void xcd_barrier_complete(unsigned* bar, unsigned x, unsigned& nloc, unsigned& nx) {
    const unsigned G = gridDim.x * gridDim.y * gridDim.z;
    unsigned sum, cnt, mine, sp = 0u;
    for (;;) {
        sum = 0u; cnt = 0u; mine = 0u;
#pragma unroll
        for (unsigned j = 0; j < 16; ++j) { const unsigned c = xb_ld(&bar[XB_XCNT(j)]); sum += c; cnt += (c > 0u) ? 1u : 0u; mine = (j == x) ? c : mine; }
        if (sum == G) break;
        __builtin_amdgcn_s_sleep(1);
        if ((++sp & 255u) == 0u) { if (xb_ld(&bar[XB_TMO])) break; if (sp > XB_SPIN_CAP) { atomicAdd(&bar[XB_TMO], 1u); break; } }
    }
    nloc = mine > 0u ? mine : 1u; nx = cnt > 0u ? cnt : 1u;
}
DI void xcd_barrier(const XcdBarrier& b) {
    asm volatile("s_waitcnt vmcnt(0)" ::: "memory");
    __syncthreads();
    if (threadIdx.x == 0) {
        unsigned* bar = b.bar;
        __builtin_amdgcn_s_waitcnt(0);
        unsigned nloc = b.st[0], nx = b.st[1];
        if (nloc == 0u) { xcd_barrier_complete(bar, b.x, nloc, nx); b.st[0] = nloc; b.st[1] = nx; }
        const unsigned old = xb_add(&bar[XB_XSUB(b.x)], 1u);
        const unsigned gen = old / nloc;
        if (old + 1u == (gen + 1u) * nloc) {
            __builtin_amdgcn_fence(__ATOMIC_RELEASE, "agent");
            asm volatile("s_waitcnt vmcnt(0)" ::: "memory");
            const unsigned og = xb_add(&bar[XB_TOP], 1u);
            const unsigned tg = og / nx;
            if (og + 1u == (tg + 1u) * nx) xb_add(&bar[XB_TOPGEN], 1u);
            else XB_SPIN(xb_ld(&bar[XB_TOPGEN]) == tg, bar);
            __builtin_amdgcn_fence(__ATOMIC_ACQUIRE, "agent");
            xb_add(&bar[XB_XGEN(b.x)], 1u);
            asm volatile("s_waitcnt vmcnt(0)" ::: "memory");
        } else {
            XB_SPIN(xb_ld(&bar[XB_XGEN(b.x)]) == gen, bar);
            __builtin_amdgcn_fence(__ATOMIC_ACQUIRE, "agent");
            asm volatile("s_waitcnt vmcnt(0)" ::: "memory");
        }
    }
    __syncthreads();
}
#ifndef DUP_PHASE

#define DUP_PHASE -1
#endif
#define PHASE(k, ...) if (ph_lo <= (k) && (k) < ph_hi) { if ((k) > ph_lo) { xcd_barrier(xbar); } \
    { __VA_ARGS__ } __syncthreads(); if (DUP_PHASE == (k)) { xcd_barrier(xbar); { __VA_ARGS__ } __syncthreads(); } }
__global__ void __launch_bounds__(NTHR, 2) mega(Params P, int ph_lo, int ph_hi) {
    extern __shared__ __attribute__((aligned(16))) float lds[];
    const int bid = blockIdx.x, nb = gridDim.x;
    volatile LAS unsigned* xst = (volatile LAS unsigned*)((LAS unsigned char*)lds + 131072 + 512);
    if (threadIdx.x < 4) xst[threadIdx.x] = 0u;
    __syncthreads();
    const XcdBarrier xbar = xcd_barrier_post(WSP(unsigned, WS_CTL) + CW_BAR, xst);
    PHASE(0, p0_prologue(P, lds, bid, nb, 0);)
    PHASE(1, { SchedP1 S{&P, bid, nb}; EpiP1 E{&P}; gemm_run(lds, DM, PX, PX, S, E); SchedP1g S2{&P, bid, nb}; pg8::gemm_phase<EpiP1, SchedP1g, false, true>((LAS unsigned char*)lds, DM, P8, P8, S2, E); })
    PHASE(2, p2_prep(P, lds, bid, nb);)
    PHASE(3, { SchedP3 S{&P, bid, nb, 0}; EpiP3<0> E{&P}; gemm_run(lds, 256, 1024, 256, S, E); SchedP3 S2{&P, bid, nb, 1}; EpiP3<1> E2{&P}; gemm_run(lds, 256, 256, 1024, S2, E2); })
    if (ph_lo <= 3 && 3 < ph_hi) { xcd_barrier(xbar); p3b_ml_pre(P, lds, bid, nb); __syncthreads(); }
#ifdef DUP4_SKIP
    { xcd_barrier(xbar); int sk = DUP4_SKIP; asm volatile("" : "+s"(sk)); p4_scans(P, lds, bid, nb, sk); __syncthreads(); }
#endif
    PHASE(4, p4_scans(P, lds, bid, nb);)
    PHASE(5, { SchedFold S{&P, bid, nb}; EpiFold E{&P}; gemm_run(lds, 512, DM, DM, S, E); } __syncthreads(); p5_combine(P, bid, nb);)
    PHASE(6, { SchedP6 S{&P, bid, nb}; EpiP6 E{&P}; gemm_run(lds, 1024, 1024, 1024, S, E); })
    PHASE(7, { SchedMix S{&P, bid, nb}; EpiResT<true> E{&P, P.in[I_X], P.in[I_NXA], WS_SS1, 1.f / 512.f}; pg8::gemm_phase<EpiResT<true>, SchedMix, false, true>((LAS unsigned char*)lds, DM, P8, P8, S, E); })
    PHASE(8, { for (int su = bid; su < 256; su += nb) { SchedSc1u S{&P, su}; EpiScSoftmax E{&P}; pg8::gemm_phase<EpiScSoftmax, SchedSc1u, true, true>((LAS unsigned char*)lds, DM, DM, DM, S, E); } })
    PHASE(12, { SchedO S{&P, bid, nb}; EpiResT<false> E{&P, nullptr, P.in[I_NFFN], WS_SS2, 1.f / 256.f}; pg8::gemm_phase<EpiResT<false>, SchedO, false, true>((LAS unsigned char*)lds, 1024, 1024, 1024, S, E); })
    PHASE(13, p13_route_fused(P, lds, bid, nb);)
    PHASE(16, { fill_tstab(P, lds); const int n_units = tstab(lds)[32] * 4; { SchedExp S{&P, bid, nb, 0, tstab(lds)}; EpiGU E{&P}; pg8::gemm_phase<EpiGU, SchedExp, false, true, true>((LAS unsigned char*)lds, DM, DM, DM, S, E); }
    })
    PHASE(17, { fill_tstab(P, lds); SchedExp S{&P, bid, nb, 1, tstab(lds)}; EpiDown E{&P}; pg8::gemm_phase<EpiDown, SchedExp, false, true>((LAS unsigned char*)lds, DEXP, DEXP, DEXP, S, E); })
    PHASE(18, p18_final(P, lds, bid, nb);)
}

#ifndef N_LAUNCH_PER_PHASE
#define N_LAUNCH_PER_PHASE 0
#endif
extern "C" void kernel_launch(void* const* d_in, const int* in_sizes, int n_in, void* d_out, int out_size, void* d_ws, size_t ws_size, hipStream_t stream) {
    Params P{};
    for (int i = 0; i < 33; ++i) P.in[i] = (const float*)d_in[i];
    P.out = (float*)d_out; P.ws = (unsigned char*)d_ws;
    constexpr int LDS_BYTES = 131072 + 1024;
    static int grid = 0;
    if (!grid) {
        (void)hipFuncSetAttribute((const void*)mega, hipFuncAttributeMaxDynamicSharedMemorySize, LDS_BYTES);
        int dev = 0, cus = 0, per_cu = 0;
        (void)hipGetDevice(&dev); (void)hipDeviceGetAttribute(&cus, hipDeviceAttributeMultiprocessorCount, dev);
        (void)hipOccupancyMaxActiveBlocksPerMultiprocessor(&per_cu, (const void*)mega, NTHR, LDS_BYTES);
        if (per_cu < 1) per_cu = 1;
        grid = cus;
        if (grid > cus * per_cu) grid = cus * per_cu;
    }
    (void)hipMemsetAsync((char*)d_ws + WS_CTL, 0, 32768, stream);
#if N_LAUNCH_PER_PHASE
    for (int ph = 0; ph < N_PHASES; ++ph) hipLaunchKernelGGL(mega, dim3(grid), dim3(NTHR), LDS_BYTES, stream, P, ph, ph + 1);
#else
    int lo = 0, hi = N_PHASES;
    void* args[] = {&P, &lo, &hi};
    hipError_t e = hipLaunchCooperativeKernel((const void*)mega, dim3(grid), dim3(NTHR), args, LDS_BYTES, stream);
    if (e != hipSuccess) fprintf(stderr, "cooperative launch failed: %s (grid %d)\n", hipGetErrorString(e), grid);
#endif
}
```

```cpp
#include <hip/hip_runtime.h>
#include <hip/hip_cooperative_groups.h>
namespace cg = cooperative_groups;
#include <cstdint>
#include <cstdio>

#define DI __device__ __forceinline__
typedef unsigned short bf16_t;
typedef short bf16x8 __attribute__((ext_vector_type(8)));
typedef float f32x4 __attribute__((ext_vector_type(4)));
typedef float f32x2 __attribute__((ext_vector_type(2)));
typedef unsigned u32x4 __attribute__((ext_vector_type(4)));
typedef unsigned u32x2 __attribute__((ext_vector_type(2)));

constexpr int DM = 2048, NB = 4, SEQ = 4096, MTOK = NB * SEQ;
constexpr int NMEM = 256;
constexpr int CH = 64, NCH = SEQ / CH;
constexpr int IN_TOTAL = 9264;
constexpr int NEXP = 32, DEXP = 512;
constexpr int NTHR = 512, NWG = 256;
constexpr float EPS = 1e-6f;
constexpr int O_GQ = 0, O_GK = 512, O_GV = 1024, O_GG = 2048, O_LRF = 3072, O_LRB = 3088, O_MX = 3104, O_MZ = 4128, O_MG = 5152, O_GA = 5168, O_GB = 7216;
constexpr int WIN_ROWS = 9472;

constexpr size_t MiB = 1u << 20;
constexpr size_t WS_CTL = 0;
constexpr size_t WS_WA = 1 * MiB;
constexpr size_t WS_WB = 5 * MiB;
constexpr size_t WS_WMIX = 9 * MiB;
constexpr size_t WS_WXQ = 17 * MiB;
constexpr size_t WS_WXKV = 25 * MiB;
constexpr size_t WS_WXO = 41 * MiB;
constexpr size_t WS_WMQK = 49 * MiB;
constexpr size_t WS_WMV = 50 * MiB;
constexpr size_t WS_WR = 51 * MiB;
constexpr size_t WS_SMALL = 52 * MiB;
constexpr size_t WS_MSC = 55 * MiB;
constexpr size_t WS_MCH = 57 * MiB;
constexpr size_t WS_GDEC = 58 * MiB;
constexpr size_t WS_SS1 = 59 * MiB;
constexpr size_t WS_SS2 = 61 * MiB;
constexpr size_t WS_MEMN = 63 * MiB;
constexpr size_t WS_KMEM = 67 * MiB;
constexpr size_t WS_VTMEM = 71 * MiB;
constexpr size_t WS_LOGIT = 75 * MiB;
constexpr size_t WS_ROUTE = 79 * MiB;
constexpr size_t WS_GG = 80 * MiB, WS_MZ = 112 * MiB, WS_GA = 144 * MiB, WS_GB = 208 * MiB;
constexpr size_t WS_QF = 272 * MiB, WS_QB = 288 * MiB, WS_KF = 304 * MiB, WS_KB = 320 * MiB;
constexpr size_t WS_KTF = 336 * MiB, WS_KTB = 352 * MiB, WS_VTG = 368 * MiB;
constexpr size_t WS_QM = 400 * MiB, WS_KM = 432 * MiB, WS_KMT = 464 * MiB, WS_VMT = 496 * MiB;
constexpr size_t WS_GQ = 528 * MiB, WS_GK = 544 * MiB, WS_KTG = 560 * MiB, WS_MX = 576 * MiB, WS_XC = 608 * MiB;
constexpr size_t WS_WIN = 400 * MiB;
constexpr size_t WS_XN = 440 * MiB;
constexpr size_t WS_YA = 272 * MiB, WS_YB = 304 * MiB;
constexpr size_t WS_MERGED = 336 * MiB;
constexpr size_t WS_ATTQ = 80 * MiB;
constexpr size_t WS_H = 80 * MiB;
constexpr size_t WS_SC = 144 * MiB;
constexpr size_t WS_P = 208 * MiB;
constexpr size_t WS_WKT = 400 * MiB;
constexpr size_t WS_VWT = 416 * MiB;
constexpr size_t WS_ATTO = 336 * MiB;
constexpr size_t WS_WGU = 528 * MiB;
constexpr size_t WS_WD = 592 * MiB;
constexpr size_t WS_XROWS = 272 * MiB;
constexpr size_t WS_HID = 440 * MiB;
constexpr size_t WS_YROWS = 272 * MiB;
constexpr size_t WS_PREP = 656 * MiB;
constexpr size_t WS_PRET = 672 * MiB;
constexpr size_t WS_PRES = 674 * MiB;
constexpr size_t WS_WIN8 = 272 * MiB;
constexpr int PX = 2048 + 128;
constexpr int P8 = 2048 + 128;
constexpr size_t WS_XN8 = 304 * MiB;
constexpr int MAXROWS = 40960;
constexpr int RT_TOKE = 0;
constexpr int RT_TOKI = 32768;
constexpr int RT_TOKW = 65536;
constexpr int RT_ROWRS = 98304;
constexpr int RT_ROWW = 98304 + MAXROWS;
constexpr int RT_TOKRS = 98304 + 2 * MAXROWS;
constexpr int CW_CNT = 1024;

struct Params {
    const float* in[33];
    float* out;
    unsigned char* ws;
};

DI float bf2f(bf16_t v) { return __uint_as_float(((unsigned)v) << 16); }
DI bf16_t f2bf(float f) { unsigned u = __float_as_uint(f); return (bf16_t)((u + 0x7fffu + ((u >> 16) & 1u)) >> 16); }
DI unsigned pk2(float lo, float hi) { return (unsigned)f2bf(lo) | ((unsigned)f2bf(hi) << 16); }
DI float frcp(float x) { return __builtin_amdgcn_rcpf(x); }
DI float sigmoidf_(float x) { return frcp(1.f + __expf(-x)); }
DI float siluf_(float x) { return x * frcp(1.f + __expf(-x)); }
DI float logsigmoidf_(float z) { return fminf(z, 0.f) - __logf(1.f + __expf(-fabsf(z))); }
DI float wave_sum(float v) {
#pragma unroll
    for (int o = 1; o < 64; o <<= 1) v += __shfl_xor(v, o);
    return v;
}
#define WSP(T, off) ((T*)(P.ws + (off)))

DI unsigned pk4_f8(float a, float b, float c, float d) { unsigned p = 0; p = __builtin_amdgcn_cvt_pk_fp8_f32(a, b, p, false); p = __builtin_amdgcn_cvt_pk_fp8_f32(c, d, p, true); return p; }
template <int F8 = 0>
DI void tr_item(const float* W, int ldw, int K, int ncols, bf16_t* dst, float* scr, int item, int lane, int dp) {
    const int nblk = (ncols + 31) / 32, kb = item / nblk, nb = item % nblk, k0 = 64 * kb, n0 = 32 * nb;
    const bool nok = (n0 + (lane & 31)) < ncols;
    float tv[32];
#pragma unroll
    for (int i = 0; i < 32; ++i) { const int kk = 2 * i + (lane >> 5); tv[i] = nok ? W[(size_t)(k0 + kk) * ldw + n0 + (lane & 31)] : 0.f; }
#pragma unroll
    for (int i = 0; i < 32; ++i) { const int kk = 2 * i + (lane >> 5); scr[kk * 33 + (lane & 31)] = tv[i]; }
    asm volatile("s_waitcnt lgkmcnt(0)" ::: "memory");
    const int c = lane & 7;
#pragma unroll
    for (int j = 0; j < 4; ++j) { const int n = (lane >> 3) + 8 * j; const float* s = scr + (8 * c) * 33 + n;
        if (F8 > 0) { constexpr float SC = (float)(F8 > 0 ? F8 : 1); u32x2 o; o.x = pk4_f8(s[0] * SC, s[33] * SC, s[66] * SC, s[99] * SC); o.y = pk4_f8(s[132] * SC, s[165] * SC, s[198] * SC, s[231] * SC);
            if (n0 + n < ncols) *(u32x2*)((unsigned char*)dst + (size_t)(n0 + n) * dp + k0 + 8 * c) = o; }
        else { u32x4 o; o.x = pk2(s[0], s[33]); o.y = pk2(s[66], s[99]); o.z = pk2(s[132], s[165]); o.w = pk2(s[198], s[231]);
            if (n0 + n < ncols) *(u32x4*)(dst + (size_t)(n0 + n) * dp + k0 + 8 * c) = o; } }
    asm volatile("s_waitcnt lgkmcnt(0)" ::: "memory");
}
struct SegRun { int gw, ngw, off; float* scr; int lane; };
template <int F8 = 0>
DI void tr_seg(SegRun& R, const float* W, int ldw, int K, int ncols, bf16_t* dst, int dp = 0) {
    const int nitems = (K / 64) * ((ncols + 31) / 32);
    int first = (R.gw - (R.off % R.ngw) + R.ngw) % R.ngw;
    for (int it = first; it < nitems; it += R.ngw) tr_item<F8>(W, ldw, K, ncols, dst, R.scr, it, R.lane, dp ? dp : K);
    R.off += nitems;
}
DI void rms_row_bf16(const float* xrow, const float* g, bf16_t* orow, int lane) {
    f32x4 v[8]; float s = 0.f;
#pragma unroll
    for (int j = 0; j < 8; ++j) { v[j] = *(const f32x4*)(xrow + 256 * j + 4 * lane); s += v[j].x * v[j].x + v[j].y * v[j].y + v[j].z * v[j].z + v[j].w * v[j].w; }
    const float rstd = rsqrtf(wave_sum(s) * (1.f / DM) + EPS);
#pragma unroll
    for (int j = 0; j < 8; ++j) { const f32x4 gg = *(const f32x4*)(g + 256 * j + 4 * lane);
        u32x2 o; o.x = pk2(v[j].x * rstd * gg.x, v[j].y * rstd * gg.y); o.y = pk2(v[j].z * rstd * gg.z, v[j].w * rstd * gg.w);
        *(u32x2*)(orow + 256 * j + 4 * lane) = o; }
}
enum { I_X = 0, I_MEM, I_NMIX, I_WIN, I_LRWF, I_LRBF, I_LRWB, I_LRBB, I_GNORM, I_CONVW, I_CONVB, I_MWQ, I_MWK, I_MWV, I_MGB, I_MNORM, I_WBA, I_WBB, I_WMIX,
       I_NXA, I_NMEM, I_WXQ, I_WXKV, I_WXO, I_NFFN, I_WGRP, I_BGRP, I_WRT, I_BRT, I_WGATE, I_WUP, I_WDOWN, I_NFIN };

DI void p0_prologue(const Params& P, float* lds, int bid, int nb, int part) {
    const int tid = threadIdx.x, lane = tid & 63, wave = tid >> 6;
    SegRun R; R.gw = bid * 8 + wave; R.ngw = nb * 8; R.off = 0; R.scr = lds + wave * (64 * 33); R.lane = lane;
    if (part == 0) {
        bf16_t* win = WSP(bf16_t, WS_WIN); const float* w = P.in[I_WIN];
        tr_seg(R, w + O_GQ, IN_TOTAL, DM, 512, win + (size_t)0 * PX, PX);
        tr_seg(R, w + O_GK, IN_TOTAL, DM, 512, win + (size_t)512 * PX, PX);
        tr_seg(R, w + O_GV, IN_TOTAL, DM, 1024, win + (size_t)1024 * PX, PX);
        tr_seg<64>(R, w + O_GG, IN_TOTAL, DM, 1024, (bf16_t*)(WSP(unsigned char, WS_WIN8) + (size_t)2048 * P8), P8);
        tr_seg(R, w + O_MX, IN_TOTAL, DM, 1024, win + (size_t)3072 * PX, PX);
        tr_seg<64>(R, w + O_MZ, IN_TOTAL, DM, 1024, (bf16_t*)(WSP(unsigned char, WS_WIN8) + (size_t)4096 * P8), P8);
        tr_seg<64>(R, w + O_GA, IN_TOTAL, DM, 2048, (bf16_t*)(WSP(unsigned char, WS_WIN8) + (size_t)5120 * P8), P8);
        tr_seg<64>(R, w + O_GB, IN_TOTAL, DM, 2048, (bf16_t*)(WSP(unsigned char, WS_WIN8) + (size_t)7168 * P8), P8);
        tr_seg(R, w + O_LRF, IN_TOTAL, DM, 16, win + (size_t)9216 * PX, PX);
        tr_seg(R, w + O_LRB, IN_TOTAL, DM, 16, win + (size_t)9232 * PX, PX);
        tr_seg(R, w + O_MG, IN_TOTAL, DM, 16, win + (size_t)9248 * PX, PX);
        tr_seg(R, P.in[I_WXKV], 2 * DM, DM, 2 * DM, WSP(bf16_t, WS_WXKV));
        for (int h = 0; h < 4; ++h) {
            tr_seg(R, P.in[I_MWQ] + (size_t)h * 65536, 256, 256, 256, WSP(bf16_t, WS_WMQK) + (size_t)h * 512 * 256);
            tr_seg(R, P.in[I_MWK] + (size_t)h * 65536, 256, 256, 256, WSP(bf16_t, WS_WMQK) + (size_t)h * 512 * 256 + 256 * 256);
            tr_seg(R, P.in[I_MWV] + (size_t)h * 65536, 256, 256, 256, WSP(bf16_t, WS_WMV) + (size_t)h * 256 * 256);
        }
        {
            const float* g = P.in[I_NMIX]; f32x4 gg[8];
#pragma unroll
            for (int j = 0; j < 8; ++j) gg[j] = *(const f32x4*)(g + 512 * (j >> 1) + 8 * lane + 4 * (j & 1));
            for (int m = R.gw; m < MTOK; m += 2 * R.ngw) {
                const int m1 = m + R.ngw; const bool has1 = m1 < MTOK;
                const float* x0 = P.in[I_X] + (size_t)m * DM; const float* x1 = P.in[I_X] + (size_t)(has1 ? m1 : m) * DM;
                f32x4 v0[8], v1[8]; float s0 = 0.f, s1 = 0.f;
#pragma unroll
                for (int j = 0; j < 8; ++j) { v0[j] = *(const f32x4*)(x0 + 512 * (j >> 1) + 8 * lane + 4 * (j & 1)); v1[j] = *(const f32x4*)(x1 + 512 * (j >> 1) + 8 * lane + 4 * (j & 1)); }
#pragma unroll
                for (int j = 0; j < 8; ++j) { s0 += v0[j].x * v0[j].x + v0[j].y * v0[j].y + v0[j].z * v0[j].z + v0[j].w * v0[j].w; s1 += v1[j].x * v1[j].x + v1[j].y * v1[j].y + v1[j].z * v1[j].z + v1[j].w * v1[j].w; }
                const float r0 = rsqrtf(wave_sum(s0) * (1.f / DM) + EPS), r1 = rsqrtf(wave_sum(s1) * (1.f / DM) + EPS);
                bf16_t* o0 = WSP(bf16_t, WS_XN) + (size_t)m * PX; bf16_t* o1 = WSP(bf16_t, WS_XN) + (size_t)m1 * PX;
#pragma unroll
                for (int j = 0; j < 4; ++j) {
                    const f32x4 a = v0[2 * j] * r0 * gg[2 * j], b = v0[2 * j + 1] * r0 * gg[2 * j + 1];
                    u32x4 o; o.x = pk2(a.x, a.y); o.y = pk2(a.z, a.w); o.z = pk2(b.x, b.y); o.w = pk2(b.z, b.w); *(u32x4*)(o0 + 512 * j + 8 * lane) = o;
                    u32x2 e; e.x = pk4_f8(a.x, a.y, a.z, a.w); e.y = pk4_f8(b.x, b.y, b.z, b.w); *(u32x2*)(WSP(unsigned char, WS_XN8) + (size_t)m * P8 + 512 * j + 8 * lane) = e;
                    if (has1) { const f32x4 c = v1[2 * j] * r1 * gg[2 * j], d = v1[2 * j + 1] * r1 * gg[2 * j + 1];
                        u32x4 q; q.x = pk2(c.x, c.y); q.y = pk2(c.z, c.w); q.z = pk2(d.x, d.y); q.w = pk2(d.z, d.w); *(u32x4*)(o1 + 512 * j + 8 * lane) = q;
                        u32x2 f; f.x = pk4_f8(c.x, c.y, c.z, c.w); f.y = pk4_f8(d.x, d.y, d.z, d.w); *(u32x2*)(WSP(unsigned char, WS_XN8) + (size_t)m1 * P8 + 512 * j + 8 * lane) = f; } }
            }
        }
        for (int m = R.gw; m < NB * NMEM; m += R.ngw) rms_row_bf16(P.in[I_MEM] + (size_t)m * DM, P.in[I_NMEM], WSP(bf16_t, WS_MEMN) + (size_t)m * DM, lane);
    } else if (part == 1) {
        tr_seg(R, P.in[I_WBA], DM, 1024, DM, WSP(bf16_t, WS_WA));
        tr_seg(R, P.in[I_WBB], DM, 1024, DM, WSP(bf16_t, WS_WB));
        tr_seg<64>(R, P.in[I_WMIX], DM, DM, DM, WSP(bf16_t, WS_WMIX), P8);
        { const int gt = bid * NTHR + tid, ngt = nb * NTHR; const float* s = P.in[I_WXQ]; bf16_t* d = WSP(bf16_t, WS_WXQ);
          for (int i = gt; i < DM * DM / 8; i += ngt) { const f32x4 a = *(const f32x4*)(s + (size_t)i * 8), c = *(const f32x4*)(s + (size_t)i * 8 + 4);
              u32x4 o; o.x = pk2(a.x, a.y); o.y = pk2(a.z, a.w); o.z = pk2(c.x, c.y); o.w = pk2(c.z, c.w); *(u32x4*)(d + (size_t)i * 8) = o; } }
        tr_seg(R, P.in[I_WXO], DM, DM, DM, WSP(bf16_t, WS_WXO));
        for (int g = 0; g < 4; ++g) tr_seg(R, P.in[I_WRT] + (size_t)g * DM * 8, 8, DM, 8, WSP(bf16_t, WS_WR) + (size_t)(g * 8) * DM);
        tr_seg(R, P.in[I_WGRP], 4, DM, 4, WSP(bf16_t, WS_WR) + (size_t)32 * DM);
        { const int gt = bid * NTHR + tid, ngt = nb * NTHR; u32x4 z = {0u, 0u, 0u, 0u};
          u32x4* p2 = (u32x4*)(WSP(bf16_t, WS_WR) + (size_t)36 * DM); for (int i = gt; i < 220 * DM / 8; i += ngt) p2[i] = z; }
        for (int e = 0; e < NEXP; ++e) {
            const float* wg = P.in[I_WGATE] + (size_t)e * DM * DEXP; const float* wu = P.in[I_WUP] + (size_t)e * DM * DEXP;
            unsigned char* d = WSP(unsigned char, WS_WGU) + (size_t)e * 1024 * DM;
            for (int pn = 0; pn < 4; ++pn) {
                tr_seg<64>(R, wg + pn * 128, DEXP, DM, 128, (bf16_t*)(d + (size_t)(pn * 256) * DM));
                tr_seg<64>(R, wu + pn * 128, DEXP, DM, 128, (bf16_t*)(d + (size_t)(pn * 256 + 128) * DM));
            }
        }
    } else {
        for (int e = 0; e < NEXP; ++e) tr_seg<32>(R, P.in[I_WDOWN] + (size_t)e * DEXP * DM, DM, DEXP, DM, (bf16_t*)(WSP(unsigned char, WS_WD) + (size_t)e * DM * DEXP));
    }
}

struct Unit { const bf16_t* A; const bf16_t* B; int lda, ldb; int kind, pm, pn, aux; bool keep; };
typedef f32x4 Acc[2][2][4][2];
#define ACC_FOREACH(ai, bj, m, n) _Pragma("unroll") for (int ai = 0; ai < 2; ++ai) _Pragma("unroll") for (int bj = 0; bj < 2; ++bj) _Pragma("unroll") for (int m = 0; m < 4; ++m) _Pragma("unroll") for (int n = 0; n < 2; ++n)
#define ACC_ROW(ai, m) ((ai) * 128 + wr * 64 + (m) * 16 + fr)
#define ACC_COL(bj, n) ((bj) * 128 + wc * 32 + (n) * 16 + fq * 4)

constexpr int SG_BK = 32, SG_LD = 40;
template <class Sched, class Epi>
DI void gemm_simple(float* ldsf, int K, const Sched& S, const Epi& E) {
    bf16_t* sA = (bf16_t*)ldsf; bf16_t* sB = sA + 256 * SG_LD;
    const int tid = threadIdx.x, wid = tid >> 6, lane = tid & 63, wr = wid >> 2, wc = wid & 3, fr = lane & 15, fq = lane >> 4;
    Acc acc;
    ACC_FOREACH(ai, bj, m, n) acc[ai][bj][m][n] = (f32x4){0.f, 0.f, 0.f, 0.f};
    Unit u;
    for (int ui = 0; S.next(ui, u); ++ui) {
        for (int k0 = 0; k0 < K; k0 += SG_BK) {
#pragma unroll
            for (int i = 0; i < 2; ++i) { const int p = tid + i * 512, r = p >> 2, c = (p & 3) * 8;
                const u32x4 va = *(const u32x4*)(u.A + (size_t)r * u.lda + k0 + c);
                const u32x4 vb = *(const u32x4*)(u.B + (size_t)r * u.ldb + k0 + c);
                *(u32x4*)(sA + r * SG_LD + c) = va; *(u32x4*)(sB + r * SG_LD + c) = vb; }
            __syncthreads();
            bf16x8 af[2][4], bfr[2][2];
#pragma unroll
            for (int ai = 0; ai < 2; ++ai)
#pragma unroll
                for (int m = 0; m < 4; ++m) af[ai][m] = *(const bf16x8*)(sA + (ai * 128 + wr * 64 + m * 16 + fr) * SG_LD + fq * 8);
#pragma unroll
            for (int bj = 0; bj < 2; ++bj)
#pragma unroll
                for (int n = 0; n < 2; ++n) bfr[bj][n] = *(const bf16x8*)(sB + (bj * 128 + wc * 32 + n * 16 + fr) * SG_LD + fq * 8);
            ACC_FOREACH(ai, bj, m, n) acc[ai][bj][m][n] = __builtin_amdgcn_mfma_f32_16x16x32_bf16(bfr[bj][n], af[ai][m], acc[ai][bj][m][n], 0, 0, 0);
            __syncthreads();
        }
        E(acc, u, wr, wc, fr, fq);
        if (!u.keep) { ACC_FOREACH(ai, bj, m, n) acc[ai][bj][m][n] = (f32x4){0.f, 0.f, 0.f, 0.f}; }
    }
}
#define LAS __attribute__((address_space(3)))
namespace pg8 {
constexpr int BK = 64, HALF = 128, HTB = HALF * BK * 2, STAGE_BYTES = 8 * HTB;
DI int lds_byte(int r, int c) { return (r >> 3) * 1024 + (r & 7) * 128 + ((((c >> 3) ^ (r >> 1)) & 7) << 4) + (c & 7) * 2; }
DI void stage_rc(int b, int& R, int& C) { const int slot = (b & 1023) >> 4; R = (b >> 10) * 8 + (slot >> 3); C = ((slot ^ (R >> 1)) & 7) * 8; }
typedef int v4i_t __attribute__((ext_vector_type(4)));
typedef int v8i_t __attribute__((ext_vector_type(8)));
DI f32x4 mfma_f8(bf16x8 a0, bf16x8 a1, bf16x8 b0, bf16x8 b1, f32x4 c) {
    const v8i_t a = __builtin_shufflevector(__builtin_bit_cast(v4i_t, a0), __builtin_bit_cast(v4i_t, a1), 0, 1, 2, 3, 4, 5, 6, 7);
    const v8i_t b = __builtin_shufflevector(__builtin_bit_cast(v4i_t, b0), __builtin_bit_cast(v4i_t, b1), 0, 1, 2, 3, 4, 5, 6, 7);
    return __builtin_amdgcn_mfma_scale_f32_16x16x128_f8f6f4(a, b, c, 0, 0, 0, 0x7F7F7F7F, 0, 0x7F7F7F7F);
}
template <class Epi, class Sched, bool AFTER = false, bool FP8 = false>
DI void gemm_phase(LAS unsigned char* lds, const int K, const int lda, const int ldb, const Sched& S, const Epi& E) {
    const int tid = threadIdx.x, wid = __builtin_amdgcn_readfirstlane(tid >> 6), lane = tid & 63, wr = wid >> 2, wc = wid & 3, fr = lane & 15, fq = lane >> 4;
    int Kop = K; asm volatile("" : "+s"(Kop));
    constexpr int ESZ = FP8 ? 1 : 2;
    const int nt = Kop / (FP8 ? 2 * BK : BK);
    unsigned voffA[2], voffB[2];
#pragma unroll
    for (int i = 0; i < 2; ++i) { int R, C; stage_rc(tid * 16 + i * 8192, R, C); voffA[i] = (unsigned)(R * lda * ESZ + C * 2); voffB[i] = (unsigned)(R * ldb * ESZ + C * 2); }
    const size_t kstep = (size_t)(BK * 2);
    const size_t hstepA = (size_t)HALF * lda * ESZ, hstepB = (size_t)HALF * ldb * ESZ;
    const unsigned ldsw = (unsigned)wid * 1024u;
    const int aoff = lds_byte(wr * 64 + fr, fq * 8), boff = lds_byte(wc * 32 + fr, fq * 8), aoff1 = lds_byte(wr * 64 + fr, 32 + fq * 8), boff1 = lds_byte(wc * 32 + fr, 32 + fq * 8);
#define PG8_SA(b, h) (((b) * 2 + (h)) * HTB)
#define PG8_SB(b, h) ((4 + (b) * 2 + (h)) * HTB)
#define PG8_STAGE(bufoff, gbase, voff) do { _Pragma("unroll") for (int _i = 0; _i < 2; ++_i) \
        __builtin_amdgcn_global_load_lds((const unsigned*)((const char*)(gbase) + (voff)[_i]), (LAS unsigned*)(lds + (bufoff) + ldsw + _i * 8192), 16, 0, 0); } while (0)
#define PG8_CAT(p, q) __builtin_shufflevector(__builtin_bit_cast(v4i_t, *(const LAS bf16x8*)(p)), __builtin_bit_cast(v4i_t, *(const LAS bf16x8*)(q)), 0, 1, 2, 3, 4, 5, 6, 7)
#define PG8_LDA(dst, b, h) do { if constexpr (FP8) { _Pragma("unroll") for (int m = 0; m < 4; ++m) dst##8[m] = PG8_CAT(lds + PG8_SA(b, h) + aoff + m * 2048, lds + PG8_SA(b, h) + aoff1 + m * 2048); } \
        else { _Pragma("unroll") for (int m = 0; m < 4; ++m) _Pragma("unroll") for (int k = 0; k < 2; ++k) dst[m][k] = *(const LAS bf16x8*)(lds + PG8_SA(b, h) + (k ? aoff1 : aoff) + m * 2048); } } while (0)
#define PG8_LDB(dst, b, h) do { if constexpr (FP8) { _Pragma("unroll") for (int n = 0; n < 2; ++n) dst##8[n] = PG8_CAT(lds + PG8_SB(b, h) + boff + n * 2048, lds + PG8_SB(b, h) + boff1 + n * 2048); } \
        else { _Pragma("unroll") for (int n = 0; n < 2; ++n) _Pragma("unroll") for (int k = 0; k < 2; ++k) dst[n][k] = *(const LAS bf16x8*)(lds + PG8_SB(b, h) + (k ? boff1 : boff) + n * 2048); } } while (0)
#define PG8_MMA(ai, bj, At, Bt) do { __builtin_amdgcn_s_setprio(1); _Pragma("unroll") for (int m = 0; m < 4; ++m) _Pragma("unroll") for (int n = 0; n < 2; ++n) { \
        if constexpr (FP8) asm volatile("v_mfma_scale_f32_16x16x128_f8f6f4 %0, %1, %2, %0, %3, %3 op_sel_hi:[0,0,0]" : "+v"(acc[ai][bj][m][n]) : "v"(Bt##8[n]), "v"(At##8[m]), "v"(f8scale)); \
        else { _Pragma("unroll") for (int k = 0; k < 2; ++k) acc[ai][bj][m][n] = __builtin_amdgcn_mfma_f32_16x16x32_bf16(Bt[n][k], At[m][k], acc[ai][bj][m][n], 0, 0, 0); } } \
        __builtin_amdgcn_s_setprio(0); } while (0)
#define PG8_WAIT_V(n) asm volatile("s_waitcnt vmcnt(" #n ")" ::: "memory")
#define PG8_WAIT_L(n) asm volatile("s_waitcnt lgkmcnt(" #n ")" ::: "memory")
#define PG8_BAR __builtin_amdgcn_s_barrier()
#define PG8_SCHED __builtin_amdgcn_sched_barrier(0)
    Unit cur, nxt; int ui = 0;
    if (!S.next(0, cur)) return;
    Acc acc;
    ACC_FOREACH(a_, b_, m_, n_) acc[a_][b_][m_][n_] = (f32x4){0.f, 0.f, 0.f, 0.f};
    const unsigned f8scale = 0x7F7F7F7Fu;
    bf16x8 At[FP8 ? 1 : 4][2], B0[FP8 ? 1 : 2][2], B1[FP8 ? 1 : 2][2];
    v8i_t At8[FP8 ? 4 : 1], B08[FP8 ? 2 : 1], B18[FP8 ? 2 : 1];
    const char* cA = (const char*)cur.A; const char* cB = (const char*)cur.B;
    PG8_STAGE(PG8_SB(0, 0), cB, voffB); PG8_STAGE(PG8_SB(0, 1), cB + hstepB, voffB); PG8_STAGE(PG8_SA(0, 0), cA, voffA); PG8_STAGE(PG8_SA(0, 1), cA + hstepA, voffA);
    if (wr == 1) PG8_BAR;
    PG8_WAIT_V(2); PG8_BAR;
    PG8_STAGE(PG8_SB(1, 0), cB + kstep, voffB); PG8_STAGE(PG8_SA(1, 0), cA + kstep, voffA); PG8_STAGE(PG8_SB(1, 1), cB + hstepB + kstep, voffB);
    PG8_WAIT_V(6); PG8_BAR;
    for (;;) {
        const bool has_next = S.next(ui + 1, nxt);
        const char* nA = has_next ? (const char*)nxt.A : cA; const char* nB = has_next ? (const char*)nxt.B : cB;
        for (int t = 0; t < nt; t += 2) {
            const bool last = (t == nt - 2);
            const char* a1 = cA + (size_t)(t + 1) * kstep;
            const char* a2 = last ? nA : cA + (size_t)(t + 2) * kstep; const char* b2 = last ? nB : cB + (size_t)(t + 2) * kstep;
            const char* a3 = a2 + kstep; const char* b3 = b2 + kstep;
            PG8_LDB(B0, 0, 0); PG8_LDB(B1, 0, 1); PG8_SCHED; PG8_LDA(At, 0, 0); PG8_STAGE(PG8_SA(1, 1), a1 + hstepA, voffA);
            PG8_WAIT_V(8); PG8_WAIT_L(0); PG8_BAR; PG8_MMA(0, 0, At, B0); PG8_MMA(0, 1, At, B1); PG8_BAR; PG8_SCHED;
            PG8_LDA(At, 0, 1); PG8_STAGE(PG8_SB(0, 0), b2, voffB); PG8_STAGE(PG8_SB(0, 1), b2 + hstepB, voffB); PG8_STAGE(PG8_SA(0, 0), a2, voffA);
            PG8_WAIT_V(8); PG8_WAIT_L(0); PG8_BAR; PG8_MMA(1, 0, At, B0); PG8_MMA(1, 1, At, B1); PG8_BAR; PG8_SCHED;
            PG8_LDB(B0, 1, 0); PG8_LDB(B1, 1, 1); PG8_SCHED; PG8_LDA(At, 1, 0); PG8_STAGE(PG8_SA(0, 1), a2 + hstepA, voffA);
            PG8_WAIT_V(8); PG8_WAIT_L(0); PG8_BAR; PG8_MMA(0, 0, At, B0); PG8_MMA(0, 1, At, B1); PG8_BAR; PG8_SCHED;
            PG8_LDA(At, 1, 1); PG8_STAGE(PG8_SB(1, 0), b3, voffB); PG8_STAGE(PG8_SB(1, 1), b3 + hstepB, voffB); PG8_STAGE(PG8_SA(1, 0), a3, voffA);
            PG8_WAIT_V(8); PG8_WAIT_L(0); PG8_BAR; PG8_MMA(1, 0, At, B0); PG8_MMA(1, 1, At, B1); PG8_BAR; PG8_SCHED;
        }
        if (wr == 0) PG8_BAR;
        if constexpr (FP8) asm volatile("s_nop 15\n\ts_nop 15" ::: "memory");
        if constexpr (!AFTER) E(acc, cur, wr, wc, fr, fq);
        if (!has_next) break;
        if (!cur.keep) { ACC_FOREACH(a_, b_, m_, n_) acc[a_][b_][m_][n_] = (f32x4){0.f, 0.f, 0.f, 0.f}; }
        cur = nxt; cA = nA; cB = nB; ++ui;
        if (wr == 1) PG8_BAR;
    }
    PG8_WAIT_V(0);
    PG8_BAR;
    if constexpr (AFTER) { if constexpr (FP8) asm volatile("s_nop 15\n\ts_nop 15" ::: "memory"); E.fused(acc, cur, wr, wc, fr, fq, lds); }
#undef PG8_SA
#undef PG8_SB
#undef PG8_STAGE
#undef PG8_LDA
#undef PG8_CAT
#undef PG8_LDB
#undef PG8_MMA
#undef PG8_WAIT_V
#undef PG8_WAIT_L
#undef PG8_BAR
#undef PG8_SCHED
}
}
#ifndef USE_ENGINE
#define USE_ENGINE 1
#endif
template <class Sched, class Epi>
DI void gemm_run(float* ldsf, int K, int lda, int ldb, const Sched& S, const Epi& E) {
#if USE_ENGINE
    pg8::gemm_phase<Epi, Sched>((LAS unsigned char*)ldsf, K, lda, ldb, S, E);
#else
    gemm_simple(ldsf, K, S, E);
#endif
}
DI void st_bf4(bf16_t* p, f32x4 v) { u32x2 o; o.x = pk2(v.x, v.y); o.y = pk2(v.z, v.w); *(u32x2*)p = o; }
DI void st_f8x8(unsigned char* p, f32x4 a0, f32x4 a1);
#define ACC_COLW(bj) ((bj) * 128 + wc * 32 + (fq & 1) * 16 + (fq >> 1) * 8)
#define ACC_FOREACH3(ai, bj, m) _Pragma("unroll") for (int ai = 0; ai < 2; ++ai) _Pragma("unroll") for (int bj = 0; bj < 2; ++bj) _Pragma("unroll") for (int m = 0; m < 4; ++m)
DI void st_bf8(bf16_t* p, f32x4 a0, f32x4 a1) {
    const unsigned x0 = pk2(a0.x, a0.y), x1 = pk2(a0.z, a0.w), y0 = pk2(a1.x, a1.y), y1 = pk2(a1.z, a1.w);
    const auto r0 = __builtin_amdgcn_permlane16_swap(x0, y0, false, false); const auto r1 = __builtin_amdgcn_permlane16_swap(x1, y1, false, false);
    u32x4 o; o.x = r0[0]; o.y = r1[0]; o.z = r0[1]; o.w = r1[1]; __builtin_nontemporal_store(o, (u32x4*)p);
}
DI void ld_bf8(const bf16_t* p, u32x2& n0, u32x2& n1) {
    const u32x4 L = *(const u32x4*)p; const auto r0 = __builtin_amdgcn_permlane16_swap(L.x, L.z, false, false); const auto r1 = __builtin_amdgcn_permlane16_swap(L.y, L.w, false, false);
    n0.x = r0[0]; n0.y = r1[0]; n1.x = r0[1]; n1.y = r1[1];
}
DI void st_f8x8(unsigned char* p, f32x4 a0, f32x4 a1) {
    const auto r = __builtin_amdgcn_permlane16_swap(pk4_f8(a0.x, a0.y, a0.z, a0.w), pk4_f8(a1.x, a1.y, a1.z, a1.w), false, false);
    u32x2 o; o.x = r[0]; o.y = r[1]; *(u32x2*)p = o;
}

struct SchedP1 {
    const Params* P; int bid, nb;
    DI bool next(int i, Unit& u) const {
        const int L = i * nb + bid; if (L >= 768) return false;
        const bf16_t* xn = (const bf16_t*)(P->ws + WS_XN); const bf16_t* win = (const bf16_t*)(P->ws + WS_WIN);
        u.lda = PX; u.ldb = PX; u.keep = false; u.aux = 0;
        if (L < 512) { int t = L / 64; u.pm = L % 64; u.pn = t < 4 ? t : t + 8; u.kind = 0;
            u.A = xn + (size_t)u.pm * 256 * PX; u.B = win + (size_t)u.pn * 256 * PX; }
        else { const int l = L - 512; u.pn = 4 + l / 64; u.pm = l % 64; u.kind = 1;
            u.A = win + (size_t)u.pn * 256 * PX; u.B = xn + (size_t)u.pm * 256 * PX; }
        return true;
    }
};
struct SchedP1g {
    const Params* P; int bid, nb;
    DI bool next(int i, Unit& u) const {
        const int L = i * nb + bid; if (L >= 1536) return false;
        const int t = L / 64; u.pm = L % 64; u.pn = t < 4 ? 8 + t : 12 + t; u.kind = 0; u.lda = P8; u.ldb = P8; u.keep = false; u.aux = 1;
        u.A = (const bf16_t*)(P->ws + WS_XN8 + (size_t)u.pm * 256 * P8); u.B = (const bf16_t*)(P->ws + WS_WIN8 + (size_t)u.pn * 256 * P8);
        return true;
    }
};
struct SchedKV {
    const Params* P; int l;
    DI bool next(int i, Unit& u) const {
        if (i > 0 || l >= 64) return false;
        u.lda = DM; u.ldb = DM; u.keep = false; u.aux = 0; u.pm = l / 16; u.pn = l % 16;
        const bf16_t* mn = (const bf16_t*)(P->ws + WS_MEMN); const bf16_t* wkv = (const bf16_t*)(P->ws + WS_WXKV);
        u.kind = u.pn < 8 ? 2 : 3; u.A = mn + (size_t)u.pm * 256 * DM; u.B = wkv + (size_t)u.pn * 256 * DM;
        return true;
    }
};
struct EpiP1 {
    const Params* Pp;
    DI void operator()(Acc& acc, const Unit& u, int wr, int wc, int fr, int fq) const {
        const Params& P = *Pp;
        bf16_t* dst; int ld; size_t base;
        if (u.kind == 0) {
            const int pn = u.pn;
            if (pn == 36) {
                float* sm = WSP(float, WS_SMALL);
                ACC_FOREACH(ai, bj, m, n) { const int c = ACC_COL(bj, n); if (c < 48) *(f32x4*)(sm + (size_t)(u.pm * 256 + ACC_ROW(ai, m)) * 48 + c) = acc[ai][bj][m][n]; }
                return;
            }
            if (pn < 2) { dst = WSP(bf16_t, WS_GQ); ld = 512; base = (size_t)pn * 256; }
            else if (pn < 4) { dst = WSP(bf16_t, WS_GK); ld = 512; base = (size_t)(pn - 2) * 256; }
            else if (pn < 12) { dst = WSP(bf16_t, WS_GG); ld = 1024; base = (size_t)(pn - 8) * 256; }
            else if (pn < 16) { dst = WSP(bf16_t, WS_MX); ld = 1024; base = (size_t)(pn - 12) * 256; }
            else if (pn < 20) { dst = WSP(bf16_t, WS_MZ); ld = 1024; base = (size_t)(pn - 16) * 256; }
            else if (pn < 28) { dst = WSP(bf16_t, WS_GA); ld = 2048; base = (size_t)(pn - 20) * 256; }
            else { dst = WSP(bf16_t, WS_GB); ld = 2048; base = (size_t)(pn - 28) * 256; }
            base += (size_t)u.pm * 256 * ld;
        } else if (u.kind == 1) {
            if (u.pn < 4) { dst = WSP(bf16_t, WS_KTG); base = (size_t)(u.pn - 2) * 256 * MTOK; } else { dst = WSP(bf16_t, WS_VTG); base = (size_t)(u.pn - 4) * 256 * MTOK; }
            ld = MTOK; base += (size_t)u.pm * 256;
        } else if (u.kind == 2) { dst = WSP(bf16_t, WS_KMEM); ld = DM; base = (size_t)u.pm * 256 * DM + (size_t)u.pn * 256; }
        else { dst = WSP(bf16_t, WS_VTMEM); ld = DM; base = (size_t)u.pm * 256 * DM + (size_t)(u.pn - 8) * 256; }
        const float sc = u.aux ? (1.f / 64.f) : 1.f;
        ACC_FOREACH3(ai, bj, m) st_bf8(dst + base + (size_t)ACC_ROW(ai, m) * ld + ACC_COLW(bj), acc[ai][bj][m][0] * sc, acc[ai][bj][m][1] * sc);
    }
};

DI float wave_incl_scan_add(float v, int lane) {
#pragma unroll
    for (int o = 1; o < 64; o <<= 1) { const float t = __shfl_up(v, o); if (lane >= o) v += t; }
    return v;
}
DI float wave_incl_scan_max(float v, int lane) {
#pragma unroll
    for (int o = 1; o < 64; o <<= 1) { const float t = __shfl_up(v, o); if (lane >= o) v = fmaxf(v, t); }
    return v;
}
DI void p2_prep(const Params& P, float* lds, int bid, int nb) {
    float* lr = lds + 8 * 64 * 48;
    unsigned char* ktT = (unsigned char*)lds;
    float* wvs = lds + 16384;
    float* part = lds;
    for (int item = bid; item < NB * NCH; item += nb) {
        int tid = threadIdx.x; asm volatile("" : "+v"(tid));
        const int lane = tid & 63, wave = __builtin_amdgcn_readfirstlane(tid >> 6);
        const int b = item / NCH, c = item % NCH; const size_t m0 = (size_t)b * SEQ + (size_t)c * CH;
        __syncthreads();
        {
            const int c16 = lane & 15, kg = lane >> 4;
            const bf16_t* xa = WSP(bf16_t, WS_XN) + (m0 + c16) * PX + wave * 256 + 8 * kg;
            const bf16_t* wb = WSP(bf16_t, WS_WIN) + (size_t)(9216 + c16) * PX + wave * 256 + 8 * kg;
            f32x4 acc[4][3];
#pragma unroll
            for (int mt = 0; mt < 4; ++mt)
#pragma unroll
                for (int nt = 0; nt < 3; ++nt) acc[mt][nt] = (f32x4){0.f, 0.f, 0.f, 0.f};
#pragma unroll 2
            for (int k2 = 0; k2 < 4; ++k2) {
                bf16x8 fa[2][4], fb[2][3];
#pragma unroll
                for (int q = 0; q < 2; ++q) {
#pragma unroll
                    for (int mt = 0; mt < 4; ++mt) fa[q][mt] = *(const bf16x8*)(xa + (size_t)(16 * mt) * PX + (2 * k2 + q) * 32);
#pragma unroll
                    for (int nt = 0; nt < 3; ++nt) fb[q][nt] = *(const bf16x8*)(wb + (size_t)(16 * nt) * PX + (2 * k2 + q) * 32);
                }
#pragma unroll
                for (int q = 0; q < 2; ++q)
#pragma unroll
                    for (int mt = 0; mt < 4; ++mt)
#pragma unroll
                        for (int nt = 0; nt < 3; ++nt) acc[mt][nt] = __builtin_amdgcn_mfma_f32_16x16x32_bf16(fa[q][mt], fb[q][nt], acc[mt][nt], 0, 0, 0);
            }
#pragma unroll
            for (int mt = 0; mt < 4; ++mt)
#pragma unroll
                for (int nt = 0; nt < 3; ++nt)
#pragma unroll
                    for (int i = 0; i < 4; ++i) part[(wave * 64 + 16 * mt + 4 * kg + i) * 48 + 16 * nt + c16] = acc[mt][nt][i];
        }
        f32x4 wpre[4];
#pragma unroll
        for (int i = 0; i < 4; ++i) wpre[i] = ((const f32x4*)P.in[I_LRWF])[tid + 512 * i];
        __syncthreads();
        for (int i = tid; i < 64 * 48; i += NTHR) { float s = 0.f;
#pragma unroll
            for (int w8 = 0; w8 < 8; ++w8) s += part[w8 * 3072 + i];
            lr[i] = s; }
        __syncthreads();
        {
            const float qs = 0.08838834764831845f;
#pragma unroll 1
            for (int dir = 0; dir < 2; ++dir) {
                __syncthreads();
#pragma unroll
                for (int i = 0; i < 4; ++i) ((f32x4*)wvs)[tid + 512 * i] = wpre[i];
                float z[8][8];
                { const float* bsrc = (dir ? P.in[I_LRBB] : P.in[I_LRBF]) + 8 * lane; const f32x4 b0 = *(const f32x4*)bsrc, b1 = *(const f32x4*)(bsrc + 4);
#pragma unroll
                  for (int i = 0; i < 8; ++i) { z[i][0] = b0.x; z[i][1] = b0.y; z[i][2] = b0.z; z[i][3] = b0.w; z[i][4] = b1.x; z[i][5] = b1.y; z[i][6] = b1.z; z[i][7] = b1.w; } }
                __syncthreads();
#pragma unroll 1
                for (int rb = 0; rb < 4; ++rb) {
                    f32x4 l[8];
#pragma unroll
                    for (int i = 0; i < 8; ++i) l[i] = *(const f32x4*)(lr + (8 * wave + i) * 48 + dir * 16 + 4 * rb);
#pragma unroll
                    for (int rr = 0; rr < 4; ++rr) {
                        const f32x4 w0 = *(const f32x4*)(wvs + (4 * rb + rr) * 512 + 8 * lane), w1 = *(const f32x4*)(wvs + (4 * rb + rr) * 512 + 8 * lane + 4);
#pragma unroll
                        for (int i = 0; i < 8; ++i) { const float lv = l[i][rr];
                            z[i][0] += lv * w0.x; z[i][1] += lv * w0.y; z[i][2] += lv * w0.z; z[i][3] += lv * w0.w; z[i][4] += lv * w1.x; z[i][5] += lv * w1.y; z[i][6] += lv * w1.z; z[i][7] += lv * w1.w; }
                    }
                }
                if (dir == 0) {
#pragma unroll
                    for (int i = 0; i < 4; ++i) wpre[i] = ((const f32x4*)P.in[I_LRWB])[tid + 512 * i]; }
                u32x4 qr[8], kr[8];
#pragma unroll
                for (int i = 0; i < 8; ++i) { qr[i] = *(const u32x4*)(WSP(bf16_t, WS_GQ) + (m0 + 8 * wave + i) * 512 + 8 * lane); kr[i] = *(const u32x4*)(WSP(bf16_t, WS_GK) + (m0 + 8 * wave + i) * 512 + 8 * lane); }
                float tot[8];
#pragma unroll
                for (int j = 0; j < 8; ++j) {
#pragma unroll
                    for (int i = 0; i < 8; ++i) z[i][j] = logsigmoidf_(z[i][j]) * (1.f / 16.f);
                    if (dir == 0) {
#pragma unroll
                        for (int i = 1; i < 8; ++i) z[i][j] += z[i - 1][j];
                        tot[j] = z[7][j];
                    } else {
#pragma unroll
                        for (int i = 6; i >= 0; --i) z[i][j] += z[i + 1][j];
                        tot[j] = z[0][j];
                    }
                }
                __syncthreads();
                *(f32x4*)(wvs + wave * 512 + 8 * lane) = (f32x4){tot[0], tot[1], tot[2], tot[3]}; *(f32x4*)(wvs + wave * 512 + 8 * lane + 4) = (f32x4){tot[4], tot[5], tot[6], tot[7]};
                __syncthreads();
                float off[8];
#pragma unroll
                for (int j = 0; j < 8; ++j) off[j] = 0.f;
#pragma unroll
                for (int g = 0; g < 8; ++g) if (dir ? g > wave : g < wave) {
                    const f32x4 t0 = *(const f32x4*)(wvs + g * 512 + 8 * lane), t1 = *(const f32x4*)(wvs + g * 512 + 8 * lane + 4);
                    off[0] += t0.x; off[1] += t0.y; off[2] += t0.z; off[3] += t0.w; off[4] += t1.x; off[5] += t1.y; off[6] += t1.z; off[7] += t1.w; }
                if (wave == (dir ? 0 : 7)) {
                    float* gd = WSP(float, WS_GDEC) + ((size_t)(dir * NB + b) * NCH + c) * 512 + 8 * lane;
                    *(f32x4*)gd = (f32x4){__expf(off[0] + tot[0]), __expf(off[1] + tot[1]), __expf(off[2] + tot[2]), __expf(off[3] + tot[3])};
                    *(f32x4*)(gd + 4) = (f32x4){__expf(off[4] + tot[4]), __expf(off[5] + tot[5]), __expf(off[6] + tot[6]), __expf(off[7] + tot[7])}; }
                bf16_t* qo = (dir ? WSP(bf16_t, WS_QB) : WSP(bf16_t, WS_QF)) + (m0 + 8 * wave) * 512 + 8 * lane; bf16_t* ko = (dir ? WSP(bf16_t, WS_KB) : WSP(bf16_t, WS_KF)) + (m0 + 8 * wave) * 512 + 8 * lane;
#pragma unroll
                for (int i = 0; i < 8; ++i) {
                    float cum[8];
#pragma unroll
                    for (int j = 0; j < 8; ++j) cum[j] = off[j] + z[i][j];
                    const u32x4 q = qr[i], k = kr[i]; u32x4 o;
                    o.x = pk2(bf2f(q.x & 0xffff) * qs * __expf(cum[0]), bf2f(q.x >> 16) * qs * __expf(cum[1])); o.y = pk2(bf2f(q.y & 0xffff) * qs * __expf(cum[2]), bf2f(q.y >> 16) * qs * __expf(cum[3]));
                    o.z = pk2(bf2f(q.z & 0xffff) * qs * __expf(cum[4]), bf2f(q.z >> 16) * qs * __expf(cum[5])); o.w = pk2(bf2f(q.w & 0xffff) * qs * __expf(cum[6]), bf2f(q.w >> 16) * qs * __expf(cum[7]));
                    *(u32x4*)(qo + (size_t)i * 512) = o;
                    z[i][0] = bf2f(k.x & 0xffff) * __expf(-cum[0]); z[i][1] = bf2f(k.x >> 16) * __expf(-cum[1]); z[i][2] = bf2f(k.y & 0xffff) * __expf(-cum[2]); z[i][3] = bf2f(k.y >> 16) * __expf(-cum[3]);
                    z[i][4] = bf2f(k.z & 0xffff) * __expf(-cum[4]); z[i][5] = bf2f(k.z >> 16) * __expf(-cum[5]); z[i][6] = bf2f(k.w & 0xffff) * __expf(-cum[6]); z[i][7] = bf2f(k.w >> 16) * __expf(-cum[7]);
                    o.x = pk2(z[i][0], z[i][1]); o.y = pk2(z[i][2], z[i][3]); o.z = pk2(z[i][4], z[i][5]); o.w = pk2(z[i][6], z[i][7]);
                    *(u32x4*)(ko + (size_t)i * 512) = o;
                }
#pragma unroll
                for (int j = 0; j < 8; ++j) { u32x4 o; o.x = pk2(z[0][j], z[1][j]); o.y = pk2(z[2][j], z[3][j]); o.z = pk2(z[4][j], z[5][j]); o.w = pk2(z[6][j], z[7][j]);
                    *(u32x4*)(ktT + (8 * lane + j) * 128 + ((wave ^ (lane & 7)) << 4)) = o; }
                __syncthreads();
                bf16_t* ktg = (dir ? WSP(bf16_t, WS_KTB) : WSP(bf16_t, WS_KTF)) + m0;
#pragma unroll
                for (int it = 0; it < 8; ++it) { const int idx = it * 512 + tid, d = idx >> 3, s = idx & 7;
                    *(u32x4*)(ktg + (size_t)d * MTOK + 8 * s) = *(const u32x4*)(ktT + d * 128 + ((s ^ ((d >> 3) & 7)) << 4)); }
            }
        }
        {
            const int ch = 8 * (tid & 127), tq = tid >> 7, s0 = c * CH + 16 * tq;
            f32x4 w[5][2];
#pragma unroll
            for (int j = 0; j < 5; ++j) { w[j][0] = *(const f32x4*)(P.in[I_CONVW] + j * 1024 + ch); w[j][1] = *(const f32x4*)(P.in[I_CONVW] + j * 1024 + ch + 4); }
            const f32x4 cb0 = *(const f32x4*)(P.in[I_CONVB] + ch), cb1 = *(const f32x4*)(P.in[I_CONVB] + ch + 4);
            const bf16_t* mx = WSP(bf16_t, WS_MX) + (size_t)b * SEQ * 1024 + ch; bf16_t* xc = WSP(bf16_t, WS_XC) + (m0 + 16 * tq) * 1024 + ch;
            u32x4 xr[20];
#pragma unroll
            for (int r = 0; r < 20; ++r) { const int s = s0 - 2 + r; xr[r] = (u32x4){0u, 0u, 0u, 0u}; if (s >= 0 && s < SEQ) xr[r] = *(const u32x4*)(mx + (size_t)s * 1024); }
#pragma unroll
            for (int i = 0; i < 16; ++i) {
                f32x4 a0 = cb0, a1 = cb1;
#pragma unroll
                for (int k = 0; k < 5; ++k) { const u32x4 x = xr[i + k];
                    a0 += w[k][0] * (f32x4){bf2f(x.x & 0xffff), bf2f(x.x >> 16), bf2f(x.y & 0xffff), bf2f(x.y >> 16)}; a1 += w[k][1] * (f32x4){bf2f(x.z & 0xffff), bf2f(x.z >> 16), bf2f(x.w & 0xffff), bf2f(x.w >> 16)}; }
                u32x4 o; o.x = pk2(siluf_(a0.x), siluf_(a0.y)); o.y = pk2(siluf_(a0.z), siluf_(a0.w)); o.z = pk2(siluf_(a1.x), siluf_(a1.y)); o.w = pk2(siluf_(a1.z), siluf_(a1.w));
                *(u32x4*)(xc + (size_t)i * 1024) = o;
            }
        }
        {
            const int dir = wave >> 2, h = wave & 3;
            const float ipre = lr[lane * 48 + 32 + (dir * 2 + 0) * 4 + h] + P.in[I_MGB][(dir * 2 + 0) * 4 + h];
            const float fpre = lr[lane * 48 + 32 + (dir * 2 + 1) * 4 + h] + P.in[I_MGB][(dir * 2 + 1) * 4 + h];
            const float lf = logsigmoidf_(fpre);
            const float pre = wave_incl_scan_add(lf, lane); const float tot = __shfl(pre, 63);
            float Bv, Av, CMv;
            if (dir == 0) { Bv = pre; Av = ipre - Bv; CMv = wave_incl_scan_max(Av, lane); }
            else { Bv = tot - pre + lf; Av = ipre - Bv;
                const float ar = __shfl(Av, 63 - lane); const float pm = wave_incl_scan_max(ar, lane); CMv = __shfl(pm, 63 - lane); }
            float* msc = WSP(float, WS_MSC);
            const size_t o = ((size_t)(dir * 4 + h)) * MTOK + m0 + lane;
            msc[o] = Bv; msc[(size_t)8 * MTOK + o] = Av; msc[(size_t)16 * MTOK + o] = CMv;
            const float cmlast = dir == 0 ? __shfl(CMv, 63) : __shfl(CMv, 0);
            if (lane == 0) { float* mch = WSP(float, WS_MCH); const int ci = ((dir * 4 + b) * 4 + h) * 64 + c; mch[ci] = tot; mch[2048 + ci] = cmlast; }
        }
    }
}

struct SchedP3 {
    const Params* P; int bid, nb, part;
    DI bool next(int i, Unit& u) const {
        const int L = i * nb + bid; if (L >= 512) return false;
        const int which = part * 2 + (L >> 8), l = L & 255; u.pm = l >> 2; u.pn = l & 3; u.kind = which; u.keep = false; u.aux = 0;
        const bf16_t* xc = (const bf16_t*)(P->ws + WS_XC) + (size_t)u.pm * 256 * 1024 + u.pn * 256;
        const bf16_t* mx = (const bf16_t*)(P->ws + WS_MX) + (size_t)u.pm * 256 * 1024 + u.pn * 256;
        const bf16_t* wqk = (const bf16_t*)(P->ws + WS_WMQK) + (size_t)u.pn * 512 * 256; const bf16_t* wv = (const bf16_t*)(P->ws + WS_WMV) + (size_t)u.pn * 256 * 256;
        if (which == 0) { u.A = xc; u.lda = 1024; u.B = wqk; u.ldb = 256; }
        else if (which == 1) { u.A = xc; u.lda = 1024; u.B = wqk + 256 * 256; u.ldb = 256; }
        else if (which == 2) { u.A = wqk + 256 * 256; u.lda = 256; u.B = xc; u.ldb = 1024; }
        else { u.A = wv; u.lda = 256; u.B = mx; u.ldb = 1024; }
        return true;
    }
};
template <int PART> struct EpiP3 {
    const Params* Pp;
    DI void operator()(Acc& acc, const Unit& u, int wr, int wc, int fr, int fq) const {
        const Params& P = *Pp;
        if (PART == 0) {
            bf16_t* dst = (u.kind == 0 ? WSP(bf16_t, WS_QM) : WSP(bf16_t, WS_KM)) + (size_t)u.pm * 256 * 1024 + u.pn * 256; const float sc = u.kind == 0 ? 1.f : 0.0625f;
            ACC_FOREACH3(ai, bj, m) st_bf8(dst + (size_t)ACC_ROW(ai, m) * 1024 + ACC_COLW(bj), acc[ai][bj][m][0] * sc, acc[ai][bj][m][1] * sc);
        } else {
            bf16_t* dst = (u.kind == 2 ? WSP(bf16_t, WS_KMT) : WSP(bf16_t, WS_VMT)) + (size_t)u.pn * 256 * MTOK + (size_t)u.pm * 256; const float sc = u.kind == 2 ? 0.0625f : 1.f;
            ACC_FOREACH3(ai, bj, m) st_bf8(dst + (size_t)ACC_ROW(ai, m) * MTOK + ACC_COLW(bj), acc[ai][bj][m][0] * sc, acc[ai][bj][m][1] * sc);
        }
    }
};

DI bf16_t* obuf(const Params& P, int which) { return (bf16_t*)P.out + (size_t)which * MTOK * 1024; }
DI void naive_gla(const Params& P, float* lds, int item) {
    float* sa = lds; float* sq = lds + 128; float* sk = lds + 256; float* part = lds + 384;
    const int dir = item & 1, h = (item >> 1) & 3, b = item >> 3, tid = threadIdx.x, e = tid & 255, half = tid >> 8;
    float S[64];
#pragma unroll
    for (int d = 0; d < 64; ++d) S[d] = 0.f;
    const float* small = WSP(float, WS_SMALL);
    const float* wl = dir ? P.in[I_LRWB] : P.in[I_LRWF]; const float* bl = dir ? P.in[I_LRBB] : P.in[I_LRBF];
    const bf16_t* gq = WSP(bf16_t, WS_GQ); const bf16_t* gk = WSP(bf16_t, WS_GK); const bf16_t* vt = WSP(bf16_t, WS_VTG);
    bf16_t* o = obuf(P, dir);
    for (int step = 0; step < SEQ; ++step) {
        const int s = dir ? SEQ - 1 - step : step; const size_t m = (size_t)b * SEQ + s;
        __syncthreads();
        if (tid < 128) { const int d = h * 128 + tid; float z = bl[d];
            for (int r = 0; r < 16; ++r) z += small[m * 48 + dir * 16 + r] * wl[r * 512 + d];
            sa[tid] = __expf(logsigmoidf_(z) * (1.f / 16.f)); sq[tid] = bf2f(gq[m * 512 + d]) * 0.08838834764831845f; sk[tid] = bf2f(gk[m * 512 + d]); }
        __syncthreads();
        const float v = bf2f(vt[(size_t)(h * 256 + e) * MTOK + m]);
        float acc = 0.f;
#pragma unroll
        for (int d = 0; d < 64; ++d) { S[d] = sa[half * 64 + d] * S[d] + sk[half * 64 + d] * v; acc += sq[half * 64 + d] * S[d]; }
        part[tid] = acc;
        __syncthreads();
        if (tid < 256) o[m * 1024 + h * 256 + tid] = f2bf(part[tid] + part[tid + 256]);
    }
}
DI void naive_mlstm(const Params& P, float* lds, int item) {
    float* sq = lds; float* sk = lds + 256; float* sn = lds + 512; float* part = lds + 768; float* sden = lds + 1280;
    const int dir = item & 1, h = (item >> 1) & 3, b = item >> 3, tid = threadIdx.x, e = tid & 255, half = tid >> 8;
    float C[128];
#pragma unroll
    for (int d = 0; d < 128; ++d) C[d] = 0.f;
    if (tid < 256) sn[tid] = 0.f;
    const float* small = WSP(float, WS_SMALL);
    const bf16_t* qm = WSP(bf16_t, WS_QM); const bf16_t* km = WSP(bf16_t, WS_KM); const bf16_t* vt = WSP(bf16_t, WS_VMT);
    bf16_t* o = obuf(P, 2 + dir);
    const float bi = P.in[I_MGB][(dir * 2 + 0) * 4 + h], bfz = P.in[I_MGB][(dir * 2 + 1) * 4 + h];
    for (int step = 0; step < SEQ; ++step) {
        const int s = dir ? SEQ - 1 - step : step; const size_t m = (size_t)b * SEQ + s;
        const float ig = __expf(small[m * 48 + 32 + (dir * 2 + 0) * 4 + h] + bi);
        const float fg = sigmoidf_(small[m * 48 + 32 + (dir * 2 + 1) * 4 + h] + bfz);
        __syncthreads();
        if (tid < 256) { sq[tid] = bf2f(qm[m * 1024 + h * 256 + tid]); const float k = bf2f(km[m * 1024 + h * 256 + tid]); sk[tid] = k; sn[tid] = fg * sn[tid] + ig * k; }
        __syncthreads();
        const float v = bf2f(vt[(size_t)(h * 256 + e) * MTOK + m]) * ig;
        float acc = 0.f;
#pragma unroll
        for (int d = 0; d < 128; ++d) { C[d] = fg * C[d] + sk[half * 128 + d] * v; acc += sq[half * 128 + d] * C[d]; }
        part[tid] = acc;
        if (tid < 64) { float dsum = 0.f; for (int d = tid; d < 256; d += 64) dsum += sq[d] * sn[d]; dsum = wave_sum(dsum); if (tid == 0) sden[0] = dsum; }
        __syncthreads();
        if (tid < 256) { const float num = part[tid] + part[tid + 256]; o[m * 1024 + h * 256 + tid] = f2bf(num / fmaxf(fabsf(sden[0]), 1.f)); }
    }
}
typedef float f32x16 __attribute__((ext_vector_type(16)));
typedef __bf16 bf16x2_t __attribute__((ext_vector_type(2)));
DI unsigned cvtpk(float lo, float hi) { f32x2 v = {lo, hi}; bf16x2_t b = __builtin_convertvector(v, bf16x2_t); return __builtin_bit_cast(unsigned, b); }
DI f32x16 mfma32(bf16x8 a, bf16x8 b, f32x16 c) { return __builtin_amdgcn_mfma_f32_32x32x16_bf16(a, b, c, 0, 0, 0); }
DI int crow(int reg, int hh) { return (reg & 3) + 8 * (reg >> 2) + 4 * hh; }
DI bf16x8 pack8(const f32x16& x, int s) { u32x4 p; p.x = cvtpk(x[8 * s], x[8 * s + 1]); p.y = cvtpk(x[8 * s + 2], x[8 * s + 3]); p.z = cvtpk(x[8 * s + 4], x[8 * s + 5]); p.w = cvtpk(x[8 * s + 6], x[8 * s + 7]); return __builtin_bit_cast(bf16x8, p); }
#define LRD(T, base, off) (*(const LAS T*)((base) + (off)))
#define LWR(T, base, off) (*(LAS T*)((base) + (off)))
template <int DK, bool ML>
DI void scan_fast(const Params& P, float* ldsf, int item) {
    constexpr int NDT = DK / 32, QLD = DK + 8, TLD = 72, FT = ML ? 1024 : 512;
    constexpr int QB_ = QLD * 2, TB_ = TLD * 2;
    LAS unsigned char* L0 = (LAS unsigned char*)ldsf;
    LAS unsigned char* Qs = L0; LAS unsigned char* Ks = Qs + 64 * QB_; LAS unsigned char* KTs = Ks + 64 * QB_; LAS unsigned char* Ps = KTs + DK * TB_;
    LAS unsigned char* tab = Ps + 64 * TB_;
    constexpr int T_A = 0, T_CM = 256, T_B = 512, T_W = 768, T_WI = 1024, T_FL = 1280, T_D1 = 1536, T_DS = 1792, T_G = 2304, T_N = 2816;
    const int dir = item & 1, h = (item >> 1) & 3, b = item >> 3;
    const bf16_t* qg = (ML ? WSP(bf16_t, WS_QM) : (dir ? WSP(bf16_t, WS_QB) : WSP(bf16_t, WS_QF))) + h * DK;
    const bf16_t* kg = (ML ? WSP(bf16_t, WS_KM) : (dir ? WSP(bf16_t, WS_KB) : WSP(bf16_t, WS_KF))) + h * DK;
    const bf16_t* ktg = (ML ? WSP(bf16_t, WS_KMT) : (dir ? WSP(bf16_t, WS_KTB) : WSP(bf16_t, WS_KTF))) + (size_t)h * DK * MTOK;
    const bf16_t* vtg0 = (ML ? WSP(bf16_t, WS_VMT) : WSP(bf16_t, WS_VTG)) + (size_t)(h * 256) * MTOK;
    bf16_t* og0 = obuf(P, (ML ? 2 : 0) + dir) + h * 256;
    const float* msc = WSP(float, WS_MSC) + (size_t)(dir * 4 + h) * MTOK; const float* mch = WSP(float, WS_MCH) + ((dir * 4 + b) * 4 + h) * 64;
    f32x16 S[NDT];
#pragma unroll
    for (int dt = 0; dt < NDT; ++dt)
#pragma unroll
        for (int i = 0; i < 16; ++i) S[dt][i] = 0.f;
    if (ML && threadIdx.x < 256) LWR(float, tab, T_N + threadIdx.x * 4) = 0.f;
    float m_prev = 0.f;
    for (int ci = 0; ci < NCH; ++ci) {
        const int c = dir ? NCH - 1 - ci : ci; const size_t m0 = (size_t)b * SEQ + (size_t)c * CH;
        int tid = threadIdx.x; asm volatile("" : "+v"(tid));
        const int lane = tid & 63, w = __builtin_amdgcn_readfirstlane(tid >> 6), r = lane & 31, hh = lane >> 5;
        const bf16_t* vtg = vtg0 + (size_t)(32 * w + r) * MTOK + 8 * hh;
        bf16_t* og = og0 + 32 * w + r;
        LAS unsigned char* qfrag = Qs + r * QB_ + hh * 8;
        LAS unsigned char* pfrag = Ps + r * TB_ + hh * 16;
        LAS unsigned char* ktfrag = KTs + r * TB_ + hh * 16;
        LAS unsigned char* tabh = tab + hh * 16;
        __syncthreads();
        for (int p = tid; p < 64 * DK / 8; p += NTHR) { const int row = p / (DK / 8), c8 = p % (DK / 8);
            LWR(u32x4, Qs, row * QB_ + c8 * 16) = *(const u32x4*)(qg + (m0 + row) * FT + c8 * 8);
            LWR(u32x4, Ks, row * QB_ + c8 * 16) = *(const u32x4*)(kg + (m0 + row) * FT + c8 * 8); }
        for (int p = tid; p < DK * 8; p += NTHR) { const int d = p >> 3, c8 = p & 7; LWR(u32x4, KTs, d * TB_ + c8 * 16) = *(const u32x4*)(ktg + (size_t)d * MTOK + m0 + c8 * 8); }
        bf16x8 Bv[4];
#pragma unroll
        for (int ks = 0; ks < 4; ++ks) Bv[ks] = *(const bf16x8*)(vtg + m0 + 16 * ks);
        float Mx = 0.f, w_old = 1.f, Btot = 0.f;
        if (ML) {
            if (tid < 64) { LWR(float, tab, T_B + tid * 4) = msc[m0 + tid]; LWR(float, tab, T_A + tid * 4) = msc[(size_t)8 * MTOK + m0 + tid]; LWR(float, tab, T_CM + tid * 4) = msc[(size_t)16 * MTOK + m0 + tid]; }
            Btot = mch[c]; const float cml = mch[2048 + c]; Mx = fmaxf(m_prev, cml); w_old = __expf(m_prev - Mx);
        } else {
            if (tid < 128) LWR(float, tab, T_G + tid * 4) = WSP(float, WS_GDEC)[((size_t)(dir * NB + b) * NCH + c) * 512 + h * 128 + tid];
        }
        __syncthreads();
        if (w < 4) {
            const int si = w >> 1, ti = w & 1;
            LAS unsigned char* ka = Ks + (32 * si + r) * QB_ + hh * 16; LAS unsigned char* qa = Qs + (32 * ti + r) * QB_ + hh * 16;
            f32x16 X;
#pragma unroll
            for (int i = 0; i < 16; ++i) X[i] = 0.f;
#pragma unroll
            for (int ks = 0; ks < DK / 16; ++ks) { X = mfma32(LRD(bf16x8, ka, ks * 32), LRD(bf16x8, qa, ks * 32), X); if (ML && (ks & 3) == 3) __builtin_amdgcn_sched_barrier(0); }
            const int t = 32 * ti + r;
            float cmt = 0.f; if (ML) cmt = fmaxf(m_prev, LRD(float, tab, T_CM + t * 4));
            float rs = 0.f;
            LAS unsigned char* prow = Ps + t * TB_ + (32 * si + 4 * hh) * 2;
            LAS unsigned char* arow = tab + T_A + (32 * si + 4 * hh) * 4;
#pragma unroll
            for (int g = 0; g < 4; ++g) {
                float v[4]; f32x4 av = {0.f, 0.f, 0.f, 0.f}; if (ML) av = LRD(f32x4, arow, g * 32);
#pragma unroll
                for (int i = 0; i < 4; ++i) { const int s = 32 * si + 8 * g + 4 * hh + i; const bool keep = dir ? (s >= t) : (s <= t);
                    float x = X[4 * g + i]; if (ML) x *= __expf(av[i] - cmt); v[i] = keep ? x : 0.f; rs += v[i]; }
                u32x2 pk; pk.x = cvtpk(v[0], v[1]); pk.y = cvtpk(v[2], v[3]);
                LWR(u32x2, prow, g * 16) = pk;
            }
            if (ML) { rs += __shfl_xor(rs, 32); if (hh == 0) LWR(float, tab, T_DS + (si * 64 + t) * 4) = rs; }
        } else if (ML) {
            const int j = tid - 256, t = j >> 2, part = j & 3;
            LAS unsigned char* qrow = Qs + t * QB_ + part * (DK / 4) * 2; LAS unsigned char* nrow = tab + T_N + part * (DK / 4) * 4;
            float a = 0.f;
#pragma unroll
            for (int d8 = 0; d8 < DK / 32; ++d8) { const u32x4 qv = LRD(u32x4, qrow, d8 * 16); const f32x4 n0 = LRD(f32x4, nrow, d8 * 32), n1 = LRD(f32x4, nrow, d8 * 32 + 16);
                a += __uint_as_float(qv.x << 16) * n0.x + __uint_as_float(qv.x & 0xffff0000u) * n0.y + __uint_as_float(qv.y << 16) * n0.z + __uint_as_float(qv.y & 0xffff0000u) * n0.w
                   + __uint_as_float(qv.z << 16) * n1.x + __uint_as_float(qv.z & 0xffff0000u) * n1.y + __uint_as_float(qv.w << 16) * n1.z + __uint_as_float(qv.w & 0xffff0000u) * n1.w; }
            a += __shfl_xor(a, 1); a += __shfl_xor(a, 2);
            if (part == 0) LWR(float, tab, T_D1 + t * 4) = a;
            if (j < 64) { const float cmt = fmaxf(m_prev, LRD(float, tab, T_CM + j * 4));
                LWR(float, tab, T_WI + j * 4) = __expf(m_prev - cmt); LWR(float, tab, T_FL + j * 4) = __expf(-(LRD(float, tab, T_B + j * 4) + cmt)); LWR(float, tab, T_W + j * 4) = __expf(LRD(float, tab, T_A + j * 4) - Mx); }
        }
        __syncthreads();
#pragma unroll
        for (int tt = 0; tt < 2; ++tt) {
            f32x16 O;
#pragma unroll
            for (int i = 0; i < 16; ++i) O[i] = 0.f;
#pragma unroll
            for (int dt = 0; dt < NDT; ++dt)
#pragma unroll
                for (int sp = 0; sp < 2; ++sp) {
                    const bf16x8 bs = pack8(S[dt], sp);
                    const u32x2 lo = LRD(u32x2, qfrag, tt * 32 * QB_ + dt * 64 + sp * 32), hi = LRD(u32x2, qfrag, tt * 32 * QB_ + dt * 64 + sp * 32 + 16);
                    const u32x4 av = {lo.x, lo.y, hi.x, hi.y};
                    O = mfma32(__builtin_bit_cast(bf16x8, av), bs, O);
                    if (ML) __builtin_amdgcn_sched_barrier(0);
                }
            if (ML) {
#pragma unroll
                for (int g = 0; g < 4; ++g) { const f32x4 wi = LRD(f32x4, tabh, T_WI + (32 * tt + 8 * g) * 4);
                    O[4 * g] *= wi.x; O[4 * g + 1] *= wi.y; O[4 * g + 2] *= wi.z; O[4 * g + 3] *= wi.w; }
            }
#pragma unroll
            for (int ks = 0; ks < 4; ++ks) O = mfma32(LRD(bf16x8, pfrag, tt * 32 * TB_ + ks * 32), Bv[ks], O);
            bf16_t* orow = og + (m0 + 32 * tt + 4 * hh) * 1024;
#pragma unroll
            for (int g = 0; g < 4; ++g) {
                f32x4 rd = {1.f, 1.f, 1.f, 1.f};
                if (ML) { const int to = (32 * tt + 8 * g) * 4;
                    const f32x4 wi = LRD(f32x4, tabh, T_WI + to), d1 = LRD(f32x4, tabh, T_D1 + to), ds0 = LRD(f32x4, tabh, T_DS + to), ds1 = LRD(f32x4, tabh, T_DS + 256 + to), fl = LRD(f32x4, tabh, T_FL + to);
                    const f32x4 den = wi * d1 + ds0 + ds1;
                    rd.x = 1.f / fmaxf(fabsf(den.x), fl.x); rd.y = 1.f / fmaxf(fabsf(den.y), fl.y); rd.z = 1.f / fmaxf(fabsf(den.z), fl.z); rd.w = 1.f / fmaxf(fabsf(den.w), fl.w); }
#pragma unroll
                for (int i = 0; i < 4; ++i) orow[(8 * g + i) * 1024] = f2bf(O[4 * g + i] * rd[i]);
            }
            __builtin_amdgcn_sched_barrier(0);
        }
        if (ML) {
#pragma unroll
            for (int ks = 0; ks < 4; ++ks) {
                const f32x4 w0 = LRD(f32x4, tab, T_W + (16 * ks + 8 * hh) * 4), w1 = LRD(f32x4, tab, T_W + (16 * ks + 8 * hh + 4) * 4);
                const u32x4 bv = __builtin_bit_cast(u32x4, Bv[ks]); u32x4 o;
                o.x = cvtpk(__uint_as_float(bv.x << 16) * w0.x, __uint_as_float(bv.x & 0xffff0000u) * w0.y);
                o.y = cvtpk(__uint_as_float(bv.y << 16) * w0.z, __uint_as_float(bv.y & 0xffff0000u) * w0.w);
                o.z = cvtpk(__uint_as_float(bv.z << 16) * w1.x, __uint_as_float(bv.z & 0xffff0000u) * w1.y);
                o.w = cvtpk(__uint_as_float(bv.w << 16) * w1.z, __uint_as_float(bv.w & 0xffff0000u) * w1.w);
                Bv[ks] = __builtin_bit_cast(bf16x8, o);
            }
        }
#pragma unroll
        for (int dt = 0; dt < NDT; ++dt) {
            if (ML) {
#pragma unroll
                for (int i = 0; i < 16; ++i) S[dt][i] *= w_old;
            }
#pragma unroll
            for (int ks = 0; ks < 4; ++ks) S[dt] = mfma32(LRD(bf16x8, ktfrag, dt * 32 * TB_ + ks * 32), Bv[ks], S[dt]);
            if (ML) __builtin_amdgcn_sched_barrier(0);
            if (!ML) {
#pragma unroll
                for (int g = 0; g < 4; ++g) { const f32x4 gg = LRD(f32x4, tabh, T_G + (32 * dt + 8 * g) * 4);
                    S[dt][4 * g] *= gg.x; S[dt][4 * g + 1] *= gg.y; S[dt][4 * g + 2] *= gg.z; S[dt][4 * g + 3] *= gg.w; }
            }
        }
        if (ML) {
            if (tid < 256) { float a = 0.f; LAS unsigned char* krow = KTs + tid * TB_;
#pragma unroll
                for (int s8 = 0; s8 < 8; ++s8) { const u32x4 kv = LRD(u32x4, krow, s8 * 16); const f32x4 w0 = LRD(f32x4, tab, T_W + s8 * 32), w1 = LRD(f32x4, tab, T_W + s8 * 32 + 16);
                    a += __uint_as_float(kv.x << 16) * w0.x + __uint_as_float(kv.x & 0xffff0000u) * w0.y + __uint_as_float(kv.y << 16) * w0.z + __uint_as_float(kv.y & 0xffff0000u) * w0.w
                       + __uint_as_float(kv.z << 16) * w1.x + __uint_as_float(kv.z & 0xffff0000u) * w1.y + __uint_as_float(kv.w << 16) * w1.z + __uint_as_float(kv.w & 0xffff0000u) * w1.w; }
                LWR(float, tab, T_N + tid * 4) = w_old * LRD(float, tab, T_N + tid * 4) + a; }
            m_prev = Btot + Mx;
        }
    }
}
DI f32x4 mfma16(bf16x8 a, bf16x8 b, f32x4 c) { return __builtin_amdgcn_mfma_f32_16x16x32_bf16(a, b, c, 0, 0, 0); }
template <int DK, bool ML, bool PRE>
DI void scan16(const Params& P, float* ldsf, int item, int skip = 0) {
    constexpr int NDT = DK / 16, NJ = DK / 32, QLD = DK + 8, TLD = 72, FT = ML ? 1024 : 512;
    constexpr int QB_ = QLD * 2, TB_ = TLD * 2;
    LAS unsigned char* L0 = (LAS unsigned char*)ldsf;
    LAS unsigned char* Qs = L0; LAS unsigned char* Ks = Qs + 64 * QB_; LAS unsigned char* KTs = Ks + 64 * QB_; LAS unsigned char* Ps = KTs + DK * TB_;
    LAS unsigned char* tab = Ps + 64 * TB_;
    constexpr int T_A = 0, T_CM = 256, T_B = 512, T_W = 768, T_WI = 1024, T_FL = 1280, T_D1 = 1536, T_DS = 1792, T_G = 2816, T_N = 3328, T_BT = 4352, T_CL = 4608;
    const int eh = item & 1, dir = (item >> 1) & 1, h = (item >> 2) & 3, b = item >> 4;
    const bf16_t* qg = (ML ? WSP(bf16_t, WS_QM) : (dir ? WSP(bf16_t, WS_QB) : WSP(bf16_t, WS_QF))) + h * DK;
    const bf16_t* kg_ = (ML ? WSP(bf16_t, WS_KM) : (dir ? WSP(bf16_t, WS_KB) : WSP(bf16_t, WS_KF))) + h * DK;
    const bf16_t* ktg = (ML ? WSP(bf16_t, WS_KMT) : (dir ? WSP(bf16_t, WS_KTB) : WSP(bf16_t, WS_KTF))) + (size_t)h * DK * MTOK;
    const bf16_t* vtg0 = (ML ? WSP(bf16_t, WS_VMT) : WSP(bf16_t, WS_VTG)) + (size_t)(h * 256 + 128 * eh) * MTOK;
    bf16_t* og0 = obuf(P, (ML ? 2 : 0) + dir) + h * 256 + 128 * eh;
    const float* msc = WSP(float, WS_MSC) + (size_t)(dir * 4 + h) * MTOK; const float* mch = WSP(float, WS_MCH) + ((dir * 4 + b) * 4 + h) * 64;
    f32x4 S[NDT];
#pragma unroll
    for (int dt = 0; dt < NDT; ++dt) S[dt] = (f32x4){0.f, 0.f, 0.f, 0.f};
    if (ML && threadIdx.x < 256) LWR(float, tab, T_N + threadIdx.x * 4) = 0.f;
    const int sidx = (dir * 4 + b) * 4 + h;
    if (ML && !PRE && threadIdx.x < 64) { LWR(float, tab, T_BT + threadIdx.x * 4) = mch[threadIdx.x]; LWR(float, tab, T_CL + threadIdx.x * 4) = mch[2048 + threadIdx.x]; }
    if (PRE && threadIdx.x < 64) LWR(float, tab, T_BT + threadIdx.x * 4) = WSP(float, WS_PRES)[sidx * 64 + threadIdx.x];
    __syncthreads();
    float m_prev = 0.f;
    constexpr int NQ = 64 * DK / 8 / NTHR, NKT = DK * 8 / NTHR;
    u32x4 rq[NQ], rk[NQ], rkt[NKT]; bf16x8 Bn[2]; float rt0 = 0.f, rt1 = 0.f, rt2 = 0.f;
    constexpr unsigned QSTEP = (unsigned)(NTHR / (DK / 8)) * FT * 2u, KTSTEP = 64u * MTOK * 2u;
#define SCAN16_TID() unsigned t0_ = threadIdx.x; asm volatile("" : "+v"(t0_))
#define SCAN16_VOQ() (((t0_ / (DK / 8)) * FT + (t0_ % (DK / 8)) * 8) * 2u)
#define SCAN16_VOKT() ((t0_ >> 3) * (unsigned)(MTOK * 2) + (t0_ & 7) * 16u)
#define SCAN16_VOV() ((16 * (t0_ >> 6) + (t0_ & 15)) * (unsigned)(MTOK * 2) + ((t0_ & 63) >> 4) * 16u)
#define LDG(T, ubase, voff) (*(const T*)((const char*)(ubase) + (voff)))
#define SCAN16_LOAD(cc) do { const size_t m0n = (size_t)b * SEQ + (size_t)(cc) * CH; SCAN16_TID(); const unsigned voq = SCAN16_VOQ(), vov = SCAN16_VOV(); \
        const char* qb_ = (const char*)(qg + m0n * FT); const char* kb_ = (const char*)(kg_ + m0n * FT); \
        _Pragma("unroll") for (int i = 0; i < NQ; ++i) { rq[i] = LDG(u32x4, qb_ + (size_t)i * QSTEP, voq); if (!PRE) rk[i] = LDG(u32x4, kb_ + (size_t)i * QSTEP, voq); } \
        if (PRE) { rk[0] = LDG(u32x4, (const char*)(WSP(bf16_t, WS_PREP) + (size_t)(sidx * 64 + (cc)) * 4096), t0_ * 16u); } \
        { const char* vb_ = (const char*)(vtg0 + m0n); Bn[0] = LDG(bf16x8, vb_, vov); Bn[1] = LDG(bf16x8, vb_ + 64, vov); } \
        if (PRE) { if (t0_ < 256) rt0 = WSP(float, WS_PRET)[(size_t)(sidx * 64 + (cc)) * 256 + t0_]; } \
        else if (ML) { if (t0_ < 64) { rt0 = msc[m0n + t0_]; rt1 = msc[(size_t)8 * MTOK + m0n + t0_]; rt2 = msc[(size_t)16 * MTOK + m0n + t0_]; } } \
        else { if (t0_ < 128) rt0 = WSP(float, WS_GDEC)[((size_t)(dir * NB + b) * NCH + (cc)) * 512 + h * 128 + t0_]; } } while (0)
#define SCAN16_LOADKT(cc) do { const size_t m0n = (size_t)b * SEQ + (size_t)(cc) * CH; SCAN16_TID(); const unsigned vokt = SCAN16_VOKT(); const char* tb_ = (const char*)(ktg + m0n); \
        _Pragma("unroll") for (int i = 0; i < NKT; ++i) rkt[i] = LDG(u32x4, tb_ + (size_t)i * KTSTEP, vokt); } while (0)
    SCAN16_LOAD(dir ? NCH - 1 : 0); SCAN16_LOADKT(dir ? NCH - 1 : 0);
    for (int ci = 0; ci < NCH; ++ci) {
        const int c = dir ? NCH - 1 - ci : ci; const size_t m0 = (size_t)b * SEQ + (size_t)c * CH;
        int tid = threadIdx.x; asm volatile("" : "+v"(tid));
        const int lane = tid & 63, w = __builtin_amdgcn_readfirstlane(tid >> 6), c16 = lane & 15, kg = lane >> 4;
        LAS unsigned char* qfrag = Qs + c16 * QB_ + kg * 16;
        LAS unsigned char* pfrag = Ps + c16 * TB_ + kg * 16;
        LAS unsigned char* ktfrag = KTs + c16 * TB_ + kg * 16;
        LAS unsigned char* tabk = tab + kg * 16;
        __syncthreads();
#pragma unroll
        for (int i = 0; i < NQ; ++i) { const int p = tid + i * NTHR, row = p / (DK / 8), c8 = p % (DK / 8);
            const int wq = c8 & 3, off = row * QB_ + (c8 >> 2) * 64 + ((wq & 1) * 16 + (wq >> 1) * 4) * 2;
            LWR(u32x2, Qs, off) = (u32x2){rq[i].x, rq[i].y}; LWR(u32x2, Qs, off + 16) = (u32x2){rq[i].z, rq[i].w};
            if (!PRE) { LWR(u32x2, Ks, off) = (u32x2){rk[i].x, rk[i].y}; LWR(u32x2, Ks, off + 16) = (u32x2){rk[i].z, rk[i].w}; } }
        if (PRE) LWR(u32x4, Ps, (tid >> 3) * TB_ + (tid & 7) * 16) = rk[0];
#pragma unroll
        for (int i = 0; i < NKT; ++i) { const int p = tid + i * NTHR, d = p >> 3, c8 = p & 7; LWR(u32x4, KTs, d * TB_ + c8 * 16) = rkt[i]; }
        bf16x8 Bv[2]; Bv[0] = Bn[0]; Bv[1] = Bn[1];
        float Mx = 0.f, w_old = 1.f, Btot = 0.f;
        if (PRE) {
            if (tid < 256) LWR(float, tab, (tid < 192 ? T_W + tid * 4 : T_DS + (tid - 192) * 4)) = rt0;
            w_old = LRD(float, tab, T_BT + c * 4);
        } else if (ML) {
            if (tid < 64) { LWR(float, tab, T_B + tid * 4) = rt0; LWR(float, tab, T_A + tid * 4) = rt1; LWR(float, tab, T_CM + tid * 4) = rt2; }
            Btot = LRD(float, tab, T_BT + c * 4); const float cml = LRD(float, tab, T_CL + c * 4); Mx = fmaxf(m_prev, cml); w_old = __expf(m_prev - Mx);
        } else {
            if (tid < 128) LWR(float, tab, T_G + tid * 4) = rt0;
        }
        __syncthreads();
        if (ci + 1 < NCH) SCAN16_LOAD(dir ? NCH - 2 - ci : ci + 1);
#define SB() __builtin_amdgcn_sched_barrier(0)
        if (!PRE && !(skip & 1)) {
            constexpr int NS = DK / 64;
            const int idx0 = 2 * w, si0 = idx0 >> 2, ti0 = idx0 & 3, si1 = (idx0 + 1) >> 2, ti1 = (idx0 + 1) & 3;
            const bool dead0 = dir ? (si0 < ti0) : (si0 > ti0), dead1 = dir ? (si1 < ti1) : (si1 > ti1);
            LAS unsigned char* ka0 = Ks + (16 * si0 + c16) * QB_ + kg * 16; LAS unsigned char* qa0 = Qs + (16 * ti0 + c16) * QB_ + kg * 16;
            LAS unsigned char* ka1 = Ks + (16 * si1 + c16) * QB_ + kg * 16; LAS unsigned char* qa1 = Qs + (16 * ti1 + c16) * QB_ + kg * 16;
            f32x4 X0 = {0.f, 0.f, 0.f, 0.f}, X1 = {0.f, 0.f, 0.f, 0.f};
            if (!ML) {
                bf16x8 fa[2][2], fb[2][2];
                fa[0][0] = LRD(bf16x8, ka0, 0); fb[0][0] = LRD(bf16x8, qa0, 0); fa[0][1] = LRD(bf16x8, ka0, 64); fb[0][1] = LRD(bf16x8, qa0, 64);
#pragma unroll
                for (int st = 0; st < 2 * NS; ++st) {
                    if (st + 1 < 2 * NS) {
                        const int sn = st + 1, nb_ = sn & 1, ko = (sn % NS) * 2;
                        LAS unsigned char* kan = (sn < NS) ? ka0 : ka1; LAS unsigned char* qan = (sn < NS) ? qa0 : qa1;
                        fa[nb_][0] = LRD(bf16x8, kan, ko * 64); fb[nb_][0] = LRD(bf16x8, qan, ko * 64); fa[nb_][1] = LRD(bf16x8, kan, (ko + 1) * 64); fb[nb_][1] = LRD(bf16x8, qan, (ko + 1) * 64);
                    }
                    SB();
                    if (st < NS) { if (!dead0) { X0 = mfma16(fa[st & 1][0], fb[st & 1][0], X0); X0 = mfma16(fa[st & 1][1], fb[st & 1][1], X0); } }
                    else { if (!dead1) { X1 = mfma16(fa[st & 1][0], fb[st & 1][0], X1); X1 = mfma16(fa[st & 1][1], fb[st & 1][1], X1); } }
                    SB();
                }
            } else {
#pragma unroll
                for (int st = 0; st < 2 * NS; ++st) {
                    const int ko = (st % NS) * 2; LAS unsigned char* kan = (st < NS) ? ka0 : ka1; LAS unsigned char* qan = (st < NS) ? qa0 : qa1;
                    const bool dd = (st < NS) ? dead0 : dead1;
                    if (!dd) {
                        const bf16x8 a0 = LRD(bf16x8, kan, ko * 64), b0 = LRD(bf16x8, qan, ko * 64), a1 = LRD(bf16x8, kan, (ko + 1) * 64), b1 = LRD(bf16x8, qan, (ko + 1) * 64);
                        if (st < NS) { X0 = mfma16(a0, b0, X0); X0 = mfma16(a1, b1, X0); } else { X1 = mfma16(a0, b0, X1); X1 = mfma16(a1, b1, X1); }
                    }
                    SB();
                }
            }
#pragma unroll
            for (int q2 = 0; q2 < 2; ++q2) {
                const int si = q2 ? si1 : si0, ti = q2 ? ti1 : ti0; const f32x4 X = q2 ? X1 : X0;
                const int t = 16 * ti + c16;
                float cmt = 0.f; if (ML) cmt = fmaxf(m_prev, LRD(float, tab, T_CM + t * 4));
                f32x4 av = {0.f, 0.f, 0.f, 0.f}; if (ML) av = LRD(f32x4, tab, T_A + (16 * si + 4 * kg) * 4);
                float v[4], rs = 0.f;
#pragma unroll
                for (int i = 0; i < 4; ++i) { const int s = 16 * si + 4 * kg + i; const bool keep = dir ? (s >= t) : (s <= t);
                    float x = X[i]; if (ML) x *= __expf(av[i] - cmt); v[i] = keep ? x : 0.f; rs += v[i]; }
                u32x2 pk; pk.x = cvtpk(v[0], v[1]); pk.y = cvtpk(v[2], v[3]);
                LWR(u32x2, Ps, t * TB_ + (16 * si + 4 * kg) * 2) = pk;
                if (ML) { rs += __shfl_xor(rs, 16); rs += __shfl_xor(rs, 32); if (kg == 0) LWR(float, tab, T_DS + (si * 64 + t) * 4) = rs; }
            }
        }
        if (ML && !(skip & 1)) {
            const int t = tid >> 3, part = tid & 7;
            LAS unsigned char* qrow = Qs + t * QB_ + part * (DK / 8) * 2; LAS unsigned char* nrow = tab + T_N + part * (DK / 8) * 4;
            u32x4 qv[DK / 64]; f32x4 n0[DK / 64], n1[DK / 64];
#pragma unroll
            for (int d8 = 0; d8 < DK / 64; ++d8) { qv[d8] = LRD(u32x4, qrow, d8 * 16); n0[d8] = LRD(f32x4, nrow, d8 * 32); n1[d8] = LRD(f32x4, nrow, d8 * 32 + 16); }
            float cmv = 0.f, bvv = 0.f, avv = 0.f;
            if (!PRE && tid < 64) { cmv = LRD(float, tab, T_CM + tid * 4); bvv = LRD(float, tab, T_B + tid * 4); avv = LRD(float, tab, T_A + tid * 4); }
            SB();
            float a = 0.f;
#pragma unroll
            for (int d8 = 0; d8 < DK / 64; ++d8) {
                a += __uint_as_float(qv[d8].x << 16) * n0[d8].x + __uint_as_float(qv[d8].x & 0xffff0000u) * n0[d8].y + __uint_as_float(qv[d8].y << 16) * n0[d8].z + __uint_as_float(qv[d8].y & 0xffff0000u) * n0[d8].w
                   + __uint_as_float(qv[d8].z << 16) * n1[d8].x + __uint_as_float(qv[d8].z & 0xffff0000u) * n1[d8].y + __uint_as_float(qv[d8].w << 16) * n1[d8].z + __uint_as_float(qv[d8].w & 0xffff0000u) * n1[d8].w; }
            a += __shfl_xor(a, 1); a += __shfl_xor(a, 2); a += __shfl_xor(a, 4);
            if (part == 0) LWR(float, tab, T_D1 + t * 4) = a;
            if (!PRE && tid < 64) { const float cmt = fmaxf(m_prev, cmv);
                LWR(float, tab, T_WI + tid * 4) = __expf(m_prev - cmt); LWR(float, tab, T_FL + tid * 4) = __expf(-(bvv + cmt)); LWR(float, tab, T_W + tid * 4) = __expf(avv - Mx); }
        }
        __syncthreads();
        bf16x8 qa[2][4];
#pragma unroll
        for (int tt = 0; tt < 4; ++tt) qa[0][tt] = LRD(bf16x8, qfrag, tt * 16 * QB_);
        f32x4 O[4];
#pragma unroll
        for (int tt = 0; tt < 4; ++tt) O[tt] = (f32x4){0.f, 0.f, 0.f, 0.f};
        if (!(skip & 2))
#pragma unroll
        for (int j = 0; j < NJ; ++j) {
            if (j + 1 < NJ) {
#pragma unroll
                for (int tt = 0; tt < 4; ++tt) qa[(j + 1) & 1][tt] = LRD(bf16x8, qfrag, tt * 16 * QB_ + (j + 1) * 64);
            }
            SB();
            u32x4 bp; bp.x = cvtpk(S[2 * j][0], S[2 * j][1]); bp.y = cvtpk(S[2 * j][2], S[2 * j][3]); bp.z = cvtpk(S[2 * j + 1][0], S[2 * j + 1][1]); bp.w = cvtpk(S[2 * j + 1][2], S[2 * j + 1][3]);
            const bf16x8 bs = __builtin_bit_cast(bf16x8, bp);
#pragma unroll
            for (int tt = 0; tt < 4; ++tt) O[tt] = mfma16(bs, qa[j & 1][tt], O[tt]);
        }
        if (ci + 1 < NCH) SCAN16_LOADKT(dir ? NCH - 2 - ci : ci + 1);
        bf16x8 kt[2][2];
        kt[0][0] = LRD(bf16x8, ktfrag, 0); kt[0][1] = LRD(bf16x8, ktfrag, 64);
        unsigned opk[4][2];
#pragma unroll
        for (int tt = 0; tt < 4; ++tt) {
            const bf16x8 p0 = LRD(bf16x8, pfrag, tt * 16 * TB_), p1 = LRD(bf16x8, pfrag, tt * 16 * TB_ + 64);
            float wi = 1.f, d1 = 0.f, fl = 0.f, ds = 0.f;
            if (ML) { const int to = (16 * tt + c16) * 4;
                wi = LRD(float, tab, T_WI + to); d1 = LRD(float, tab, T_D1 + to); fl = LRD(float, tab, T_FL + to);
                ds = LRD(float, tab, T_DS + to); if (!PRE) ds += LRD(float, tab, T_DS + 256 + to) + LRD(float, tab, T_DS + 512 + to) + LRD(float, tab, T_DS + 768 + to); }
            SB();
            float rd = 1.f;
            if (ML) { O[tt] = O[tt] * wi; rd = frcp(fmaxf(fabsf(wi * d1 + ds), fl)); }
            O[tt] = mfma16(Bv[0], p0, O[tt]); O[tt] = mfma16(Bv[1], p1, O[tt]);
            opk[tt][0] = cvtpk(O[tt][0] * rd, O[tt][1] * rd); opk[tt][1] = cvtpk(O[tt][2] * rd, O[tt][3] * rd);
        }
#pragma unroll
        for (int tp = 0; tp < 2; ++tp) {
            const auto r0 = __builtin_amdgcn_permlane16_swap(opk[2 * tp][0], opk[2 * tp + 1][0], false, false); const auto r1 = __builtin_amdgcn_permlane16_swap(opk[2 * tp][1], opk[2 * tp + 1][1], false, false);
            u32x4 o; o.x = r0[0]; o.y = r1[0]; o.z = r0[1]; o.w = r1[1];
            if (!(skip & 8)) *(u32x4*)(og0 + (m0 + 16 * (2 * tp + (kg & 1)) + c16) * 1024 + 16 * w + 8 * (kg >> 1)) = o;
        }
        if (ML) {
            const f32x4 wv0 = LRD(f32x4, tab, T_W + (8 * kg) * 4), wv1 = LRD(f32x4, tab, T_W + (8 * kg + 4) * 4), wv2 = LRD(f32x4, tab, T_W + (32 + 8 * kg) * 4), wv3 = LRD(f32x4, tab, T_W + (32 + 8 * kg + 4) * 4);
            { const u32x4 bv = __builtin_bit_cast(u32x4, Bv[0]); u32x4 o;
              o.x = cvtpk(__uint_as_float(bv.x << 16) * wv0.x, __uint_as_float(bv.x & 0xffff0000u) * wv0.y); o.y = cvtpk(__uint_as_float(bv.y << 16) * wv0.z, __uint_as_float(bv.y & 0xffff0000u) * wv0.w);
              o.z = cvtpk(__uint_as_float(bv.z << 16) * wv1.x, __uint_as_float(bv.z & 0xffff0000u) * wv1.y); o.w = cvtpk(__uint_as_float(bv.w << 16) * wv1.z, __uint_as_float(bv.w & 0xffff0000u) * wv1.w);
              Bv[0] = __builtin_bit_cast(bf16x8, o); }
            { const u32x4 bv = __builtin_bit_cast(u32x4, Bv[1]); u32x4 o;
              o.x = cvtpk(__uint_as_float(bv.x << 16) * wv2.x, __uint_as_float(bv.x & 0xffff0000u) * wv2.y); o.y = cvtpk(__uint_as_float(bv.y << 16) * wv2.z, __uint_as_float(bv.y & 0xffff0000u) * wv2.w);
              o.z = cvtpk(__uint_as_float(bv.z << 16) * wv3.x, __uint_as_float(bv.z & 0xffff0000u) * wv3.y); o.w = cvtpk(__uint_as_float(bv.w << 16) * wv3.z, __uint_as_float(bv.w & 0xffff0000u) * wv3.w);
              Bv[1] = __builtin_bit_cast(bf16x8, o); }
        }
        f32x4 gdec[NDT];
        if (!ML) {
#pragma unroll
            for (int dt = 0; dt < NDT; ++dt) gdec[dt] = LRD(f32x4, tabk, T_G + dt * 64);
        }
        if (!(skip & 4))
#pragma unroll
        for (int dt = 0; dt < NDT; ++dt) {
            if (dt + 1 < NDT) { kt[(dt + 1) & 1][0] = LRD(bf16x8, ktfrag, (dt + 1) * 16 * TB_); kt[(dt + 1) & 1][1] = LRD(bf16x8, ktfrag, (dt + 1) * 16 * TB_ + 64); }
            SB();
            if (ML) S[dt] = S[dt] * w_old;
            S[dt] = mfma16(kt[dt & 1][0], Bv[0], S[dt]); S[dt] = mfma16(kt[dt & 1][1], Bv[1], S[dt]);
            if (!ML) S[dt] = S[dt] * gdec[dt];
        }
        if (ML) {
            if (tid < 256) { float a = 0.f; LAS unsigned char* krow = KTs + tid * TB_;
                const int dd = tid & 31, npos = (tid & ~31) + 8 * ((dd & 15) >> 2) + 4 * (dd >> 4) + (dd & 3);
                u32x4 kv[8]; f32x4 w0[8], w1[8];
#pragma unroll
                for (int s8 = 0; s8 < 8; ++s8) { kv[s8] = LRD(u32x4, krow, s8 * 16); w0[s8] = LRD(f32x4, tab, T_W + s8 * 32); w1[s8] = LRD(f32x4, tab, T_W + s8 * 32 + 16); }
                const float nold = LRD(float, tab, T_N + npos * 4);
                SB();
#pragma unroll
                for (int s8 = 0; s8 < 8; ++s8) {
                    a += __uint_as_float(kv[s8].x << 16) * w0[s8].x + __uint_as_float(kv[s8].x & 0xffff0000u) * w0[s8].y + __uint_as_float(kv[s8].y << 16) * w0[s8].z + __uint_as_float(kv[s8].y & 0xffff0000u) * w0[s8].w
                       + __uint_as_float(kv[s8].z << 16) * w1[s8].x + __uint_as_float(kv[s8].z & 0xffff0000u) * w1[s8].y + __uint_as_float(kv[s8].w << 16) * w1[s8].z + __uint_as_float(kv[s8].w & 0xffff0000u) * w1[s8].w; }
                LWR(float, tab, T_N + npos * 4) = w_old * nold + a; }
            m_prev = Btot + Mx;
        }
    }
#undef SB
}
#undef SCAN16_LOAD
#undef SCAN16_LOADKT
#undef LDG
#undef SCAN16_TID
#undef SCAN16_VOQ
#undef SCAN16_VOKT
#undef SCAN16_VOV
DI void p3b_ml_pre(const Params& P, float* ldsf, int bid, int nb) {
    constexpr int DK = 256, QB_ = (DK + 8) * 2;
    LAS unsigned char* L0 = (LAS unsigned char*)ldsf;
    LAS unsigned char* Qs = L0; LAS unsigned char* Ks = Qs + 64 * QB_; LAS unsigned char* tab0 = Ks + 64 * QB_;
    constexpr int T_A = 0, T_CM = 256, T_B = 512, T_DS = 768, T_BT = 1792, T_CL = 2048, TABSZ = 2304;
    const int tid = threadIdx.x, lane = tid & 63, w = __builtin_amdgcn_readfirstlane(tid >> 6), c16 = lane & 15, kg = lane >> 4;
    const int td = __builtin_amdgcn_readfirstlane((tid >> 6) & 1), tl = tid & 63;
    for (int item = bid; item < 256; item += nb) {
        const int o2 = item & 15, h = (item >> 4) & 3, b = item >> 6, c0 = 4 * o2;
        const bf16_t* qg = WSP(bf16_t, WS_QM) + h * DK; const bf16_t* kg_ = WSP(bf16_t, WS_KM) + h * DK;
        __syncthreads();
        if (tid < 128) { const float* mch = WSP(float, WS_MCH) + ((td * 4 + b) * 4 + h) * 64; LWR(float, tab0 + td * TABSZ, T_BT + tl * 4) = mch[tl]; LWR(float, tab0 + td * TABSZ, T_CL + tl * 4) = mch[2048 + tl]; }
        __syncthreads();
        float mpf = 0.f;
        for (int c = 0; c < c0; ++c) mpf = LRD(float, tab0, T_BT + c * 4) + fmaxf(mpf, LRD(float, tab0, T_CL + c * 4));
        float mpb[4];
        { float m = 0.f;
          for (int c = NCH - 1; c > c0 + 3; --c) m = LRD(float, tab0 + TABSZ, T_BT + c * 4) + fmaxf(m, LRD(float, tab0 + TABSZ, T_CL + c * 4));
#pragma unroll
          for (int j = 3; j >= 0; --j) { mpb[j] = m; m = LRD(float, tab0 + TABSZ, T_BT + (c0 + j) * 4) + fmaxf(m, LRD(float, tab0 + TABSZ, T_CL + (c0 + j) * 4)); } }
        u32x4 rq[4], rk[4]; float r0 = 0.f, r1 = 0.f, r2 = 0.f;
#define PRE_LOAD(cc) do { const size_t m0n = (size_t)b * SEQ + (size_t)(cc) * CH; \
        _Pragma("unroll") for (int i = 0; i < 4; ++i) { const int p = tid + i * NTHR, row = p >> 5, c8 = p & 31; \
            rq[i] = *(const u32x4*)(qg + (m0n + row) * 1024 + c8 * 8); rk[i] = *(const u32x4*)(kg_ + (m0n + row) * 1024 + c8 * 8); } \
        if (tid < 128) { const float* msc = WSP(float, WS_MSC) + (size_t)(td * 4 + h) * MTOK; r0 = msc[m0n + tl]; r1 = msc[(size_t)8 * MTOK + m0n + tl]; r2 = msc[(size_t)16 * MTOK + m0n + tl]; } } while (0)
        PRE_LOAD(c0);
#pragma unroll
        for (int j = 0; j < 4; ++j) {
            const int c = c0 + j;
            __syncthreads();
#pragma unroll
            for (int i = 0; i < 4; ++i) { const int p = tid + i * NTHR, row = p >> 5, c8 = p & 31; LWR(u32x4, Qs, row * QB_ + c8 * 16) = rq[i]; LWR(u32x4, Ks, row * QB_ + c8 * 16) = rk[i]; }
            if (tid < 128) { LWR(float, tab0 + td * TABSZ, T_B + tl * 4) = r0; LWR(float, tab0 + td * TABSZ, T_A + tl * 4) = r1; LWR(float, tab0 + td * TABSZ, T_CM + tl * 4) = r2; }
            float mp[2], Mx[2];
            mp[0] = mpf; mp[1] = mpb[j];
#pragma unroll
            for (int d = 0; d < 2; ++d) Mx[d] = fmaxf(mp[d], LRD(float, tab0 + d * TABSZ, T_CL + c * 4));
            __syncthreads();
            if (j + 1 < 4) PRE_LOAD(c + 1);
#pragma unroll
            for (int q2 = 0; q2 < 2; ++q2) {
                const int idx = 2 * w + q2, si = idx >> 2, ti = idx & 3;
                f32x4 X = {0.f, 0.f, 0.f, 0.f};
                { LAS unsigned char* ka = Ks + (16 * si + c16) * QB_ + kg * 16; LAS unsigned char* qa = Qs + (16 * ti + c16) * QB_ + kg * 16;
#pragma unroll
                  for (int ks = 0; ks < DK / 32; ++ks) X = mfma16(LRD(bf16x8, ka, ks * 64), LRD(bf16x8, qa, ks * 64), X); }
                const int t = 16 * ti + c16;
#pragma unroll
                for (int d = 0; d < 2; ++d) {
                    LAS unsigned char* tab = tab0 + d * TABSZ;
                    const bool dead = d ? (si < ti) : (si > ti);
                    const float cmt = fmaxf(mp[d], LRD(float, tab, T_CM + t * 4));
                    const f32x4 av = LRD(f32x4, tab, T_A + (16 * si + 4 * kg) * 4);
                    float v[4], rs = 0.f;
#pragma unroll
                    for (int i = 0; i < 4; ++i) { const int s = 16 * si + 4 * kg + i; const bool keep = !dead && (d ? (s >= t) : (s <= t));
                        const float x = X[i] * __expf(av[i] - cmt); v[i] = keep ? x : 0.f; rs += v[i]; }
                    u32x2 pk; pk.x = cvtpk(v[0], v[1]); pk.y = cvtpk(v[2], v[3]);
                    bf16_t* pg = WSP(bf16_t, WS_PREP) + (size_t)((((d * 4 + b) * 4 + h)) * 64 + c) * 4096;
                    *(u32x2*)(pg + t * 64 + 16 * si + 4 * kg) = pk;
                    rs += __shfl_xor(rs, 16); rs += __shfl_xor(rs, 32);
                    if (kg == 0) LWR(float, tab, T_DS + (si * 64 + t) * 4) = rs;
                }
            }
            __syncthreads();
            if (tid < 128) {
                LAS unsigned char* tab = tab0 + td * TABSZ; const int sidx = (td * 4 + b) * 4 + h;
                const float mpd = td ? mp[1] : mp[0], Mxd = td ? Mx[1] : Mx[0];
                const float cmt = fmaxf(mpd, LRD(float, tab, T_CM + tl * 4));
                float* tg = WSP(float, WS_PRET) + (size_t)(sidx * 64 + c) * 256;
                tg[tl] = __expf(LRD(float, tab, T_A + tl * 4) - Mxd);
                tg[64 + tl] = __expf(mpd - cmt);
                tg[128 + tl] = __expf(-(LRD(float, tab, T_B + tl * 4) + cmt));
                tg[192 + tl] = (LRD(float, tab, T_DS + tl * 4) + LRD(float, tab, T_DS + 256 + tl * 4)) + (LRD(float, tab, T_DS + 512 + tl * 4) + LRD(float, tab, T_DS + 768 + tl * 4));
                if (tl == 0) WSP(float, WS_PRES)[sidx * 64 + c] = __expf(mpd - Mxd);
            }
            mpf = LRD(float, tab0, T_BT + c * 4) + Mx[0];
        }
#undef PRE_LOAD
    }
}

#ifndef FAST_GLA
#define FAST_GLA 1
#endif
#ifndef FAST_ML
#define FAST_ML 0
#endif
DI void p4_scans(const Params& P, float* lds, int bid, int nb, int skip = 0) {
    if (nb >= 256 && bid >= 128) {
        if (!skip) { { SchedKV S{&P, bid - 128}; EpiP1 E{&P}; gemm_run(lds, DM, DM, DM, S, E); } __syncthreads(); p0_prologue(P, lds, bid - 128, nb - 128, 1); }
        return; }
    for (int it = bid; it < 128; it += nb) {
        __syncthreads();
        if (it & 1) scan16<256, true, true>(P, lds, it >> 1, skip);
        else { scan16<128, false, false>(P, lds, it >> 1, skip); if (!skip) { __syncthreads(); p0_prologue(P, lds, it >> 1, 64, 2); } }
    }
    if (nb < 256) { for (int l = bid; l < 64; l += nb) { SchedKV S{&P, l}; EpiP1 E{&P}; gemm_run(lds, DM, DM, DM, S, E); __syncthreads(); } p0_prologue(P, lds, bid, nb, 1); }
}

DI void p5_combine(const Params& P, int bid, int nb) {
    const int lane = threadIdx.x & 63, gw = bid * 8 + (threadIdx.x >> 6), ngw = nb * 8;
    for (int m = gw; m < MTOK; m += ngw) {
        u32x2 a[2][4], bq[2][4], gt[2][4];
#pragma unroll
        for (int mixer = 0; mixer < 2; ++mixer)
#pragma unroll
            for (int h = 0; h < 4; ++h) { const size_t off = (size_t)m * 1024 + h * 256 + lane * 4;
                a[mixer][h] = *(const u32x2*)(obuf(P, mixer * 2) + off); bq[mixer][h] = *(const u32x2*)(obuf(P, mixer * 2 + 1) + off);
                gt[mixer][h] = *(const u32x2*)((mixer ? WSP(bf16_t, WS_MZ) : WSP(bf16_t, WS_GG)) + off); }
#pragma unroll
        for (int mixer = 0; mixer < 2; ++mixer) {
            const float* gn = mixer ? P.in[I_MNORM] : P.in[I_GNORM];
            bf16_t* y = (mixer ? WSP(bf16_t, WS_YB) : WSP(bf16_t, WS_YA)) + (size_t)m * 1024;
#pragma unroll
            for (int h = 0; h < 4; ++h) {
                const int c0 = h * 256 + lane * 4; const u32x2 av = a[mixer][h], bv = bq[mixer][h], gv = gt[mixer][h];
                float v[4], g[4];
                v[0] = bf2f(av.x & 0xffff) + bf2f(bv.x & 0xffff); v[1] = bf2f(av.x >> 16) + bf2f(bv.x >> 16); v[2] = bf2f(av.y & 0xffff) + bf2f(bv.y & 0xffff); v[3] = bf2f(av.y >> 16) + bf2f(bv.y >> 16);
                g[0] = bf2f(gv.x & 0xffff); g[1] = bf2f(gv.x >> 16); g[2] = bf2f(gv.y & 0xffff); g[3] = bf2f(gv.y >> 16);
                const float ss = wave_sum(v[0] * v[0] + v[1] * v[1] + v[2] * v[2] + v[3] * v[3]);
                const float rstd = rsqrtf(ss * (1.f / 256.f) + EPS);
                const f32x4 nw = *(const f32x4*)(gn + c0);
                f32x4 o;
                o.x = v[0] * rstd * nw.x * (mixer ? sigmoidf_(g[0]) : siluf_(g[0])); o.y = v[1] * rstd * nw.y * (mixer ? sigmoidf_(g[1]) : siluf_(g[1]));
                o.z = v[2] * rstd * nw.z * (mixer ? sigmoidf_(g[2]) : siluf_(g[2])); o.w = v[3] * rstd * nw.w * (mixer ? sigmoidf_(g[3]) : siluf_(g[3]));
                st_bf4(y + c0, o);
            }
        }
    }
}

struct SchedP6 {
    const Params* P; int bid, nb;
    DI bool next(int i, Unit& u) const {
        const int L2 = (i >> 1) * nb + bid; if (L2 >= 512) return false;
        const int part = i & 1; u.pm = L2 >> 3; u.pn = L2 & 7; u.kind = part; u.keep = (part == 0); u.aux = 0; u.lda = 1024; u.ldb = 1024;
        u.A = (const bf16_t*)(P->ws + (part ? WS_YB : WS_YA)) + (size_t)u.pm * 256 * 1024;
        u.B = (const bf16_t*)(P->ws + (part ? WS_WB : WS_WA)) + (size_t)u.pn * 256 * 1024;
        return true;
    }
};
struct EpiP6 {
    const Params* Pp;
    DI void operator()(Acc& acc, const Unit& u, int wr, int wc, int fr, int fq) const {
        const Params& P = *Pp;
        const bf16_t* ga = WSP(bf16_t, WS_GA); const bf16_t* gb = WSP(bf16_t, WS_GB); bf16_t* mg = WSP(bf16_t, WS_MERGED);
        ACC_FOREACH3(ai, bj, m) {
            const size_t offw = (size_t)(u.pm * 256 + ACC_ROW(ai, m)) * DM + u.pn * 256 + ACC_COLW(bj);
            u32x2 bb[2]; ld_bf8(gb + offw, bb[0], bb[1]);
            if (u.kind == 0) {
                u32x2 aa[2]; ld_bf8(ga + offw, aa[0], aa[1]);
#pragma unroll
                for (int n = 0; n < 2; ++n) {
                    const u32x2 a = aa[n], b = bb[n];
                    const float eb0 = __expf(-bf2f(b.x & 0xffff)), eb1 = __expf(-bf2f(b.x >> 16)), eb2 = __expf(-bf2f(b.y & 0xffff)), eb3 = __expf(-bf2f(b.y >> 16));
                    const float ea0 = __expf(-bf2f(a.x & 0xffff)), ea1 = __expf(-bf2f(a.x >> 16)), ea2 = __expf(-bf2f(a.y & 0xffff)), ea3 = __expf(-bf2f(a.y >> 16));
                    f32x4& v = acc[ai][bj][m][n];
                    v.x *= (1.f + eb0) * frcp(1.f + ea0); v.y *= (1.f + eb1) * frcp(1.f + ea1); v.z *= (1.f + eb2) * frcp(1.f + ea2); v.w *= (1.f + eb3) * frcp(1.f + ea3);
                }
            } else {
                f32x4 v[2];
#pragma unroll
                for (int n = 0; n < 2; ++n) {
                    const u32x2 b = bb[n];
                    const float eb0 = __expf(-bf2f(b.x & 0xffff)), eb1 = __expf(-bf2f(b.x >> 16)), eb2 = __expf(-bf2f(b.y & 0xffff)), eb3 = __expf(-bf2f(b.y >> 16));
                    v[n] = acc[ai][bj][m][n];
                    v[n].x *= frcp(1.f + eb0); v[n].y *= frcp(1.f + eb1); v[n].z *= frcp(1.f + eb2); v[n].w *= frcp(1.f + eb3);
                }
                st_f8x8((unsigned char*)mg + (size_t)(u.pm * 256 + ACC_ROW(ai, m)) * P8 + u.pn * 256 + ACC_COLW(bj), v[0] * 8.f, v[1] * 8.f);
            }
        }
    }
};

struct SchedRes {
    const Params* P; int bid, nb; size_t a_off, w_off;
    DI bool next(int i, Unit& u) const {
        const int L = i * nb + bid; if (L >= 512) return false;
        u.pm = L >> 3; u.pn = L & 7; u.kind = 0; u.keep = false; u.aux = 0; u.lda = DM; u.ldb = DM;
        u.A = (const bf16_t*)(P->ws + a_off) + (size_t)u.pm * 256 * DM; u.B = (const bf16_t*)(P->ws + w_off) + (size_t)u.pn * 256 * DM;
        return true;
    }
};
template <bool F8AN>
struct EpiResT {
    const Params* Pp; const float* base; const float* gnext; size_t ss_off; float ascale;
    DI void operator()(Acc& acc, const Unit& u, int wr, int wc, int fr, int fq) const {
        const Params& P = *Pp; bf16_t* hb = WSP(bf16_t, WS_H); bf16_t* an = WSP(bf16_t, WS_XN); float* ss = WSP(float, ss_off);
        f32x4 gw[2][2];
#pragma unroll
        for (int bj = 0; bj < 2; ++bj)
#pragma unroll
            for (int n = 0; n < 2; ++n) gw[bj][n] = *(const f32x4*)(gnext + u.pn * 256 + ACC_COL(bj, n));
#pragma unroll
        for (int ai = 0; ai < 2; ++ai)
#pragma unroll
            for (int m = 0; m < 4; ++m) {
                const int row = u.pm * 256 + ACC_ROW(ai, m); float sq = 0.f;
#pragma unroll
                for (int bj = 0; bj < 2; ++bj) {
                    const size_t offw = (size_t)row * DM + u.pn * 256 + ACC_COLW(bj);
                    f32x4 h0, h1;
                    if (F8AN) { h0 = *(const f32x4*)(base + (size_t)row * DM + u.pn * 256 + ACC_COL(bj, 0)); h1 = *(const f32x4*)(base + (size_t)row * DM + u.pn * 256 + ACC_COL(bj, 1)); }
                    else { u32x2 p0, p1; ld_bf8(hb + offw, p0, p1);
                        h0 = (f32x4){bf2f(p0.x & 0xffff), bf2f(p0.x >> 16), bf2f(p0.y & 0xffff), bf2f(p0.y >> 16)}; h1 = (f32x4){bf2f(p1.x & 0xffff), bf2f(p1.x >> 16), bf2f(p1.y & 0xffff), bf2f(p1.y >> 16)}; }
                    h0 += acc[ai][bj][m][0] * ascale; h1 += acc[ai][bj][m][1] * ascale;
                    sq += h0.x * h0.x + h0.y * h0.y + h0.z * h0.z + h0.w * h0.w; sq += h1.x * h1.x + h1.y * h1.y + h1.z * h1.z + h1.w * h1.w;
                    const f32x4 a0 = h0 * gw[bj][0], a1 = h1 * gw[bj][1];
                    if (F8AN) st_f8x8((unsigned char*)an + offw, a0, a1); else st_bf8(an + offw, a0, a1);
                    st_bf8(hb + offw, h0, h1);
                }
                sq += __shfl_xor(sq, 16); sq += __shfl_xor(sq, 32);
                if (fq == 0) ss[(size_t)row * 32 + u.pn * 4 + wc] = sq;
            }
    }
};
DI float row_rstd(const float* ss, int row) {
    float s = 0.f;
#pragma unroll
    for (int i = 0; i < 32; i += 4) { const f32x4 v = *(const f32x4*)(ss + (size_t)row * 32 + i); s += (v.x + v.y) + (v.z + v.w); }
    return rsqrtf(s * (1.f / DM) + EPS);
}

struct EpiQ {
    const Params* Pp;
    DI void operator()(Acc& acc, const Unit& u, int wr, int wc, int fr, int fq) const {
        const Params& P = *Pp; bf16_t* q = WSP(bf16_t, WS_ATTQ); const float* ss = WSP(float, WS_SS1);
#pragma unroll
        for (int ai = 0; ai < 2; ++ai)
#pragma unroll
            for (int m = 0; m < 4; ++m) {
                const int row = u.pm * 256 + ACC_ROW(ai, m); const float sc = row_rstd(ss, row) * 0.04419417382415922f;
#pragma unroll
                for (int bj = 0; bj < 2; ++bj)
#pragma unroll
                    for (int n = 0; n < 2; ++n) st_bf4(q + (size_t)row * DM + u.pn * 256 + ACC_COL(bj, n), acc[ai][bj][m][n] * sc);
            }
    }
};
struct SchedSc {
    const Params* P; int bid, nb;
    DI bool next(int i, Unit& u) const {
        const int L = i * nb + bid; if (L >= 256) return false;
        u.pm = L >> 2; u.pn = L & 3; u.kind = 0; u.keep = false; u.aux = L; u.lda = DM; u.ldb = DM;
        u.A = (const bf16_t*)(P->ws + WS_ATTQ) + (size_t)u.pm * 256 * DM + u.pn * 512;
        u.B = (const bf16_t*)(P->ws + WS_KMEM) + (size_t)(u.pm >> 4) * 256 * DM + u.pn * 512;
        return true;
    }
};
struct EpiSc {
    const Params* Pp;
    DI void operator()(Acc& acc, const Unit& u, int wr, int wc, int fr, int fq) const {
        const Params& P = *Pp; float* sc = WSP(float, WS_SC) + (size_t)u.aux * 65536;
        ACC_FOREACH(ai, bj, m, n) *(f32x4*)(sc + (size_t)ACC_ROW(ai, m) * 256 + ACC_COL(bj, n)) = acc[ai][bj][m][n];
    }
};
DI void p10_softmax(const Params& P, int bid, int nb) {
    const int lane = threadIdx.x & 63, gw = bid * 8 + (threadIdx.x >> 6), ngw = nb * 8;
    for (int r = gw; r < 65536; r += ngw) {
        const f32x4 v = *(const f32x4*)(WSP(float, WS_SC) + (size_t)r * 256 + lane * 4);
        float mx = fmaxf(fmaxf(v.x, v.y), fmaxf(v.z, v.w));
#pragma unroll
        for (int o = 1; o < 64; o <<= 1) mx = fmaxf(mx, __shfl_xor(mx, o));
        f32x4 e; e.x = __expf(v.x - mx); e.y = __expf(v.y - mx); e.z = __expf(v.z - mx); e.w = __expf(v.w - mx);
        const float inv = frcp(wave_sum(e.x + e.y + e.z + e.w));
        st_bf4(WSP(bf16_t, WS_P) + (size_t)r * 256 + lane * 4, e * inv);
    }
}
struct SchedPV {
    const Params* P; int bid, nb;
    DI bool next(int i, Unit& u) const {
        const int L = i * nb + bid; if (L >= 512) return false;
        const int su = L >> 1, nt = L & 1; u.pm = su >> 2; u.pn = (su & 3) * 2 + nt; u.kind = 0; u.keep = false; u.aux = 0; u.lda = 256; u.ldb = 256;
        u.A = (const bf16_t*)(P->ws + WS_P) + (size_t)su * 65536;
        u.B = (const bf16_t*)(P->ws + WS_VTMEM) + (size_t)(u.pm >> 4) * DM * 256 + (size_t)u.pn * 256 * 256;
        return true;
    }
};
struct EpiPV {
    const Params* Pp;
    DI void operator()(Acc& acc, const Unit& u, int wr, int wc, int fr, int fq) const {
        const Params& P = *Pp; bf16_t* o = WSP(bf16_t, WS_ATTO);
        ACC_FOREACH(ai, bj, m, n) st_bf4(o + (size_t)(u.pm * 256 + ACC_ROW(ai, m)) * DM + u.pn * 256 + ACC_COL(bj, n), acc[ai][bj][m][n]);
    }
};

struct SchedFold {
    const Params* P; int bid, nb;
    DI bool next(int i, Unit& u) const {
        const int L = i * nb + bid; if (L >= 256) return false;
        u.keep = false; u.lda = DM; u.ldb = DM; u.aux = 0;
        if (L < 128) { const int b = L >> 5, h = (L >> 3) & 3, kt = L & 7; u.kind = 0; u.pm = b * 4 + h; u.pn = kt;
            u.A = (const bf16_t*)(P->ws + WS_KMEM) + (size_t)(b * 256) * DM + h * 512; u.B = (const bf16_t*)(P->ws + WS_WXQ) + (size_t)(kt * 256) * DM + h * 512; }
        else { const int l = L - 128, b = l >> 5, dt = (l >> 2) & 7, h = l & 3; u.kind = 1; u.pm = b * 8 + dt; u.pn = h;
            u.A = (const bf16_t*)(P->ws + WS_WXO) + (size_t)(dt * 256) * DM + h * 512; u.B = (const bf16_t*)(P->ws + WS_VTMEM) + (size_t)(b * 256) * DM + h * 512; }
        return true;
    }
};
struct EpiFold {
    const Params* Pp;
    DI void operator()(Acc& acc, const Unit& u, int wr, int wc, int fr, int fq) const {
        const Params& P = *Pp;
        if (u.kind == 0) { unsigned char* d = WSP(unsigned char, WS_WKT) + (size_t)u.pm * 256 * DM + u.pn * 256;
            ACC_FOREACH3(ai, bj, m) st_f8x8(d + (size_t)ACC_ROW(ai, m) * DM + ACC_COLW(bj), acc[ai][bj][m][0], acc[ai][bj][m][1]); }
        else { unsigned char* d = WSP(unsigned char, WS_VWT) + (size_t)u.pm * 256 * 1024 + u.pn * 256;
            ACC_FOREACH3(ai, bj, m) st_f8x8(d + (size_t)ACC_ROW(ai, m) * 1024 + ACC_COLW(bj), acc[ai][bj][m][0], acc[ai][bj][m][1]); }
    }
};
struct SchedSc2 {
    const Params* P; int bid, nb;
    DI bool next(int i, Unit& u) const {
        const int L = i * nb + bid; if (L >= 256) return false;
        u.pm = L >> 2; u.pn = L & 3; u.kind = 0; u.keep = false; u.aux = L; u.lda = DM; u.ldb = DM;
        u.A = (const bf16_t*)(P->ws + WS_XN) + (size_t)u.pm * 256 * DM;
        u.B = (const bf16_t*)(P->ws + WS_WKT) + (size_t)((u.pm >> 4) * 4 + u.pn) * 256 * DM;
        return true;
    }
};
struct EpiSc2 {
    const Params* Pp;
    DI void operator()(Acc& acc, const Unit& u, int wr, int wc, int fr, int fq) const {
        const Params& P = *Pp; float* sc = WSP(float, WS_SC) + (size_t)u.aux * 65536; const float* ss = WSP(float, WS_SS1);
#pragma unroll
        for (int ai = 0; ai < 2; ++ai)
#pragma unroll
            for (int m = 0; m < 4; ++m) {
                const int r = ACC_ROW(ai, m); const float s = row_rstd(ss, u.pm * 256 + r) * 0.04419417382415922f;
#pragma unroll
                for (int bj = 0; bj < 2; ++bj)
#pragma unroll
                    for (int n = 0; n < 2; ++n) *(f32x4*)(sc + (size_t)r * 256 + ACC_COL(bj, n)) = acc[ai][bj][m][n] * s;
            }
    }
};
struct SchedSc1u { const Params* P; int su;
    DI bool next(int i, Unit& u) const {
        if (i > 0) return false;
        u.pm = su >> 2; u.pn = su & 3; u.kind = 0; u.keep = false; u.aux = su; u.lda = DM; u.ldb = DM;
        u.A = (const bf16_t*)(P->ws + WS_XN + (size_t)u.pm * 256 * DM);
        u.B = (const bf16_t*)(P->ws + WS_WKT + (size_t)((u.pm >> 4) * 4 + u.pn) * 256 * DM);
        return true; } };
struct EpiScSoftmax {
    const Params* Pp;
    DI void operator()(Acc&, const Unit&, int, int, int, int) const {}
    DI void fused(Acc& acc, const Unit& u, int wr, int wc, int fr, int fq, LAS unsigned char* lds) const {
        const Params& P = *Pp; const float* ss = WSP(float, WS_SS1);
        LAS float* X = (LAS float*)lds;
        LAS float* R = (LAS float*)(lds + 4096);
        { const int t = threadIdx.x; const float* p = ss + (size_t)(u.pm * 256 + (t >> 1)) * 32 + (t & 1) * 16;
          const f32x4 a = *(const f32x4*)p, b = *(const f32x4*)(p + 4), c = *(const f32x4*)(p + 8), d = *(const f32x4*)(p + 12);
          float s = ((a.x + a.y) + (a.z + a.w)) + ((b.x + b.y) + (b.z + b.w)) + ((c.x + c.y) + (c.z + c.w)) + ((d.x + d.y) + (d.z + d.w));
          s += __shfl_xor(s, 1);
          if (!(t & 1)) R[t >> 1] = rsqrtf(s * (1.f / DM) + EPS) * 0.04419417382415922f; }
        asm volatile("s_waitcnt lgkmcnt(0)" ::: "memory"); __builtin_amdgcn_s_barrier(); asm volatile("" ::: "memory");
        float rmax[2][4];
#pragma unroll
        for (int ai = 0; ai < 2; ++ai)
#pragma unroll
            for (int m = 0; m < 4; ++m) {
                const int r = ACC_ROW(ai, m); const float s = R[r];
                float mx = -INFINITY;
#pragma unroll
                for (int bj = 0; bj < 2; ++bj)
#pragma unroll
                    for (int n = 0; n < 2; ++n) { f32x4& v = acc[ai][bj][m][n]; v = v * s; mx = fmaxf(mx, fmaxf(fmaxf(v.x, v.y), fmaxf(v.z, v.w))); }
                mx = fmaxf(mx, __shfl_xor(mx, 16)); mx = fmaxf(mx, __shfl_xor(mx, 32));
                if (fq == 0) X[r * 4 + wc] = mx;
                rmax[ai][m] = mx;
            }
        asm volatile("s_waitcnt lgkmcnt(0)" ::: "memory"); __builtin_amdgcn_s_barrier(); asm volatile("" ::: "memory");
        float rsum[2][4];
#pragma unroll
        for (int ai = 0; ai < 2; ++ai)
#pragma unroll
            for (int m = 0; m < 4; ++m) {
                const int r = ACC_ROW(ai, m); const f32x4 q = *(const LAS f32x4*)(X + r * 4); const float mx = fmaxf(fmaxf(q.x, q.y), fmaxf(q.z, q.w));
                float sm = 0.f;
#pragma unroll
                for (int bj = 0; bj < 2; ++bj)
#pragma unroll
                    for (int n = 0; n < 2; ++n) { f32x4& v = acc[ai][bj][m][n]; v.x = __expf(v.x - mx); v.y = __expf(v.y - mx); v.z = __expf(v.z - mx); v.w = __expf(v.w - mx); sm += (v.x + v.y) + (v.z + v.w); }
                sm += __shfl_xor(sm, 16); sm += __shfl_xor(sm, 32);
                rsum[ai][m] = sm;
            }
        asm volatile("s_waitcnt lgkmcnt(0)" ::: "memory"); __builtin_amdgcn_s_barrier(); asm volatile("" ::: "memory");
#pragma unroll
        for (int ai = 0; ai < 2; ++ai)
#pragma unroll
            for (int m = 0; m < 4; ++m) if (fq == 0) X[ACC_ROW(ai, m) * 4 + wc] = rsum[ai][m];
        asm volatile("s_waitcnt lgkmcnt(0)" ::: "memory"); __builtin_amdgcn_s_barrier(); asm volatile("" ::: "memory");
        unsigned char* pc = WSP(unsigned char, WS_P) + (size_t)(u.pm * 256) * 1024 + u.pn * 256;
#pragma unroll
        for (int ai = 0; ai < 2; ++ai)
#pragma unroll
            for (int m = 0; m < 4; ++m) {
                const int r = ACC_ROW(ai, m); const f32x4 q = *(const LAS f32x4*)(X + r * 4); const float inv = 256.f * frcp((q.x + q.y) + (q.z + q.w));
#pragma unroll
                for (int bj = 0; bj < 2; ++bj)
                    st_f8x8(pc + (size_t)r * 1024 + ACC_COLW(bj), acc[ai][bj][m][0] * inv, acc[ai][bj][m][1] * inv);
            }
        asm volatile("s_waitcnt lgkmcnt(0)" ::: "memory"); __builtin_amdgcn_s_barrier(); asm volatile("" ::: "memory");
    }
};
DI void p10_softmax_cat(const Params& P, int bid, int nb) {
    const int lane = threadIdx.x & 63, gw = bid * 8 + (threadIdx.x >> 6), ngw = nb * 8;
    for (int r = gw; r < 65536; r += ngw) {
        const int su = r >> 8, rr = r & 255, pm = su >> 2, h = su & 3;
        const f32x4 v = *(const f32x4*)(WSP(float, WS_SC) + (size_t)r * 256 + lane * 4);
        float mx = fmaxf(fmaxf(v.x, v.y), fmaxf(v.z, v.w));
#pragma unroll
        for (int o = 1; o < 64; o <<= 1) mx = fmaxf(mx, __shfl_xor(mx, o));
        f32x4 e; e.x = __expf(v.x - mx); e.y = __expf(v.y - mx); e.z = __expf(v.z - mx); e.w = __expf(v.w - mx);
        const float inv = frcp(wave_sum(e.x + e.y + e.z + e.w));
        st_bf4(WSP(bf16_t, WS_P) + (size_t)(pm * 256 + rr) * 1024 + h * 256 + lane * 4, e * inv);
    }
}
struct SchedMix {
    const Params* P; int bid, nb;
    DI bool next(int i, Unit& u) const {
        const int L = i * nb + bid; if (L >= 512) return false;
        u.pm = L >> 3; u.pn = L & 7; u.kind = 0; u.keep = false; u.aux = 0; u.lda = P8; u.ldb = P8;
        u.A = (const bf16_t*)(P->ws + WS_MERGED + (size_t)u.pm * 256 * P8); u.B = (const bf16_t*)(P->ws + WS_WMIX + (size_t)u.pn * 256 * P8);
        return true;
    }
};
struct SchedO {
    const Params* P; int bid, nb;
    DI bool next(int i, Unit& u) const {
        const int L = i * nb + bid; if (L >= 512) return false;
        u.pm = L >> 3; u.pn = L & 7; u.kind = 0; u.keep = false; u.aux = 0; u.lda = 1024; u.ldb = 1024;
        u.A = (const bf16_t*)(P->ws + WS_P + (size_t)u.pm * 256 * 1024);
        u.B = (const bf16_t*)(P->ws + WS_VWT + ((size_t)(u.pm >> 4) * DM + (size_t)u.pn * 256) * 1024);
        return true;
    }
};

struct SchedRt {
    const Params* P; int bid, nb;
    DI bool next(int i, Unit& u) const {
        const int L = i * nb + bid; if (L >= 256) return false;
        u.pm = L >> 2; u.pn = 0; u.kind = 0; u.keep = false; u.aux = L & 3; u.lda = DM; u.ldb = DM;
        u.A = (const bf16_t*)(P->ws + WS_XN) + (size_t)u.pm * 256 * DM + u.aux * 512; u.B = (const bf16_t*)(P->ws + WS_WR) + u.aux * 512;
        return true;
    }
};
struct EpiRt {
    const Params* Pp;
    DI void operator()(Acc& acc, const Unit& u, int wr, int wc, int fr, int fq) const {
        const Params& P = *Pp; float* lg = WSP(float, WS_SC) + (size_t)u.aux * MTOK * 64; const float* ss = WSP(float, WS_SS2);
#pragma unroll
        for (int ai = 0; ai < 2; ++ai)
#pragma unroll
            for (int m = 0; m < 4; ++m) {
                const int row = u.pm * 256 + ACC_ROW(ai, m); const float rs = row_rstd(ss, row);
#pragma unroll
                for (int n = 0; n < 2; ++n) { const int c = ACC_COL(0, n); if (c < 64) *(f32x4*)(lg + (size_t)row * 64 + c) = acc[ai][0][m][n] * rs; }
            }
    }
};
DI void p13_route_fused(const Params& P, float* lds, int bid, int nb) {
    const int tid = threadIdx.x, lane = tid & 63, wave = tid >> 6, c16 = lane & 15, kg = lane >> 4;
    float* part = lds; float* lg = lds + 8 * 64 * 48;
    unsigned* lcnt = (unsigned*)(lds + 8 * 64 * 48 + 64 * 48); unsigned* lbase = lcnt + 32; float* rsl = (float*)(lbase + 32);
    unsigned* cnt = WSP(unsigned, WS_CTL) + CW_CNT;
    int* toke = WSP(int, WS_ROUTE) + RT_TOKE; int* toki = WSP(int, WS_ROUTE) + RT_TOKI; float* tokw = WSP(float, WS_ROUTE) + RT_TOKW;
    for (int ib = bid; ib < MTOK / 64; ib += nb) {
        const size_t m0 = (size_t)ib * 64;
        __syncthreads();
        if (tid < 32) lcnt[tid] = 0u;
        if (tid < 128) {
            const float* p = WSP(float, WS_SS2) + (m0 + (tid >> 1)) * 32 + (tid & 1) * 16;
            const f32x4 a = *(const f32x4*)p, b = *(const f32x4*)(p + 4), c = *(const f32x4*)(p + 8), d = *(const f32x4*)(p + 12);
            float s = ((a.x + a.y) + (a.z + a.w)) + ((b.x + b.y) + (b.z + b.w)) + ((c.x + c.y) + (c.z + c.w)) + ((d.x + d.y) + (d.z + d.w));
            s += __shfl_xor(s, 1);
            if (!(tid & 1)) { const float r = rsqrtf(s * (1.f / DM) + EPS); rsl[tid >> 1] = r; WSP(float, WS_ROUTE)[RT_TOKRS + m0 + (tid >> 1)] = r; } }
        {
            const bf16_t* xa = WSP(bf16_t, WS_XN) + (m0 + c16) * DM + wave * 256 + 8 * kg;
            const bf16_t* wb = WSP(bf16_t, WS_WR) + (size_t)c16 * DM + wave * 256 + 8 * kg;
            f32x4 acc[4][3];
#pragma unroll
            for (int mt = 0; mt < 4; ++mt)
#pragma unroll
                for (int nt = 0; nt < 3; ++nt) acc[mt][nt] = (f32x4){0.f, 0.f, 0.f, 0.f};
#pragma unroll
            for (int k2 = 0; k2 < 4; ++k2) {
                bf16x8 fa[2][4], fb[2][3];
#pragma unroll
                for (int q = 0; q < 2; ++q) {
#pragma unroll
                    for (int mt = 0; mt < 4; ++mt) fa[q][mt] = *(const bf16x8*)(xa + (size_t)(16 * mt) * DM + (2 * k2 + q) * 32);
#pragma unroll
                    for (int nt = 0; nt < 3; ++nt) fb[q][nt] = *(const bf16x8*)(wb + (size_t)(16 * nt) * DM + (2 * k2 + q) * 32);
                }
#pragma unroll
                for (int q = 0; q < 2; ++q)
#pragma unroll
                    for (int mt = 0; mt < 4; ++mt)
#pragma unroll
                        for (int nt = 0; nt < 3; ++nt) acc[mt][nt] = __builtin_amdgcn_mfma_f32_16x16x32_bf16(fa[q][mt], fb[q][nt], acc[mt][nt], 0, 0, 0);
            }
#pragma unroll
            for (int mt = 0; mt < 4; ++mt)
#pragma unroll
                for (int nt = 0; nt < 3; ++nt)
#pragma unroll
                    for (int i = 0; i < 4; ++i) part[(wave * 64 + 16 * mt + 4 * kg + i) * 48 + 16 * nt + c16] = acc[mt][nt][i];
        }
        __syncthreads();
        for (int i = tid; i < 64 * 48; i += NTHR) { float s = 0.f;
#pragma unroll
            for (int w8 = 0; w8 < 8; ++w8) s += part[w8 * 3072 + i];
            lg[i] = s * rsl[i / 48]; }
        __syncthreads();
        int re0 = 0, re1 = 0; unsigned rk0 = 0u, rk1 = 0u;
        if (tid < 64) {
            const int t = (int)m0 + tid; const float* l = lg + tid * 48;
            float gl[4]; int gs = 0; float gm = -INFINITY;
#pragma unroll
            for (int g = 0; g < 4; ++g) { gl[g] = l[32 + g] + P.in[I_BGRP][g]; if (gl[g] > gm) { gm = gl[g]; gs = g; } }
            float gsum = 0.f;
#pragma unroll
            for (int g = 0; g < 4; ++g) gsum += __expf(gl[g] - gm);
            const float pg = 1.f / gsum;
            float el[8]; float em = -INFINITY;
#pragma unroll
            for (int e = 0; e < 8; ++e) { el[e] = l[gs * 8 + e] + P.in[I_BRT][gs * 8 + e]; em = fmaxf(em, el[e]); }
            int i0 = 0; float p0 = -1.f; float ep[8];
#pragma unroll
            for (int e = 0; e < 8; ++e) ep[e] = __expf(el[e] - em);
#pragma unroll
            for (int e = 0; e < 8; ++e) if (ep[e] > p0) { p0 = ep[e]; i0 = e; }
            int i1 = 0; float p1 = -1.f;
#pragma unroll
            for (int e = 0; e < 8; ++e) if (e != i0 && ep[e] > p1) { p1 = ep[e]; i1 = e; }
            const float w0 = pg * p0 / (p0 + p1), w1 = pg * p1 / (p0 + p1);
            const int e0 = gs * 8 + i0, e1 = gs * 8 + i1;
            toke[t * 2] = e0; toke[t * 2 + 1] = e1; tokw[t * 2] = w0; tokw[t * 2 + 1] = w1;
            re0 = e0; re1 = e1; rk0 = atomicAdd(&lcnt[e0], 1u); rk1 = atomicAdd(&lcnt[e1], 1u);
        }
        __syncthreads();
        if (tid < 32) { const unsigned n = lcnt[tid]; lbase[tid] = n ? atomicAdd(&cnt[tid * 32], n) : 0u; }
        __syncthreads();
        if (tid < 64) { const int t = (int)m0 + tid; toki[t * 2] = (int)(lbase[re0] + rk0); toki[t * 2 + 1] = (int)(lbase[re1] + rk1); }
    }
}
DI void p14_route(const Params& P, int bid, int nb) {
    const int gt = bid * NTHR + threadIdx.x, ngt = nb * NTHR;
    unsigned* cnt = WSP(unsigned, WS_CTL) + CW_CNT;
    int* toke = WSP(int, WS_ROUTE) + RT_TOKE; int* toki = WSP(int, WS_ROUTE) + RT_TOKI; float* tokw = WSP(float, WS_ROUTE) + RT_TOKW;
    for (int t = gt; t < MTOK; t += ngt) {
        const float* lg = WSP(float, WS_SC) + (size_t)t * 64; constexpr size_t LP = (size_t)MTOK * 64;
        float gl[4]; int gs = 0; float gm = -INFINITY;
        { const f32x4 g0 = *(const f32x4*)(lg + 32), g1 = *(const f32x4*)(lg + LP + 32), g2 = *(const f32x4*)(lg + 2 * LP + 32), g3 = *(const f32x4*)(lg + 3 * LP + 32);
          const f32x4 gsum4 = (g0 + g1) + (g2 + g3); gl[0] = gsum4.x; gl[1] = gsum4.y; gl[2] = gsum4.z; gl[3] = gsum4.w; }
#pragma unroll
        for (int g = 0; g < 4; ++g) { gl[g] += P.in[I_BGRP][g]; if (gl[g] > gm) { gm = gl[g]; gs = g; } }
        float gsum = 0.f;
#pragma unroll
        for (int g = 0; g < 4; ++g) gsum += __expf(gl[g] - gm);
        const float pg = 1.f / gsum;
        float el[8]; float em = -INFINITY;
#pragma unroll
        for (int e = 0; e < 8; ++e) { const float* q = lg + gs * 8 + e; el[e] = ((q[0] + q[LP]) + (q[2 * LP] + q[3 * LP])) + P.in[I_BRT][gs * 8 + e]; em = fmaxf(em, el[e]); }
        int i0 = 0; float p0 = -1.f, esum = 0.f; float ep[8];
#pragma unroll
        for (int e = 0; e < 8; ++e) { ep[e] = __expf(el[e] - em); esum += ep[e]; }
#pragma unroll
        for (int e = 0; e < 8; ++e) if (ep[e] > p0) { p0 = ep[e]; i0 = e; }
        int i1 = 0; float p1 = -1.f;
#pragma unroll
        for (int e = 0; e < 8; ++e) if (e != i0 && ep[e] > p1) { p1 = ep[e]; i1 = e; }
        const float w0 = pg * p0 / (p0 + p1), w1 = pg * p1 / (p0 + p1);
        const int e0 = gs * 8 + i0, e1 = gs * 8 + i1;
        toke[t * 2] = e0; toke[t * 2 + 1] = e1; tokw[t * 2] = w0; tokw[t * 2 + 1] = w1;
        toki[t * 2] = (int)atomicAdd(&cnt[e0 * 32], 1u); toki[t * 2 + 1] = (int)atomicAdd(&cnt[e1 * 32], 1u);
    }
}
DI LAS int* tstab(float* lds) { return (LAS int*)((LAS unsigned char*)lds + 131072); }
DI void fill_tstab(const Params& P, float* lds) {
    if (threadIdx.x < 64) { const int lane = threadIdx.x; const unsigned* cnt = WSP(unsigned, WS_CTL) + CW_CNT;
        int v = lane < 32 ? (((int)cnt[lane * 32] + 255) >> 8) : 0;
#pragma unroll
        for (int o = 1; o < 64; o <<= 1) { const int t = __shfl_up(v, o); if (lane >= o) v += t; }
        if (lane < 32) tstab(lds)[lane + 1] = v; if (lane == 0) tstab(lds)[0] = 0; }
    __syncthreads();
}
DI void p15_gather(const Params& P, float* lds, int bid, int nb) {
    fill_tstab(P, lds); const LAS int* ts = tstab(lds);
    const int lane = threadIdx.x & 63, gw = bid * 8 + (threadIdx.x >> 6), ngw = nb * 8;
    const unsigned* cnt = WSP(unsigned, WS_CTL) + CW_CNT;
    const int* toke = WSP(int, WS_ROUTE) + RT_TOKE; const int* toki = WSP(int, WS_ROUTE) + RT_TOKI; const float* tokw = WSP(float, WS_ROUTE) + RT_TOKW;
    float* rowrs = WSP(float, WS_ROUTE) + RT_ROWRS; float* roww = WSP(float, WS_ROUTE) + RT_ROWW;
    for (int a = gw; a < MTOK * 2; a += ngw) {
        const int t = a >> 1, e = toke[a];
        const int row = ts[e] * 256 + toki[a];
        const u32x4* src = (const u32x4*)(WSP(bf16_t, WS_XN) + (size_t)t * DM); u32x2* dst = (u32x2*)(WSP(unsigned char, WS_XROWS) + (size_t)row * DM);
        u32x4 v[4];
#pragma unroll
        for (int j = 0; j < 4; ++j) v[j] = src[lane + 64 * j];
#pragma unroll
        for (int j = 0; j < 4; ++j) { u32x2 o;
            o.x = pk4_f8(__uint_as_float(v[j].x << 16), __uint_as_float(v[j].x & 0xffff0000u), __uint_as_float(v[j].y << 16), __uint_as_float(v[j].y & 0xffff0000u));
            o.y = pk4_f8(__uint_as_float(v[j].z << 16), __uint_as_float(v[j].z & 0xffff0000u), __uint_as_float(v[j].w << 16), __uint_as_float(v[j].w & 0xffff0000u));
            dst[lane + 64 * j] = o; }
        if (lane == 0) { rowrs[row] = WSP(float, WS_ROUTE)[RT_TOKRS + t]; roww[row] = tokw[a]; }
    }
}
struct SchedExp {
    const Params* P; int bid, nb; int down; const LAS int* ts;
    DI bool next(int i, Unit& u) const {
        const int npn = down ? 8 : 4; const int L = i * nb + bid; const int T = L / npn; u.pn = L % npn;
        if (T >= ts[32]) return false;
        int e = 0;
#pragma unroll
        for (int s = 16; s > 0; s >>= 1) if (ts[e + s] <= T) e += s;
        while (ts[e + 1] <= T) ++e;
        u.pm = T; u.kind = 0; u.keep = false; u.aux = e;
        if (!down) { u.lda = DM; u.ldb = DM; u.A = (const bf16_t*)(P->ws + WS_XROWS + (size_t)T * 256 * DM); u.B = (const bf16_t*)(P->ws + WS_WGU + ((size_t)e * 1024 + u.pn * 256) * DM); }
        else { u.lda = DEXP; u.ldb = DEXP; u.A = (const bf16_t*)(P->ws + WS_HID + (size_t)T * 256 * DEXP); u.B = (const bf16_t*)(P->ws + WS_WD + ((size_t)e * DM + u.pn * 256) * DEXP); }
        return true;
    }
};
struct EpiGU {
    const Params* Pp;
    DI void operator()(Acc& acc, const Unit& u, int wr, int wc, int fr, int fq) const {
        const Params& P = *Pp; bf16_t* hid = WSP(bf16_t, WS_HID); const float* rowrs = WSP(float, WS_ROUTE) + RT_ROWRS;
#pragma unroll
        for (int ai = 0; ai < 2; ++ai)
#pragma unroll
            for (int m = 0; m < 4; ++m) {
                const int row = u.pm * 256 + ACC_ROW(ai, m); const float rs = rowrs[row];
                f32x4 o[2];
#pragma unroll
                for (int n = 0; n < 2; ++n) {
                    const f32x4 g = acc[ai][0][m][n] * (rs * (1.f / 64.f)), up = acc[ai][1][m][n] * (rs * (1.f / 64.f));
                    o[n].x = siluf_(g.x) * up.x; o[n].y = siluf_(g.y) * up.y; o[n].z = siluf_(g.z) * up.z; o[n].w = siluf_(g.w) * up.w;
                }
                st_f8x8((unsigned char*)hid + (size_t)row * DEXP + u.pn * 128 + ACC_COLW(0), o[0], o[1]);
            }
    }
};
struct EpiDown {
    const Params* Pp;
    DI void operator()(Acc& acc, const Unit& u, int wr, int wc, int fr, int fq) const {
        const Params& P = *Pp; bf16_t* y = WSP(bf16_t, WS_YROWS); const float* roww = WSP(float, WS_ROUTE) + RT_ROWW;
#pragma unroll
        for (int ai = 0; ai < 2; ++ai)
#pragma unroll
            for (int m = 0; m < 4; ++m) {
                const int row = u.pm * 256 + ACC_ROW(ai, m); const float w = roww[row] * (1.f / 32.f);
#pragma unroll
                for (int bj = 0; bj < 2; ++bj)
                    st_bf8(y + (size_t)row * DM + u.pn * 256 + ACC_COLW(bj), acc[ai][bj][m][0] * w, acc[ai][bj][m][1] * w);
            }
    }
};
DI void p18_final(const Params& P, float* lds, int bid, int nb) {
    fill_tstab(P, lds); const LAS int* ts = tstab(lds);
    const int lane = threadIdx.x & 63, gw = bid * 8 + (threadIdx.x >> 6), ngw = nb * 8;
    const unsigned* cnt = WSP(unsigned, WS_CTL) + CW_CNT;
    const int* toke = WSP(int, WS_ROUTE) + RT_TOKE; const int* toki = WSP(int, WS_ROUTE) + RT_TOKI;
    f32x4 g[4][2];
#pragma unroll
    for (int j = 0; j < 4; ++j) { g[j][0] = *(const f32x4*)(P.in[I_NFIN] + 512 * j + 8 * lane); g[j][1] = *(const f32x4*)(P.in[I_NFIN] + 512 * j + 8 * lane + 4); }
    for (int t = gw; t < MTOK; t += ngw) {
        const int r0 = ts[toke[2 * t]] * 256 + toki[2 * t], r1 = ts[toke[2 * t + 1]] * 256 + toki[2 * t + 1];
        const bf16_t* y0 = WSP(bf16_t, WS_YROWS) + (size_t)r0 * DM; const bf16_t* y1 = WSP(bf16_t, WS_YROWS) + (size_t)r1 * DM;
        float* o = P.out + (size_t)t * DM; const bf16_t* hb = WSP(bf16_t, WS_H) + (size_t)t * DM;
        f32x4 v[4][2]; float s = 0.f;
#pragma unroll
        for (int j = 0; j < 4; ++j) { const int c = 512 * j + 8 * lane; const u32x4 a = *(const u32x4*)(y0 + c), b = *(const u32x4*)(y1 + c), hh = *(const u32x4*)(hb + c);
            f32x4 h0, h1;
            h0.x = bf2f(hh.x & 0xffff) + bf2f(a.x & 0xffff) + bf2f(b.x & 0xffff); h0.y = bf2f(hh.x >> 16) + bf2f(a.x >> 16) + bf2f(b.x >> 16);
            h0.z = bf2f(hh.y & 0xffff) + bf2f(a.y & 0xffff) + bf2f(b.y & 0xffff); h0.w = bf2f(hh.y >> 16) + bf2f(a.y >> 16) + bf2f(b.y >> 16);
            h1.x = bf2f(hh.z & 0xffff) + bf2f(a.z & 0xffff) + bf2f(b.z & 0xffff); h1.y = bf2f(hh.z >> 16) + bf2f(a.z >> 16) + bf2f(b.z >> 16);
            h1.z = bf2f(hh.w & 0xffff) + bf2f(a.w & 0xffff) + bf2f(b.w & 0xffff); h1.w = bf2f(hh.w >> 16) + bf2f(a.w >> 16) + bf2f(b.w >> 16);
            v[j][0] = h0; v[j][1] = h1; s += h0.x * h0.x + h0.y * h0.y + h0.z * h0.z + h0.w * h0.w + h1.x * h1.x + h1.y * h1.y + h1.z * h1.z + h1.w * h1.w; }
        const float rstd = rsqrtf(wave_sum(s) * (1.f / DM) + EPS);
#pragma unroll
        for (int j = 0; j < 4; ++j) { const int c = 512 * j + 8 * lane; *(f32x4*)(o + c) = v[j][0] * rstd * g[j][0]; *(f32x4*)(o + c + 4) = v[j][1] * rstd * g[j][1]; }
    }
}

constexpr int N_PHASES = 19;
#define XB_TMO      128
#define XB_XCNT(j)  (256  + 64 * (j))
#define XB_XSUB(j)  (1280 + 64 * (j))
#define XB_XGEN(j)  (2304 + 64 * (j))
#define XB_TOP      3328
#define XB_TOPGEN   3392
#define XB_SPIN_CAP (1u << 18)
constexpr int CW_BAR = 4096;
DI unsigned xb_ld(unsigned* p)              { return __hip_atomic_load(p, __ATOMIC_RELAXED, __HIP_MEMORY_SCOPE_AGENT); }
DI unsigned xb_add(unsigned* p, unsigned v) { return __hip_atomic_fetch_add(p, v, __ATOMIC_RELAXED, __HIP_MEMORY_SCOPE_AGENT); }
DI unsigned xb_xcc_id() { return (unsigned)__builtin_amdgcn_s_getreg((3 << 11) | 20) & 0xFu; }
#define XB_SPIN(cond, bar) do { unsigned _sp = 0; while (cond) { __builtin_amdgcn_s_sleep(1); \
    if ((++_sp & 255u) == 0u) { if (xb_ld(&(bar)[XB_TMO])) break; if (_sp > XB_SPIN_CAP) { atomicAdd(&(bar)[XB_TMO], 1u); break; } } } } while (0)
struct XcdBarrier { unsigned* bar; unsigned x; volatile LAS unsigned* st; };
DI XcdBarrier xcd_barrier_post(unsigned* bar, volatile LAS unsigned* st) {
    XcdBarrier b; b.bar = bar; b.x = xb_xcc_id(); b.st = st;
    if (threadIdx.x == 0) (void)xb_add(&bar[XB_XCNT(b.x)], 1u);
    return b;
}
DI void xcd_barrier_complete(unsigned* bar, unsigned x, unsigned& nloc, unsigned& nx) {
    const unsigned G = gridDim.x * gridDim.y * gridDim.z;
    unsigned sum, cnt, mine, sp = 0u;
    for (;;) {
        sum = 0u; cnt = 0u; mine = 0u;
#pragma unroll
        for (unsigned j = 0; j < 16; ++j) { const unsigned c = xb_ld(&bar[XB_XCNT(j)]); sum += c; cnt += (c > 0u) ? 1u : 0u; mine = (j == x) ? c : mine; }
        if (sum == G) break;
        __builtin_amdgcn_s_sleep(1);
        if ((++sp & 255u) == 0u) { if (xb_ld(&bar[XB_TMO])) break; if (sp > XB_SPIN_CAP) { atomicAdd(&bar[XB_TMO], 1u); break; } }
    }
    nloc = mine > 0u ? mine : 1u; nx = cnt > 0u ? cnt : 1u;
}
DI void xcd_barrier(const XcdBarrier& b) {
    asm volatile("s_waitcnt vmcnt(0)" ::: "memory");
    __syncthreads();
    if (threadIdx.x == 0) {
        unsigned* bar = b.bar;
        __builtin_amdgcn_s_waitcnt(0);
        unsigned nloc = b.st[0], nx = b.st[1];
        if (nloc == 0u) { xcd_barrier_complete(bar, b.x, nloc, nx); b.st[0] = nloc; b.st[1] = nx; }
        const unsigned old = xb_add(&bar[XB_XSUB(b.x)], 1u);
        const unsigned gen = old / nloc;
        if (old + 1u == (gen + 1u) * nloc) {
            __builtin_amdgcn_fence(__ATOMIC_RELEASE, "agent");
            asm volatile("s_waitcnt vmcnt(0)" ::: "memory");
            const unsigned og = xb_add(&bar[XB_TOP], 1u);
            const unsigned tg = og / nx;
            if (og + 1u == (tg + 1u) * nx) xb_add(&bar[XB_TOPGEN], 1u);
            else XB_SPIN(xb_ld(&bar[XB_TOPGEN]) == tg, bar);
            __builtin_amdgcn_fence(__ATOMIC_ACQUIRE, "agent");
            xb_add(&bar[XB_XGEN(b.x)], 1u);
            asm volatile("s_waitcnt vmcnt(0)" ::: "memory");
        } else {
            XB_SPIN(xb_ld(&bar[XB_XGEN(b.x)]) == gen, bar);
            __builtin_amdgcn_fence(__ATOMIC_ACQUIRE, "agent");
            asm volatile("s_waitcnt vmcnt(0)" ::: "memory");
        }
    }
    __syncthreads();
}
#ifndef DUP_PHASE

#define DUP_PHASE -1
#endif
#define PHASE(k, ...) if (ph_lo <= (k) && (k) < ph_hi) { if ((k) > ph_lo) { xcd_barrier(xbar); } \
    { __VA_ARGS__ } __syncthreads(); if (DUP_PHASE == (k)) { xcd_barrier(xbar); { __VA_ARGS__ } __syncthreads(); } }
__global__ void __launch_bounds__(NTHR, 2) mega(Params P, int ph_lo, int ph_hi) {
    extern __shared__ __attribute__((aligned(16))) float lds[];
    const int bid = blockIdx.x, nb = gridDim.x;
    volatile LAS unsigned* xst = (volatile LAS unsigned*)((LAS unsigned char*)lds + 131072 + 512);
    if (threadIdx.x < 4) xst[threadIdx.x] = 0u;
    __syncthreads();
    const XcdBarrier xbar = xcd_barrier_post(WSP(unsigned, WS_CTL) + CW_BAR, xst);
    PHASE(0, p0_prologue(P, lds, bid, nb, 0);)
    PHASE(1, { SchedP1 S{&P, bid, nb}; EpiP1 E{&P}; gemm_run(lds, DM, PX, PX, S, E); SchedP1g S2{&P, bid, nb}; pg8::gemm_phase<EpiP1, SchedP1g, false, true>((LAS unsigned char*)lds, DM, P8, P8, S2, E); })
    PHASE(2, p2_prep(P, lds, bid, nb);)
    PHASE(3, { SchedP3 S{&P, bid, nb, 0}; EpiP3<0> E{&P}; gemm_run(lds, 256, 1024, 256, S, E); SchedP3 S2{&P, bid, nb, 1}; EpiP3<1> E2{&P}; gemm_run(lds, 256, 256, 1024, S2, E2); })
    if (ph_lo <= 3 && 3 < ph_hi) { xcd_barrier(xbar); p3b_ml_pre(P, lds, bid, nb); __syncthreads(); }
#ifdef DUP4_SKIP
    { xcd_barrier(xbar); int sk = DUP4_SKIP; asm volatile("" : "+s"(sk)); p4_scans(P, lds, bid, nb, sk); __syncthreads(); }
#endif
    PHASE(4, p4_scans(P, lds, bid, nb);)
    PHASE(5, { SchedFold S{&P, bid, nb}; EpiFold E{&P}; gemm_run(lds, 512, DM, DM, S, E); } __syncthreads(); p5_combine(P, bid, nb);)
    PHASE(6, { SchedP6 S{&P, bid, nb}; EpiP6 E{&P}; gemm_run(lds, 1024, 1024, 1024, S, E); })
    PHASE(7, { SchedMix S{&P, bid, nb}; EpiResT<true> E{&P, P.in[I_X], P.in[I_NXA], WS_SS1, 1.f / 512.f}; pg8::gemm_phase<EpiResT<true>, SchedMix, false, true>((LAS unsigned char*)lds, DM, P8, P8, S, E); })
    PHASE(8, { for (int su = bid; su < 256; su += nb) { SchedSc1u S{&P, su}; EpiScSoftmax E{&P}; pg8::gemm_phase<EpiScSoftmax, SchedSc1u, true, true>((LAS unsigned char*)lds, DM, DM, DM, S, E); } })
    PHASE(12, { SchedO S{&P, bid, nb}; EpiResT<false> E{&P, nullptr, P.in[I_NFFN], WS_SS2, 1.f / 256.f}; pg8::gemm_phase<EpiResT<false>, SchedO, false, true>((LAS unsigned char*)lds, 1024, 1024, 1024, S, E); })
    PHASE(13, p13_route_fused(P, lds, bid, nb);)
    PHASE(15, p15_gather(P, lds, bid, nb);)
    PHASE(16, { fill_tstab(P, lds); const int n_units = tstab(lds)[32] * 4; { SchedExp S{&P, bid, nb, 0, tstab(lds)}; EpiGU E{&P}; pg8::gemm_phase<EpiGU, SchedExp, false, true>((LAS unsigned char*)lds, DM, DM, DM, S, E); }
    })
    PHASE(17, { fill_tstab(P, lds); SchedExp S{&P, bid, nb, 1, tstab(lds)}; EpiDown E{&P}; pg8::gemm_phase<EpiDown, SchedExp, false, true>((LAS unsigned char*)lds, DEXP, DEXP, DEXP, S, E); })
    PHASE(18, p18_final(P, lds, bid, nb);)
}

#ifndef N_LAUNCH_PER_PHASE
#define N_LAUNCH_PER_PHASE 0
#endif
extern "C" void kernel_launch(void* const* d_in, const int* in_sizes, int n_in, void* d_out, int out_size, void* d_ws, size_t ws_size, hipStream_t stream) {
    Params P{};
    for (int i = 0; i < 33; ++i) P.in[i] = (const float*)d_in[i];
    P.out = (float*)d_out; P.ws = (unsigned char*)d_ws;
    constexpr int LDS_BYTES = 131072 + 1024;
    static int grid = 0;
    if (!grid) {
        (void)hipFuncSetAttribute((const void*)mega, hipFuncAttributeMaxDynamicSharedMemorySize, LDS_BYTES);
        int dev = 0, cus = 0, per_cu = 0;
        (void)hipGetDevice(&dev); (void)hipDeviceGetAttribute(&cus, hipDeviceAttributeMultiprocessorCount, dev);
        (void)hipOccupancyMaxActiveBlocksPerMultiprocessor(&per_cu, (const void*)mega, NTHR, LDS_BYTES);
        if (per_cu < 1) per_cu = 1;
        grid = cus;
        if (grid > cus * per_cu) grid = cus * per_cu;
    }
    (void)hipMemsetAsync((char*)d_ws + WS_CTL, 0, 32768, stream);
#if N_LAUNCH_PER_PHASE
    for (int ph = 0; ph < N_PHASES; ++ph) hipLaunchKernelGGL(mega, dim3(grid), dim3(NTHR), LDS_BYTES, stream, P, ph, ph + 1);
#else
    int lo = 0, hi = N_PHASES;
    void* args[] = {&P, &lo, &hi};
    hipError_t e = hipLaunchCooperativeKernel((const void*)mega, dim3(grid), dim3(NTHR), args, LDS_BYTES, stream);
    if (e != hipSuccess) fprintf(stderr, "cooperative launch failed: %s (grid %d)\n", hipGetErrorString(e), grid);
#endif
}
```

```cpp
#include <hip/hip_runtime.h>
#include <hip/hip_cooperative_groups.h>
namespace cg = cooperative_groups;
#include <cstdint>
#include <cstdio>

#define DI __device__ __forceinline__
typedef unsigned short bf16_t;
typedef short bf16x8 __attribute__((ext_vector_type(8)));
typedef float f32x4 __attribute__((ext_vector_type(4)));
typedef float f32x2 __attribute__((ext_vector_type(2)));
typedef unsigned u32x4 __attribute__((ext_vector_type(4)));
typedef unsigned u32x2 __attribute__((ext_vector_type(2)));

constexpr int DM = 2048, NB = 4, SEQ = 4096, MTOK = NB * SEQ;
constexpr int NMEM = 256;
constexpr int CH = 64, NCH = SEQ / CH;
constexpr int IN_TOTAL = 9264;
constexpr int NEXP = 32, DEXP = 512;
constexpr int NTHR = 512, NWG = 256;
constexpr float EPS = 1e-6f;
constexpr int O_GQ = 0, O_GK = 512, O_GV = 1024, O_GG = 2048, O_LRF = 3072, O_LRB = 3088, O_MX = 3104, O_MZ = 4128, O_MG = 5152, O_GA = 5168, O_GB = 7216;
constexpr int WIN_ROWS = 9472;

constexpr size_t MiB = 1u << 20;
constexpr size_t WS_CTL = 0;
constexpr size_t WS_WA = 1 * MiB;
constexpr size_t WS_WB = 5 * MiB;
constexpr size_t WS_WMIX = 9 * MiB;
constexpr size_t WS_WXQ = 17 * MiB;
constexpr size_t WS_WXKV = 25 * MiB;
constexpr size_t WS_WXO = 41 * MiB;
constexpr size_t WS_WMQK = 49 * MiB;
constexpr size_t WS_WMV = 50 * MiB;
constexpr size_t WS_WR = 51 * MiB;
constexpr size_t WS_SMALL = 52 * MiB;
constexpr size_t WS_MSC = 55 * MiB;
constexpr size_t WS_MCH = 57 * MiB;
constexpr size_t WS_GDEC = 58 * MiB;
constexpr size_t WS_SS1 = 59 * MiB;
constexpr size_t WS_SS2 = 61 * MiB;
constexpr size_t WS_MEMN = 63 * MiB;
constexpr size_t WS_KMEM = 67 * MiB;
constexpr size_t WS_VTMEM = 71 * MiB;
constexpr size_t WS_LOGIT = 75 * MiB;
constexpr size_t WS_ROUTE = 79 * MiB;
constexpr size_t WS_GG = 80 * MiB, WS_MZ = 112 * MiB, WS_GA = 144 * MiB, WS_GB = 208 * MiB;
constexpr size_t WS_QF = 272 * MiB, WS_QB = 288 * MiB, WS_KF = 304 * MiB, WS_KB = 320 * MiB;
constexpr size_t WS_KTF = 336 * MiB, WS_KTB = 352 * MiB, WS_VTG = 368 * MiB;
constexpr size_t WS_QM = 400 * MiB, WS_KM = 432 * MiB, WS_KMT = 464 * MiB, WS_VMT = 496 * MiB;
constexpr size_t WS_GQ = 528 * MiB, WS_GK = 544 * MiB, WS_KTG = 560 * MiB, WS_MX = 576 * MiB, WS_XC = 608 * MiB;
constexpr size_t WS_WIN = 400 * MiB;
constexpr size_t WS_XN = 440 * MiB;
constexpr size_t WS_YA = 272 * MiB, WS_YB = 304 * MiB;
constexpr size_t WS_MERGED = 336 * MiB;
constexpr size_t WS_ATTQ = 80 * MiB;
constexpr size_t WS_H = 80 * MiB;
constexpr size_t WS_SC = 144 * MiB;
constexpr size_t WS_P = 208 * MiB;
constexpr size_t WS_WKT = 400 * MiB;
constexpr size_t WS_VWT = 416 * MiB;
constexpr size_t WS_ATTO = 336 * MiB;
constexpr size_t WS_WGU = 528 * MiB;
constexpr size_t WS_WD = 592 * MiB;
constexpr size_t WS_XROWS = 272 * MiB;
constexpr size_t WS_HID = 440 * MiB;
constexpr size_t WS_YROWS = 272 * MiB;
constexpr size_t WS_PREP = 656 * MiB;
constexpr size_t WS_PRET = 672 * MiB;
constexpr size_t WS_PRES = 674 * MiB;
constexpr size_t WS_WIN8 = 272 * MiB;
constexpr int PX = 2048 + 128;
constexpr int P8 = 2048 + 128;
constexpr size_t WS_XN8 = 304 * MiB;
constexpr int MAXROWS = 40960;
constexpr int RT_TOKE = 0;
constexpr int RT_TOKI = 32768;
constexpr int RT_TOKW = 65536;
constexpr int RT_ROWRS = 98304;
constexpr int RT_ROWW = 98304 + MAXROWS;
constexpr int RT_TOKRS = 98304 + 2 * MAXROWS;
constexpr int CW_CNT = 1024;

struct Params {
    const float* in[33];
    float* out;
    unsigned char* ws;
};

DI float bf2f(bf16_t v) { return __uint_as_float(((unsigned)v) << 16); }
DI bf16_t f2bf(float f) { unsigned u = __float_as_uint(f); return (bf16_t)((u + 0x7fffu + ((u >> 16) & 1u)) >> 16); }
DI unsigned pk2(float lo, float hi) { return (unsigned)f2bf(lo) | ((unsigned)f2bf(hi) << 16); }
DI float frcp(float x) { return __builtin_amdgcn_rcpf(x); }
DI float sigmoidf_(float x) { return frcp(1.f + __expf(-x)); }
DI float siluf_(float x) { return x * frcp(1.f + __expf(-x)); }
DI float logsigmoidf_(float z) { return fminf(z, 0.f) - __logf(1.f + __expf(-fabsf(z))); }
DI float wave_sum(float v) {
#pragma unroll
    for (int o = 1; o < 64; o <<= 1) v += __shfl_xor(v, o);
    return v;
}
#define WSP(T, off) ((T*)(P.ws + (off)))

DI unsigned pk4_f8(float a, float b, float c, float d) { unsigned p = 0; p = __builtin_amdgcn_cvt_pk_fp8_f32(a, b, p, false); p = __builtin_amdgcn_cvt_pk_fp8_f32(c, d, p, true); return p; }
template <int F8 = 0>
DI void tr_item(const float* W, int ldw, int K, int ncols, bf16_t* dst, float* scr, int item, int lane, int dp, const float* ks) {
    const int nblk = (ncols + 31) / 32, kb = item / nblk, nb = item % nblk, k0 = 64 * kb, n0 = 32 * nb;
    const bool nok = (n0 + (lane & 31)) < ncols;
    float tv[32];
#pragma unroll
    for (int i = 0; i < 32; ++i) { const int kk = 2 * i + (lane >> 5); tv[i] = nok ? W[(size_t)(k0 + kk) * ldw + n0 + (lane & 31)] : 0.f; }
#pragma unroll
    for (int i = 0; i < 32; ++i) { const int kk = 2 * i + (lane >> 5); scr[kk * 33 + (lane & 31)] = tv[i]; }
    asm volatile("s_waitcnt lgkmcnt(0)" ::: "memory");
    const int c = lane & 7;
    constexpr float SC = (float)(F8 > 0 ? F8 : 1);
    f32x4 f0 = {SC, SC, SC, SC}, f1 = f0;
    if (ks) { f0 = *(const f32x4*)(ks + k0 + 8 * c) * SC; f1 = *(const f32x4*)(ks + k0 + 8 * c + 4) * SC; }
#pragma unroll
    for (int j = 0; j < 4; ++j) { const int n = (lane >> 3) + 8 * j; const float* s = scr + (8 * c) * 33 + n;
        if (F8 > 0) { u32x2 o; o.x = pk4_f8(s[0] * f0.x, s[33] * f0.y, s[66] * f0.z, s[99] * f0.w); o.y = pk4_f8(s[132] * f1.x, s[165] * f1.y, s[198] * f1.z, s[231] * f1.w);
            if (n0 + n < ncols) *(u32x2*)((unsigned char*)dst + (size_t)(n0 + n) * dp + k0 + 8 * c) = o; }
        else { u32x4 o; o.x = pk2(s[0] * f0.x, s[33] * f0.y); o.y = pk2(s[66] * f0.z, s[99] * f0.w); o.z = pk2(s[132] * f1.x, s[165] * f1.y); o.w = pk2(s[198] * f1.z, s[231] * f1.w);
            if (n0 + n < ncols) *(u32x4*)(dst + (size_t)(n0 + n) * dp + k0 + 8 * c) = o; } }
    asm volatile("s_waitcnt lgkmcnt(0)" ::: "memory");
}
struct SegRun { int gw, ngw, off; float* scr; int lane; };
template <int F8 = 0>
DI void tr_seg(SegRun& R, const float* W, int ldw, int K, int ncols, bf16_t* dst, int dp = 0, const float* ks = nullptr) {
    const int nitems = (K / 64) * ((ncols + 31) / 32);
    int first = (R.gw - (R.off % R.ngw) + R.ngw) % R.ngw;
    for (int it = first; it < nitems; it += R.ngw) tr_item<F8>(W, ldw, K, ncols, dst, R.scr, it, R.lane, dp ? dp : K, ks);
    R.off += nitems;
}
DI void rms_row_bf16(const float* xrow, const float* g, bf16_t* orow, int lane) {
    f32x4 v[8]; float s = 0.f;
#pragma unroll
    for (int j = 0; j < 8; ++j) { v[j] = *(const f32x4*)(xrow + 256 * j + 4 * lane); s += v[j].x * v[j].x + v[j].y * v[j].y + v[j].z * v[j].z + v[j].w * v[j].w; }
    const float rstd = rsqrtf(wave_sum(s) * (1.f / DM) + EPS);
#pragma unroll
    for (int j = 0; j < 8; ++j) { const f32x4 gg = *(const f32x4*)(g + 256 * j + 4 * lane);
        u32x2 o; o.x = pk2(v[j].x * rstd * gg.x, v[j].y * rstd * gg.y); o.y = pk2(v[j].z * rstd * gg.z, v[j].w * rstd * gg.w);
        *(u32x2*)(orow + 256 * j + 4 * lane) = o; }
}
enum { I_X = 0, I_MEM, I_NMIX, I_WIN, I_LRWF, I_LRBF, I_LRWB, I_LRBB, I_GNORM, I_CONVW, I_CONVB, I_MWQ, I_MWK, I_MWV, I_MGB, I_MNORM, I_WBA, I_WBB, I_WMIX,
       I_NXA, I_NMEM, I_WXQ, I_WXKV, I_WXO, I_NFFN, I_WGRP, I_BGRP, I_WRT, I_BRT, I_WGATE, I_WUP, I_WDOWN, I_NFIN };

DI void p0_prologue(const Params& P, float* lds, int bid, int nb, int part) {
    const int tid = threadIdx.x, lane = tid & 63, wave = tid >> 6;
    SegRun R; R.gw = bid * 8 + wave; R.ngw = nb * 8; R.off = 0; R.scr = lds + wave * (64 * 33); R.lane = lane;
    if (part == 0) {
        bf16_t* win = WSP(bf16_t, WS_WIN); const float* w = P.in[I_WIN];
        tr_seg(R, w + O_GQ, IN_TOTAL, DM, 512, win + (size_t)0 * PX, PX);
        tr_seg(R, w + O_GK, IN_TOTAL, DM, 512, win + (size_t)512 * PX, PX);
        tr_seg(R, w + O_GV, IN_TOTAL, DM, 1024, win + (size_t)1024 * PX, PX);
        tr_seg<64>(R, w + O_GG, IN_TOTAL, DM, 1024, (bf16_t*)(WSP(unsigned char, WS_WIN8) + (size_t)2048 * P8), P8);
        tr_seg(R, w + O_MX, IN_TOTAL, DM, 1024, win + (size_t)3072 * PX, PX);
        tr_seg<64>(R, w + O_MZ, IN_TOTAL, DM, 1024, (bf16_t*)(WSP(unsigned char, WS_WIN8) + (size_t)4096 * P8), P8);
        for (int j = 0; j < 16; ++j) {
            tr_seg<64>(R, w + O_GA + j * 128, IN_TOTAL, DM, 128, (bf16_t*)(WSP(unsigned char, WS_WIN8) + (size_t)(5120 + 256 * j) * P8), P8);
            tr_seg<64>(R, w + O_GB + j * 128, IN_TOTAL, DM, 128, (bf16_t*)(WSP(unsigned char, WS_WIN8) + (size_t)(5120 + 256 * j + 128) * P8), P8); }
        tr_seg(R, w + O_LRF, IN_TOTAL, DM, 16, win + (size_t)9216 * PX, PX);
        tr_seg(R, w + O_LRB, IN_TOTAL, DM, 16, win + (size_t)9232 * PX, PX);
        tr_seg(R, w + O_MG, IN_TOTAL, DM, 16, win + (size_t)9248 * PX, PX);
        tr_seg(R, P.in[I_WXKV], 2 * DM, DM, 2 * DM, WSP(bf16_t, WS_WXKV));
        for (int h = 0; h < 4; ++h) {
            tr_seg(R, P.in[I_MWQ] + (size_t)h * 65536, 256, 256, 256, WSP(bf16_t, WS_WMQK) + (size_t)h * 512 * 256);
            tr_seg(R, P.in[I_MWK] + (size_t)h * 65536, 256, 256, 256, WSP(bf16_t, WS_WMQK) + (size_t)h * 512 * 256 + 256 * 256);
            tr_seg(R, P.in[I_MWV] + (size_t)h * 65536, 256, 256, 256, WSP(bf16_t, WS_WMV) + (size_t)h * 256 * 256);
        }
        {
            const float* g = P.in[I_NMIX]; f32x4 gg[8];
#pragma unroll
            for (int j = 0; j < 8; ++j) gg[j] = *(const f32x4*)(g + 512 * (j >> 1) + 8 * lane + 4 * (j & 1));
            for (int m = R.gw; m < MTOK; m += 2 * R.ngw) {
                const int m1 = m + R.ngw; const bool has1 = m1 < MTOK;
                const float* x0 = P.in[I_X] + (size_t)m * DM; const float* x1 = P.in[I_X] + (size_t)(has1 ? m1 : m) * DM;
                f32x4 v0[8], v1[8]; float s0 = 0.f, s1 = 0.f;
#pragma unroll
                for (int j = 0; j < 8; ++j) { v0[j] = *(const f32x4*)(x0 + 512 * (j >> 1) + 8 * lane + 4 * (j & 1)); v1[j] = *(const f32x4*)(x1 + 512 * (j >> 1) + 8 * lane + 4 * (j & 1)); }
#pragma unroll
                for (int j = 0; j < 8; ++j) { s0 += v0[j].x * v0[j].x + v0[j].y * v0[j].y + v0[j].z * v0[j].z + v0[j].w * v0[j].w; s1 += v1[j].x * v1[j].x + v1[j].y * v1[j].y + v1[j].z * v1[j].z + v1[j].w * v1[j].w; }
                const float r0 = rsqrtf(wave_sum(s0) * (1.f / DM) + EPS), r1 = rsqrtf(wave_sum(s1) * (1.f / DM) + EPS);
                bf16_t* o0 = WSP(bf16_t, WS_XN) + (size_t)m * PX; bf16_t* o1 = WSP(bf16_t, WS_XN) + (size_t)m1 * PX;
#pragma unroll
                for (int j = 0; j < 4; ++j) {
                    const f32x4 a = v0[2 * j] * r0 * gg[2 * j], b = v0[2 * j + 1] * r0 * gg[2 * j + 1];
                    u32x4 o; o.x = pk2(a.x, a.y); o.y = pk2(a.z, a.w); o.z = pk2(b.x, b.y); o.w = pk2(b.z, b.w); *(u32x4*)(o0 + 512 * j + 8 * lane) = o;
                    u32x2 e; e.x = pk4_f8(a.x, a.y, a.z, a.w); e.y = pk4_f8(b.x, b.y, b.z, b.w); *(u32x2*)(WSP(unsigned char, WS_XN8) + (size_t)m * P8 + 512 * j + 8 * lane) = e;
                    if (has1) { const f32x4 c = v1[2 * j] * r1 * gg[2 * j], d = v1[2 * j + 1] * r1 * gg[2 * j + 1];
                        u32x4 q; q.x = pk2(c.x, c.y); q.y = pk2(c.z, c.w); q.z = pk2(d.x, d.y); q.w = pk2(d.z, d.w); *(u32x4*)(o1 + 512 * j + 8 * lane) = q;
                        u32x2 f; f.x = pk4_f8(c.x, c.y, c.z, c.w); f.y = pk4_f8(d.x, d.y, d.z, d.w); *(u32x2*)(WSP(unsigned char, WS_XN8) + (size_t)m1 * P8 + 512 * j + 8 * lane) = f; } }
            }
        }
        for (int m = R.gw; m < NB * NMEM; m += R.ngw) rms_row_bf16(P.in[I_MEM] + (size_t)m * DM, P.in[I_NMEM], WSP(bf16_t, WS_MEMN) + (size_t)m * DM, lane);
    } else if (part == 1) {
        tr_seg(R, P.in[I_WBA], DM, 1024, DM, WSP(bf16_t, WS_WA), 0, P.in[I_GNORM]);
        tr_seg(R, P.in[I_WBB], DM, 1024, DM, WSP(bf16_t, WS_WB), 0, P.in[I_MNORM]);
        tr_seg<64>(R, P.in[I_WMIX], DM, DM, DM, WSP(bf16_t, WS_WMIX), P8);
        { const int gt = bid * NTHR + tid, ngt = nb * NTHR; const float* s = P.in[I_WXQ]; bf16_t* d = WSP(bf16_t, WS_WXQ);
          for (int i = gt; i < DM * DM / 8; i += ngt) { const f32x4 a = *(const f32x4*)(s + (size_t)i * 8), c = *(const f32x4*)(s + (size_t)i * 8 + 4);
              u32x4 o; o.x = pk2(a.x, a.y); o.y = pk2(a.z, a.w); o.z = pk2(c.x, c.y); o.w = pk2(c.z, c.w); *(u32x4*)(d + (size_t)i * 8) = o; } }
        tr_seg(R, P.in[I_WXO], DM, DM, DM, WSP(bf16_t, WS_WXO));
        for (int g = 0; g < 4; ++g) tr_seg(R, P.in[I_WRT] + (size_t)g * DM * 8, 8, DM, 8, WSP(bf16_t, WS_WR) + (size_t)(g * 8) * DM, 0, P.in[I_NFFN]);
        tr_seg(R, P.in[I_WGRP], 4, DM, 4, WSP(bf16_t, WS_WR) + (size_t)32 * DM, 0, P.in[I_NFFN]);
        { const int gt = bid * NTHR + tid, ngt = nb * NTHR; u32x4 z = {0u, 0u, 0u, 0u};
          u32x4* p2 = (u32x4*)(WSP(bf16_t, WS_WR) + (size_t)36 * DM); for (int i = gt; i < 220 * DM / 8; i += ngt) p2[i] = z; }
        for (int e = 0; e < NEXP; ++e) {
            const float* wg = P.in[I_WGATE] + (size_t)e * DM * DEXP; const float* wu = P.in[I_WUP] + (size_t)e * DM * DEXP;
            unsigned char* d = WSP(unsigned char, WS_WGU) + (size_t)e * 1024 * DM;
            for (int pn = 0; pn < 4; ++pn) {
                tr_seg<64>(R, wg + pn * 128, DEXP, DM, 128, (bf16_t*)(d + (size_t)(pn * 256) * DM), 0, P.in[I_NFFN]);
                tr_seg<64>(R, wu + pn * 128, DEXP, DM, 128, (bf16_t*)(d + (size_t)(pn * 256 + 128) * DM), 0, P.in[I_NFFN]);
            }
        }
    } else {
        for (int e = 0; e < NEXP; ++e) tr_seg<32>(R, P.in[I_WDOWN] + (size_t)e * DEXP * DM, DM, DEXP, DM, (bf16_t*)(WSP(unsigned char, WS_WD) + (size_t)e * DM * DEXP));
    }
}

struct Unit { const bf16_t* A; const bf16_t* B; int lda, ldb; int kind, pm, pn, aux; bool keep; };
typedef f32x4 Acc[2][2][4][2];
#define ACC_FOREACH(ai, bj, m, n) _Pragma("unroll") for (int ai = 0; ai < 2; ++ai) _Pragma("unroll") for (int bj = 0; bj < 2; ++bj) _Pragma("unroll") for (int m = 0; m < 4; ++m) _Pragma("unroll") for (int n = 0; n < 2; ++n)
#define ACC_ROW(ai, m) ((ai) * 128 + wr * 64 + (m) * 16 + fr)
#define ACC_COL(bj, n) ((bj) * 128 + wc * 32 + (n) * 16 + fq * 4)

constexpr int SG_BK = 32, SG_LD = 40;
template <class Sched, class Epi>
DI void gemm_simple(float* ldsf, int K, const Sched& S, const Epi& E) {
    bf16_t* sA = (bf16_t*)ldsf; bf16_t* sB = sA + 256 * SG_LD;
    const int tid = threadIdx.x, wid = tid >> 6, lane = tid & 63, wr = wid >> 2, wc = wid & 3, fr = lane & 15, fq = lane >> 4;
    Acc acc;
    ACC_FOREACH(ai, bj, m, n) acc[ai][bj][m][n] = (f32x4){0.f, 0.f, 0.f, 0.f};
    Unit u;
    for (int ui = 0; S.next(ui, u); ++ui) {
        for (int k0 = 0; k0 < K; k0 += SG_BK) {
#pragma unroll
            for (int i = 0; i < 2; ++i) { const int p = tid + i * 512, r = p >> 2, c = (p & 3) * 8;
                const u32x4 va = *(const u32x4*)(u.A + (size_t)r * u.lda + k0 + c);
                const u32x4 vb = *(const u32x4*)(u.B + (size_t)r * u.ldb + k0 + c);
                *(u32x4*)(sA + r * SG_LD + c) = va; *(u32x4*)(sB + r * SG_LD + c) = vb; }
            __syncthreads();
            bf16x8 af[2][4], bfr[2][2];
#pragma unroll
            for (int ai = 0; ai < 2; ++ai)
#pragma unroll
                for (int m = 0; m < 4; ++m) af[ai][m] = *(const bf16x8*)(sA + (ai * 128 + wr * 64 + m * 16 + fr) * SG_LD + fq * 8);
#pragma unroll
            for (int bj = 0; bj < 2; ++bj)
#pragma unroll
                for (int n = 0; n < 2; ++n) bfr[bj][n] = *(const bf16x8*)(sB + (bj * 128 + wc * 32 + n * 16 + fr) * SG_LD + fq * 8);
            ACC_FOREACH(ai, bj, m, n) acc[ai][bj][m][n] = __builtin_amdgcn_mfma_f32_16x16x32_bf16(bfr[bj][n], af[ai][m], acc[ai][bj][m][n], 0, 0, 0);
            __syncthreads();
        }
        E(acc, u, wr, wc, fr, fq);
        if (!u.keep) { ACC_FOREACH(ai, bj, m, n) acc[ai][bj][m][n] = (f32x4){0.f, 0.f, 0.f, 0.f}; }
    }
}
#define LAS __attribute__((address_space(3)))
namespace pg8 {
constexpr int BK = 64, HALF = 128, HTB = HALF * BK * 2, STAGE_BYTES = 8 * HTB;
DI int lds_byte(int r, int c) { return (r >> 3) * 1024 + (r & 7) * 128 + ((((c >> 3) ^ (r >> 1)) & 7) << 4) + (c & 7) * 2; }
DI void stage_rc(int b, int& R, int& C) { const int slot = (b & 1023) >> 4; R = (b >> 10) * 8 + (slot >> 3); C = ((slot ^ (R >> 1)) & 7) * 8; }
typedef int v4i_t __attribute__((ext_vector_type(4)));
typedef int v8i_t __attribute__((ext_vector_type(8)));
DI f32x4 mfma_f8(bf16x8 a0, bf16x8 a1, bf16x8 b0, bf16x8 b1, f32x4 c) {
    const v8i_t a = __builtin_shufflevector(__builtin_bit_cast(v4i_t, a0), __builtin_bit_cast(v4i_t, a1), 0, 1, 2, 3, 4, 5, 6, 7);
    const v8i_t b = __builtin_shufflevector(__builtin_bit_cast(v4i_t, b0), __builtin_bit_cast(v4i_t, b1), 0, 1, 2, 3, 4, 5, 6, 7);
    return __builtin_amdgcn_mfma_scale_f32_16x16x128_f8f6f4(a, b, c, 0, 0, 0, 0x7F7F7F7F, 0, 0x7F7F7F7F);
}
template <class Epi, class Sched, bool AFTER = false, bool FP8 = false>
DI void gemm_phase(LAS unsigned char* lds, const int K, const int lda, const int ldb, const Sched& S, const Epi& E) {
    const int tid = threadIdx.x, wid = __builtin_amdgcn_readfirstlane(tid >> 6), lane = tid & 63, wr = wid >> 2, wc = wid & 3, fr = lane & 15, fq = lane >> 4;
    int Kop = K; asm volatile("" : "+s"(Kop));
    constexpr int ESZ = FP8 ? 1 : 2;
    const int nt = Kop / (FP8 ? 2 * BK : BK);
    unsigned voffA[2], voffB[2];
#pragma unroll
    for (int i = 0; i < 2; ++i) { int R, C; stage_rc(tid * 16 + i * 8192, R, C); voffA[i] = (unsigned)(R * lda * ESZ + C * 2); voffB[i] = (unsigned)(R * ldb * ESZ + C * 2); }
    const size_t kstep = (size_t)(BK * 2);
    const size_t hstepA = (size_t)HALF * lda * ESZ, hstepB = (size_t)HALF * ldb * ESZ;
    const unsigned ldsw = (unsigned)wid * 1024u;
    const int aoff = lds_byte(wr * 64 + fr, fq * 8), boff = lds_byte(wc * 32 + fr, fq * 8), aoff1 = lds_byte(wr * 64 + fr, 32 + fq * 8), boff1 = lds_byte(wc * 32 + fr, 32 + fq * 8);
#define PG8_SA(b, h) (((b) * 2 + (h)) * HTB)
#define PG8_SB(b, h) ((4 + (b) * 2 + (h)) * HTB)
#define PG8_STAGE(bufoff, gbase, voff) do { _Pragma("unroll") for (int _i = 0; _i < 2; ++_i) \
        __builtin_amdgcn_global_load_lds((const unsigned*)((const char*)(gbase) + (voff)[_i]), (LAS unsigned*)(lds + (bufoff) + ldsw + _i * 8192), 16, 0, 0); } while (0)
#define PG8_CAT(p, q) __builtin_shufflevector(__builtin_bit_cast(v4i_t, *(const LAS bf16x8*)(p)), __builtin_bit_cast(v4i_t, *(const LAS bf16x8*)(q)), 0, 1, 2, 3, 4, 5, 6, 7)
#define PG8_LDA(dst, b, h) do { if constexpr (FP8) { _Pragma("unroll") for (int m = 0; m < 4; ++m) dst##8[m] = PG8_CAT(lds + PG8_SA(b, h) + aoff + m * 2048, lds + PG8_SA(b, h) + aoff1 + m * 2048); } \
        else { _Pragma("unroll") for (int m = 0; m < 4; ++m) _Pragma("unroll") for (int k = 0; k < 2; ++k) dst[m][k] = *(const LAS bf16x8*)(lds + PG8_SA(b, h) + (k ? aoff1 : aoff) + m * 2048); } } while (0)
#define PG8_LDB(dst, b, h) do { if constexpr (FP8) { _Pragma("unroll") for (int n = 0; n < 2; ++n) dst##8[n] = PG8_CAT(lds + PG8_SB(b, h) + boff + n * 2048, lds + PG8_SB(b, h) + boff1 + n * 2048); } \
        else { _Pragma("unroll") for (int n = 0; n < 2; ++n) _Pragma("unroll") for (int k = 0; k < 2; ++k) dst[n][k] = *(const LAS bf16x8*)(lds + PG8_SB(b, h) + (k ? boff1 : boff) + n * 2048); } } while (0)
#define PG8_MMA(ai, bj, At, Bt) do { __builtin_amdgcn_s_setprio(1); _Pragma("unroll") for (int m = 0; m < 4; ++m) _Pragma("unroll") for (int n = 0; n < 2; ++n) { \
        if constexpr (FP8) asm volatile("v_mfma_scale_f32_16x16x128_f8f6f4 %0, %1, %2, %0, %3, %3 op_sel_hi:[0,0,0]" : "+v"(acc[ai][bj][m][n]) : "v"(Bt##8[n]), "v"(At##8[m]), "v"(f8scale)); \
        else { _Pragma("unroll") for (int k = 0; k < 2; ++k) acc[ai][bj][m][n] = __builtin_amdgcn_mfma_f32_16x16x32_bf16(Bt[n][k], At[m][k], acc[ai][bj][m][n], 0, 0, 0); } } \
        __builtin_amdgcn_s_setprio(0); } while (0)
#define PG8_WAIT_V(n) asm volatile("s_waitcnt vmcnt(" #n ")" ::: "memory")
#define PG8_WAIT_L(n) asm volatile("s_waitcnt lgkmcnt(" #n ")" ::: "memory")
#define PG8_BAR __builtin_amdgcn_s_barrier()
#define PG8_SCHED __builtin_amdgcn_sched_barrier(0)
    Unit cur, nxt; int ui = 0;
    if (!S.next(0, cur)) return;
    Acc acc;
    ACC_FOREACH(a_, b_, m_, n_) acc[a_][b_][m_][n_] = (f32x4){0.f, 0.f, 0.f, 0.f};
    const unsigned f8scale = 0x7F7F7F7Fu;
    bf16x8 At[FP8 ? 1 : 4][2], B0[FP8 ? 1 : 2][2], B1[FP8 ? 1 : 2][2];
    v8i_t At8[FP8 ? 4 : 1], B08[FP8 ? 2 : 1], B18[FP8 ? 2 : 1];
    const char* cA = (const char*)cur.A; const char* cB = (const char*)cur.B;
    PG8_STAGE(PG8_SB(0, 0), cB, voffB); PG8_STAGE(PG8_SB(0, 1), cB + hstepB, voffB); PG8_STAGE(PG8_SA(0, 0), cA, voffA); PG8_STAGE(PG8_SA(0, 1), cA + hstepA, voffA);
    if (wr == 1) PG8_BAR;
    PG8_WAIT_V(2); PG8_BAR;
    PG8_STAGE(PG8_SB(1, 0), cB + kstep, voffB); PG8_STAGE(PG8_SA(1, 0), cA + kstep, voffA); PG8_STAGE(PG8_SB(1, 1), cB + hstepB + kstep, voffB);
    PG8_WAIT_V(6); PG8_BAR;
    for (;;) {
        const bool has_next = S.next(ui + 1, nxt);
        const char* nA = has_next ? (const char*)nxt.A : cA; const char* nB = has_next ? (const char*)nxt.B : cB;
        for (int t = 0; t < nt; t += 2) {
            const bool last = (t == nt - 2);
            const char* a1 = cA + (size_t)(t + 1) * kstep;
            const char* a2 = last ? nA : cA + (size_t)(t + 2) * kstep; const char* b2 = last ? nB : cB + (size_t)(t + 2) * kstep;
            const char* a3 = a2 + kstep; const char* b3 = b2 + kstep;
            PG8_LDB(B0, 0, 0); PG8_LDB(B1, 0, 1); PG8_SCHED; PG8_LDA(At, 0, 0); PG8_STAGE(PG8_SA(1, 1), a1 + hstepA, voffA);
            PG8_WAIT_V(8); PG8_WAIT_L(0); PG8_BAR; PG8_MMA(0, 0, At, B0); PG8_MMA(0, 1, At, B1); PG8_BAR; PG8_SCHED;
            PG8_LDA(At, 0, 1); PG8_STAGE(PG8_SB(0, 0), b2, voffB); PG8_STAGE(PG8_SB(0, 1), b2 + hstepB, voffB); PG8_STAGE(PG8_SA(0, 0), a2, voffA);
            PG8_WAIT_V(8); PG8_WAIT_L(0); PG8_BAR; PG8_MMA(1, 0, At, B0); PG8_MMA(1, 1, At, B1); PG8_BAR; PG8_SCHED;
            PG8_LDB(B0, 1, 0); PG8_LDB(B1, 1, 1); PG8_SCHED; PG8_LDA(At, 1, 0); PG8_STAGE(PG8_SA(0, 1), a2 + hstepA, voffA);
            PG8_WAIT_V(8); PG8_WAIT_L(0); PG8_BAR; PG8_MMA(0, 0, At, B0); PG8_MMA(0, 1, At, B1); PG8_BAR; PG8_SCHED;
            PG8_LDA(At, 1, 1); PG8_STAGE(PG8_SB(1, 0), b3, voffB); PG8_STAGE(PG8_SB(1, 1), b3 + hstepB, voffB); PG8_STAGE(PG8_SA(1, 0), a3, voffA);
            PG8_WAIT_V(8); PG8_WAIT_L(0); PG8_BAR; PG8_MMA(1, 0, At, B0); PG8_MMA(1, 1, At, B1); PG8_BAR; PG8_SCHED;
        }
        if (wr == 0) PG8_BAR;
        if constexpr (FP8) asm volatile("s_nop 15\n\ts_nop 15" ::: "memory");
        if constexpr (!AFTER) E(acc, cur, wr, wc, fr, fq);
        if (!has_next) break;
        if (!cur.keep) { ACC_FOREACH(a_, b_, m_, n_) acc[a_][b_][m_][n_] = (f32x4){0.f, 0.f, 0.f, 0.f}; }
        cur = nxt; cA = nA; cB = nB; ++ui;
        if (wr == 1) PG8_BAR;
    }
    PG8_WAIT_V(0);
    PG8_BAR;
    if constexpr (AFTER) { if constexpr (FP8) asm volatile("s_nop 15\n\ts_nop 15" ::: "memory"); E.fused(acc, cur, wr, wc, fr, fq, lds); }
#undef PG8_SA
#undef PG8_SB
#undef PG8_STAGE
#undef PG8_LDA
#undef PG8_CAT
#undef PG8_LDB
#undef PG8_MMA
#undef PG8_WAIT_V
#undef PG8_WAIT_L
#undef PG8_BAR
#undef PG8_SCHED
}
}
#ifndef USE_ENGINE
#define USE_ENGINE 1
#endif
template <class Sched, class Epi>
DI void gemm_run(float* ldsf, int K, int lda, int ldb, const Sched& S, const Epi& E) {
#if USE_ENGINE
    pg8::gemm_phase<Epi, Sched>((LAS unsigned char*)ldsf, K, lda, ldb, S, E);
#else
    gemm_simple(ldsf, K, S, E);
#endif
}
DI void st_bf4(bf16_t* p, f32x4 v) { u32x2 o; o.x = pk2(v.x, v.y); o.y = pk2(v.z, v.w); *(u32x2*)p = o; }
DI void st_f8x8(unsigned char* p, f32x4 a0, f32x4 a1);
#define ACC_COLW(bj) ((bj) * 128 + wc * 32 + (fq & 1) * 16 + (fq >> 1) * 8)
#define ACC_FOREACH3(ai, bj, m) _Pragma("unroll") for (int ai = 0; ai < 2; ++ai) _Pragma("unroll") for (int bj = 0; bj < 2; ++bj) _Pragma("unroll") for (int m = 0; m < 4; ++m)
DI void st_bf8(bf16_t* p, f32x4 a0, f32x4 a1) {
    const unsigned x0 = pk2(a0.x, a0.y), x1 = pk2(a0.z, a0.w), y0 = pk2(a1.x, a1.y), y1 = pk2(a1.z, a1.w);
    const auto r0 = __builtin_amdgcn_permlane16_swap(x0, y0, false, false); const auto r1 = __builtin_amdgcn_permlane16_swap(x1, y1, false, false);
    u32x4 o; o.x = r0[0]; o.y = r1[0]; o.z = r0[1]; o.w = r1[1]; __builtin_nontemporal_store(o, (u32x4*)p);
}
DI void ld_bf8(const bf16_t* p, u32x2& n0, u32x2& n1) {
    const u32x4 L = *(const u32x4*)p; const auto r0 = __builtin_amdgcn_permlane16_swap(L.x, L.z, false, false); const auto r1 = __builtin_amdgcn_permlane16_swap(L.y, L.w, false, false);
    n0.x = r0[0]; n0.y = r1[0]; n1.x = r0[1]; n1.y = r1[1];
}
DI void st_f8x8(unsigned char* p, f32x4 a0, f32x4 a1) {
    const auto r = __builtin_amdgcn_permlane16_swap(pk4_f8(a0.x, a0.y, a0.z, a0.w), pk4_f8(a1.x, a1.y, a1.z, a1.w), false, false);
    u32x2 o; o.x = r[0]; o.y = r[1]; *(u32x2*)p = o;
}

struct SchedP1 {
    const Params* P; int bid, nb;
    DI bool next(int i, Unit& u) const {
        const int L = i * nb + bid; if (L >= 768) return false;
        const bf16_t* xn = (const bf16_t*)(P->ws + WS_XN); const bf16_t* win = (const bf16_t*)(P->ws + WS_WIN);
        u.lda = PX; u.ldb = PX; u.keep = false; u.aux = 0;
        if (L < 512) { int t = L / 64; u.pm = L % 64; u.pn = t < 4 ? t : t + 8; u.kind = 0;
            u.A = xn + (size_t)u.pm * 256 * PX; u.B = win + (size_t)u.pn * 256 * PX; }
        else { const int l = L - 512; u.pn = 4 + l / 64; u.pm = l % 64; u.kind = 1;
            u.A = win + (size_t)u.pn * 256 * PX; u.B = xn + (size_t)u.pm * 256 * PX; }
        return true;
    }
};
struct SchedP1g {
    const Params* P; int bid, nb;
    DI bool next(int i, Unit& u) const {
        const int L = i * nb + bid; if (L >= 1536) return false;
        const int t = L / 64; u.pm = L % 64; u.pn = t < 4 ? 8 + t : 12 + t; u.kind = 0; u.lda = P8; u.ldb = P8; u.keep = false; u.aux = 1;
        u.A = (const bf16_t*)(P->ws + WS_XN8 + (size_t)u.pm * 256 * P8); u.B = (const bf16_t*)(P->ws + WS_WIN8 + (size_t)u.pn * 256 * P8);
        return true;
    }
};
struct SchedKV {
    const Params* P; int l;
    DI bool next(int i, Unit& u) const {
        if (i > 0 || l >= 64) return false;
        u.lda = DM; u.ldb = DM; u.keep = false; u.aux = 0; u.pm = l / 16; u.pn = l % 16;
        const bf16_t* mn = (const bf16_t*)(P->ws + WS_MEMN); const bf16_t* wkv = (const bf16_t*)(P->ws + WS_WXKV);
        u.kind = u.pn < 8 ? 2 : 3; u.A = mn + (size_t)u.pm * 256 * DM; u.B = wkv + (size_t)u.pn * 256 * DM;
        return true;
    }
};
struct EpiP1 {
    const Params* Pp;
    DI void operator()(Acc& acc, const Unit& u, int wr, int wc, int fr, int fq) const {
        const Params& P = *Pp;
        bf16_t* dst; int ld; size_t base;
        if (u.kind == 0) {
            const int pn = u.pn;
            if (pn == 36) {
                float* sm = WSP(float, WS_SMALL);
                ACC_FOREACH(ai, bj, m, n) { const int c = ACC_COL(bj, n); if (c < 48) *(f32x4*)(sm + (size_t)(u.pm * 256 + ACC_ROW(ai, m)) * 48 + c) = acc[ai][bj][m][n]; }
                return;
            }
            if (pn >= 20) {
                bf16_t* gr = WSP(bf16_t, WS_GA) + (size_t)u.pm * 256 * DM + (size_t)(pn - 20) * 128; bf16_t* gs = WSP(bf16_t, WS_GB) + (size_t)u.pm * 256 * DM + (size_t)(pn - 20) * 128;
#pragma unroll
                for (int ai = 0; ai < 2; ++ai)
#pragma unroll
                    for (int m = 0; m < 4; ++m) {
                        f32x4 r[2], s[2];
#pragma unroll
                        for (int n = 0; n < 2; ++n) { const f32x4 a = acc[ai][0][m][n] * (1.f / 64.f), b = acc[ai][1][m][n] * (1.f / 64.f);
                            const f32x4 ea = {__expf(-a.x), __expf(-a.y), __expf(-a.z), __expf(-a.w)}, eb = {__expf(-b.x), __expf(-b.y), __expf(-b.z), __expf(-b.w)};
                            s[n] = (f32x4){frcp(1.f + eb.x), frcp(1.f + eb.y), frcp(1.f + eb.z), frcp(1.f + eb.w)};
                            r[n] = (f32x4){(1.f + eb.x) * frcp(1.f + ea.x), (1.f + eb.y) * frcp(1.f + ea.y), (1.f + eb.z) * frcp(1.f + ea.z), (1.f + eb.w) * frcp(1.f + ea.w)}; }
                        const size_t o = (size_t)ACC_ROW(ai, m) * DM + ACC_COLW(0);
                        st_bf8(gr + o, r[0], r[1]); st_bf8(gs + o, s[0], s[1]);
                    }
                return;
            }
            if (pn < 2) { dst = WSP(bf16_t, WS_GQ); ld = 512; base = (size_t)pn * 256; }
            else if (pn < 4) { dst = WSP(bf16_t, WS_GK); ld = 512; base = (size_t)(pn - 2) * 256; }
            else if (pn < 12) { dst = WSP(bf16_t, WS_GG); ld = 1024; base = (size_t)(pn - 8) * 256; }
            else if (pn < 16) { dst = WSP(bf16_t, WS_MX); ld = 1024; base = (size_t)(pn - 12) * 256; }
            else if (pn < 20) { dst = WSP(bf16_t, WS_MZ); ld = 1024; base = (size_t)(pn - 16) * 256; }
            else if (pn < 28) { dst = WSP(bf16_t, WS_GA); ld = 2048; base = (size_t)(pn - 20) * 256; }
            else { dst = WSP(bf16_t, WS_GB); ld = 2048; base = (size_t)(pn - 28) * 256; }
            base += (size_t)u.pm * 256 * ld;
        } else if (u.kind == 1) {
            if (u.pn < 4) { dst = WSP(bf16_t, WS_KTG); base = (size_t)(u.pn - 2) * 256 * MTOK; } else { dst = WSP(bf16_t, WS_VTG); base = (size_t)(u.pn - 4) * 256 * MTOK; }
            ld = MTOK; base += (size_t)u.pm * 256;
        } else if (u.kind == 2) { dst = WSP(bf16_t, WS_KMEM); ld = DM; base = (size_t)u.pm * 256 * DM + (size_t)u.pn * 256; }
        else { dst = WSP(bf16_t, WS_VTMEM); ld = DM; base = (size_t)u.pm * 256 * DM + (size_t)(u.pn - 8) * 256; }
        const float sc = u.aux ? (1.f / 64.f) : 1.f;
        ACC_FOREACH3(ai, bj, m) st_bf8(dst + base + (size_t)ACC_ROW(ai, m) * ld + ACC_COLW(bj), acc[ai][bj][m][0] * sc, acc[ai][bj][m][1] * sc);
    }
};

DI float wave_incl_scan_add(float v, int lane) {
#pragma unroll
    for (int o = 1; o < 64; o <<= 1) { const float t = __shfl_up(v, o); if (lane >= o) v += t; }
    return v;
}
DI float wave_incl_scan_max(float v, int lane) {
#pragma unroll
    for (int o = 1; o < 64; o <<= 1) { const float t = __shfl_up(v, o); if (lane >= o) v = fmaxf(v, t); }
    return v;
}
DI void p2_prep(const Params& P, float* lds, int bid, int nb) {
    float* lr = lds + 8 * 64 * 48;
    unsigned char* ktT = (unsigned char*)lds;
    float* wvs = lds + 16384;
    float* part = lds;
    for (int item = bid; item < NB * NCH; item += nb) {
        int tid = threadIdx.x; asm volatile("" : "+v"(tid));
        const int lane = tid & 63, wave = __builtin_amdgcn_readfirstlane(tid >> 6);
        const int b = item / NCH, c = item % NCH; const size_t m0 = (size_t)b * SEQ + (size_t)c * CH;
        __syncthreads();
        {
            const int c16 = lane & 15, kg = lane >> 4;
            const bf16_t* xa = WSP(bf16_t, WS_XN) + (m0 + c16) * PX + wave * 256 + 8 * kg;
            const bf16_t* wb = WSP(bf16_t, WS_WIN) + (size_t)(9216 + c16) * PX + wave * 256 + 8 * kg;
            f32x4 acc[4][3];
#pragma unroll
            for (int mt = 0; mt < 4; ++mt)
#pragma unroll
                for (int nt = 0; nt < 3; ++nt) acc[mt][nt] = (f32x4){0.f, 0.f, 0.f, 0.f};
#pragma unroll 2
            for (int k2 = 0; k2 < 4; ++k2) {
                bf16x8 fa[2][4], fb[2][3];
#pragma unroll
                for (int q = 0; q < 2; ++q) {
#pragma unroll
                    for (int mt = 0; mt < 4; ++mt) fa[q][mt] = *(const bf16x8*)(xa + (size_t)(16 * mt) * PX + (2 * k2 + q) * 32);
#pragma unroll
                    for (int nt = 0; nt < 3; ++nt) fb[q][nt] = *(const bf16x8*)(wb + (size_t)(16 * nt) * PX + (2 * k2 + q) * 32);
                }
#pragma unroll
                for (int q = 0; q < 2; ++q)
#pragma unroll
                    for (int mt = 0; mt < 4; ++mt)
#pragma unroll
                        for (int nt = 0; nt < 3; ++nt) acc[mt][nt] = __builtin_amdgcn_mfma_f32_16x16x32_bf16(fa[q][mt], fb[q][nt], acc[mt][nt], 0, 0, 0);
            }
#pragma unroll
            for (int mt = 0; mt < 4; ++mt)
#pragma unroll
                for (int nt = 0; nt < 3; ++nt)
#pragma unroll
                    for (int i = 0; i < 4; ++i) part[(wave * 64 + 16 * mt + 4 * kg + i) * 48 + 16 * nt + c16] = acc[mt][nt][i];
        }
        f32x4 wpre[4];
#pragma unroll
        for (int i = 0; i < 4; ++i) wpre[i] = ((const f32x4*)P.in[I_LRWF])[tid + 512 * i];
        __syncthreads();
        for (int i = tid; i < 64 * 48; i += NTHR) { float s = 0.f;
#pragma unroll
            for (int w8 = 0; w8 < 8; ++w8) s += part[w8 * 3072 + i];
            lr[i] = s; }
        __syncthreads();
        {
            const float qs = 0.08838834764831845f;
#pragma unroll 1
            for (int dir = 0; dir < 2; ++dir) {
                __syncthreads();
#pragma unroll
                for (int i = 0; i < 4; ++i) ((f32x4*)wvs)[tid + 512 * i] = wpre[i];
                float z[8][8];
                { const float* bsrc = (dir ? P.in[I_LRBB] : P.in[I_LRBF]) + 8 * lane; const f32x4 b0 = *(const f32x4*)bsrc, b1 = *(const f32x4*)(bsrc + 4);
#pragma unroll
                  for (int i = 0; i < 8; ++i) { z[i][0] = b0.x; z[i][1] = b0.y; z[i][2] = b0.z; z[i][3] = b0.w; z[i][4] = b1.x; z[i][5] = b1.y; z[i][6] = b1.z; z[i][7] = b1.w; } }
                __syncthreads();
#pragma unroll 1
                for (int rb = 0; rb < 4; ++rb) {
                    f32x4 l[8];
#pragma unroll
                    for (int i = 0; i < 8; ++i) l[i] = *(const f32x4*)(lr + (8 * wave + i) * 48 + dir * 16 + 4 * rb);
#pragma unroll
                    for (int rr = 0; rr < 4; ++rr) {
                        const f32x4 w0 = *(const f32x4*)(wvs + (4 * rb + rr) * 512 + 8 * lane), w1 = *(const f32x4*)(wvs + (4 * rb + rr) * 512 + 8 * lane + 4);
#pragma unroll
                        for (int i = 0; i < 8; ++i) { const float lv = l[i][rr];
                            z[i][0] += lv * w0.x; z[i][1] += lv * w0.y; z[i][2] += lv * w0.z; z[i][3] += lv * w0.w; z[i][4] += lv * w1.x; z[i][5] += lv * w1.y; z[i][6] += lv * w1.z; z[i][7] += lv * w1.w; }
                    }
                }
                if (dir == 0) {
#pragma unroll
                    for (int i = 0; i < 4; ++i) wpre[i] = ((const f32x4*)P.in[I_LRWB])[tid + 512 * i]; }
                u32x4 qr[8], kr[8];
#pragma unroll
                for (int i = 0; i < 8; ++i) { qr[i] = *(const u32x4*)(WSP(bf16_t, WS_GQ) + (m0 + 8 * wave + i) * 512 + 8 * lane); kr[i] = *(const u32x4*)(WSP(bf16_t, WS_GK) + (m0 + 8 * wave + i) * 512 + 8 * lane); }
                float tot[8];
#pragma unroll
                for (int j = 0; j < 8; ++j) {
#pragma unroll
                    for (int i = 0; i < 8; ++i) z[i][j] = logsigmoidf_(z[i][j]) * (1.f / 16.f);
                    if (dir == 0) {
#pragma unroll
                        for (int i = 1; i < 8; ++i) z[i][j] += z[i - 1][j];
                        tot[j] = z[7][j];
                    } else {
#pragma unroll
                        for (int i = 6; i >= 0; --i) z[i][j] += z[i + 1][j];
                        tot[j] = z[0][j];
                    }
                }
                __syncthreads();
                *(f32x4*)(wvs + wave * 512 + 8 * lane) = (f32x4){tot[0], tot[1], tot[2], tot[3]}; *(f32x4*)(wvs + wave * 512 + 8 * lane + 4) = (f32x4){tot[4], tot[5], tot[6], tot[7]};
                __syncthreads();
                float off[8];
#pragma unroll
                for (int j = 0; j < 8; ++j) off[j] = 0.f;
#pragma unroll
                for (int g = 0; g < 8; ++g) if (dir ? g > wave : g < wave) {
                    const f32x4 t0 = *(const f32x4*)(wvs + g * 512 + 8 * lane), t1 = *(const f32x4*)(wvs + g * 512 + 8 * lane + 4);
                    off[0] += t0.x; off[1] += t0.y; off[2] += t0.z; off[3] += t0.w; off[4] += t1.x; off[5] += t1.y; off[6] += t1.z; off[7] += t1.w; }
                if (wave == (dir ? 0 : 7)) {
                    float* gd = WSP(float, WS_GDEC) + ((size_t)(dir * NB + b) * NCH + c) * 512 + 8 * lane;
                    *(f32x4*)gd = (f32x4){__expf(off[0] + tot[0]), __expf(off[1] + tot[1]), __expf(off[2] + tot[2]), __expf(off[3] + tot[3])};
                    *(f32x4*)(gd + 4) = (f32x4){__expf(off[4] + tot[4]), __expf(off[5] + tot[5]), __expf(off[6] + tot[6]), __expf(off[7] + tot[7])}; }
                bf16_t* qo = (dir ? WSP(bf16_t, WS_QB) : WSP(bf16_t, WS_QF)) + (m0 + 8 * wave) * 512 + 8 * lane; bf16_t* ko = (dir ? WSP(bf16_t, WS_KB) : WSP(bf16_t, WS_KF)) + (m0 + 8 * wave) * 512 + 8 * lane;
#pragma unroll
                for (int i = 0; i < 8; ++i) {
                    float cum[8];
#pragma unroll
                    for (int j = 0; j < 8; ++j) cum[j] = off[j] + z[i][j];
                    const u32x4 q = qr[i], k = kr[i]; u32x4 o;
                    o.x = pk2(bf2f(q.x & 0xffff) * qs * __expf(cum[0]), bf2f(q.x >> 16) * qs * __expf(cum[1])); o.y = pk2(bf2f(q.y & 0xffff) * qs * __expf(cum[2]), bf2f(q.y >> 16) * qs * __expf(cum[3]));
                    o.z = pk2(bf2f(q.z & 0xffff) * qs * __expf(cum[4]), bf2f(q.z >> 16) * qs * __expf(cum[5])); o.w = pk2(bf2f(q.w & 0xffff) * qs * __expf(cum[6]), bf2f(q.w >> 16) * qs * __expf(cum[7]));
                    *(u32x4*)(qo + (size_t)i * 512) = o;
                    z[i][0] = bf2f(k.x & 0xffff) * __expf(-cum[0]); z[i][1] = bf2f(k.x >> 16) * __expf(-cum[1]); z[i][2] = bf2f(k.y & 0xffff) * __expf(-cum[2]); z[i][3] = bf2f(k.y >> 16) * __expf(-cum[3]);
                    z[i][4] = bf2f(k.z & 0xffff) * __expf(-cum[4]); z[i][5] = bf2f(k.z >> 16) * __expf(-cum[5]); z[i][6] = bf2f(k.w & 0xffff) * __expf(-cum[6]); z[i][7] = bf2f(k.w >> 16) * __expf(-cum[7]);
                    o.x = pk2(z[i][0], z[i][1]); o.y = pk2(z[i][2], z[i][3]); o.z = pk2(z[i][4], z[i][5]); o.w = pk2(z[i][6], z[i][7]);
                    *(u32x4*)(ko + (size_t)i * 512) = o;
                }
#pragma unroll
                for (int j = 0; j < 8; ++j) { u32x4 o; o.x = pk2(z[0][j], z[1][j]); o.y = pk2(z[2][j], z[3][j]); o.z = pk2(z[4][j], z[5][j]); o.w = pk2(z[6][j], z[7][j]);
                    *(u32x4*)(ktT + (8 * lane + j) * 128 + ((wave ^ (lane & 7)) << 4)) = o; }
                __syncthreads();
                bf16_t* ktg = (dir ? WSP(bf16_t, WS_KTB) : WSP(bf16_t, WS_KTF)) + m0;
#pragma unroll
                for (int it = 0; it < 8; ++it) { const int idx = it * 512 + tid, d = idx >> 3, s = idx & 7;
                    *(u32x4*)(ktg + (size_t)d * MTOK + 8 * s) = *(const u32x4*)(ktT + d * 128 + ((s ^ ((d >> 3) & 7)) << 4)); }
            }
        }
        {
            const int ch = 8 * (tid & 127), tq = tid >> 7, s0 = c * CH + 16 * tq;
            f32x4 w[5][2];
#pragma unroll
            for (int j = 0; j < 5; ++j) { w[j][0] = *(const f32x4*)(P.in[I_CONVW] + j * 1024 + ch); w[j][1] = *(const f32x4*)(P.in[I_CONVW] + j * 1024 + ch + 4); }
            const f32x4 cb0 = *(const f32x4*)(P.in[I_CONVB] + ch), cb1 = *(const f32x4*)(P.in[I_CONVB] + ch + 4);
            const bf16_t* mx = WSP(bf16_t, WS_MX) + (size_t)b * SEQ * 1024 + ch; bf16_t* xc = WSP(bf16_t, WS_XC) + (m0 + 16 * tq) * 1024 + ch;
            u32x4 xr[20];
#pragma unroll
            for (int r = 0; r < 20; ++r) { const int s = s0 - 2 + r; xr[r] = (u32x4){0u, 0u, 0u, 0u}; if (s >= 0 && s < SEQ) xr[r] = *(const u32x4*)(mx + (size_t)s * 1024); }
#pragma unroll
            for (int i = 0; i < 16; ++i) {
                f32x4 a0 = cb0, a1 = cb1;
#pragma unroll
                for (int k = 0; k < 5; ++k) { const u32x4 x = xr[i + k];
                    a0 += w[k][0] * (f32x4){bf2f(x.x & 0xffff), bf2f(x.x >> 16), bf2f(x.y & 0xffff), bf2f(x.y >> 16)}; a1 += w[k][1] * (f32x4){bf2f(x.z & 0xffff), bf2f(x.z >> 16), bf2f(x.w & 0xffff), bf2f(x.w >> 16)}; }
                u32x4 o; o.x = pk2(siluf_(a0.x), siluf_(a0.y)); o.y = pk2(siluf_(a0.z), siluf_(a0.w)); o.z = pk2(siluf_(a1.x), siluf_(a1.y)); o.w = pk2(siluf_(a1.z), siluf_(a1.w));
                *(u32x4*)(xc + (size_t)i * 1024) = o;
            }
        }
        {
            const int dir = wave >> 2, h = wave & 3;
            const float ipre = lr[lane * 48 + 32 + (dir * 2 + 0) * 4 + h] + P.in[I_MGB][(dir * 2 + 0) * 4 + h];
            const float fpre = lr[lane * 48 + 32 + (dir * 2 + 1) * 4 + h] + P.in[I_MGB][(dir * 2 + 1) * 4 + h];
            const float lf = logsigmoidf_(fpre);
            const float pre = wave_incl_scan_add(lf, lane); const float tot = __shfl(pre, 63);
            float Bv, Av, CMv;
            if (dir == 0) { Bv = pre; Av = ipre - Bv; CMv = wave_incl_scan_max(Av, lane); }
            else { Bv = tot - pre + lf; Av = ipre - Bv;
                const float ar = __shfl(Av, 63 - lane); const float pm = wave_incl_scan_max(ar, lane); CMv = __shfl(pm, 63 - lane); }
            float* msc = WSP(float, WS_MSC);
            const size_t o = ((size_t)(dir * 4 + h)) * MTOK + m0 + lane;
            msc[o] = Bv; msc[(size_t)8 * MTOK + o] = Av; msc[(size_t)16 * MTOK + o] = CMv;
            const float cmlast = dir == 0 ? __shfl(CMv, 63) : __shfl(CMv, 0);
            if (lane == 0) { float* mch = WSP(float, WS_MCH); const int ci = ((dir * 4 + b) * 4 + h) * 64 + c; mch[ci] = tot; mch[2048 + ci] = cmlast; }
        }
    }
}

struct SchedP3 {
    const Params* P; int bid, nb, part;
    DI bool next(int i, Unit& u) const {
        const int L = i * nb + bid; if (L >= 512) return false;
        const int which = part * 2 + (L >> 8), l = L & 255; u.pm = l >> 2; u.pn = l & 3; u.kind = which; u.keep = false; u.aux = 0;
        const bf16_t* xc = (const bf16_t*)(P->ws + WS_XC) + (size_t)u.pm * 256 * 1024 + u.pn * 256;
        const bf16_t* mx = (const bf16_t*)(P->ws + WS_MX) + (size_t)u.pm * 256 * 1024 + u.pn * 256;
        const bf16_t* wqk = (const bf16_t*)(P->ws + WS_WMQK) + (size_t)u.pn * 512 * 256; const bf16_t* wv = (const bf16_t*)(P->ws + WS_WMV) + (size_t)u.pn * 256 * 256;
        if (which == 0) { u.A = xc; u.lda = 1024; u.B = wqk; u.ldb = 256; }
        else if (which == 1) { u.A = xc; u.lda = 1024; u.B = wqk + 256 * 256; u.ldb = 256; }
        else if (which == 2) { u.A = wqk + 256 * 256; u.lda = 256; u.B = xc; u.ldb = 1024; }
        else { u.A = wv; u.lda = 256; u.B = mx; u.ldb = 1024; }
        return true;
    }
};
template <int PART> struct EpiP3 {
    const Params* Pp;
    DI void operator()(Acc& acc, const Unit& u, int wr, int wc, int fr, int fq) const {
        const Params& P = *Pp;
        if (PART == 0) {
            bf16_t* dst = (u.kind == 0 ? WSP(bf16_t, WS_QM) : WSP(bf16_t, WS_KM)) + (size_t)u.pm * 256 * 1024 + u.pn * 256; const float sc = u.kind == 0 ? 1.f : 0.0625f;
            ACC_FOREACH3(ai, bj, m) st_bf8(dst + (size_t)ACC_ROW(ai, m) * 1024 + ACC_COLW(bj), acc[ai][bj][m][0] * sc, acc[ai][bj][m][1] * sc);
        } else {
            bf16_t* dst = (u.kind == 2 ? WSP(bf16_t, WS_KMT) : WSP(bf16_t, WS_VMT)) + (size_t)u.pn * 256 * MTOK + (size_t)u.pm * 256; const float sc = u.kind == 2 ? 0.0625f : 1.f;
            ACC_FOREACH3(ai, bj, m) st_bf8(dst + (size_t)ACC_ROW(ai, m) * MTOK + ACC_COLW(bj), acc[ai][bj][m][0] * sc, acc[ai][bj][m][1] * sc);
        }
    }
};

DI bf16_t* obuf(const Params& P, int which) { return (bf16_t*)P.out + (size_t)which * MTOK * 1024; }
DI void naive_gla(const Params& P, float* lds, int item) {
    float* sa = lds; float* sq = lds + 128; float* sk = lds + 256; float* part = lds + 384;
    const int dir = item & 1, h = (item >> 1) & 3, b = item >> 3, tid = threadIdx.x, e = tid & 255, half = tid >> 8;
    float S[64];
#pragma unroll
    for (int d = 0; d < 64; ++d) S[d] = 0.f;
    const float* small = WSP(float, WS_SMALL);
    const float* wl = dir ? P.in[I_LRWB] : P.in[I_LRWF]; const float* bl = dir ? P.in[I_LRBB] : P.in[I_LRBF];
    const bf16_t* gq = WSP(bf16_t, WS_GQ); const bf16_t* gk = WSP(bf16_t, WS_GK); const bf16_t* vt = WSP(bf16_t, WS_VTG);
    bf16_t* o = obuf(P, dir);
    for (int step = 0; step < SEQ; ++step) {
        const int s = dir ? SEQ - 1 - step : step; const size_t m = (size_t)b * SEQ + s;
        __syncthreads();
        if (tid < 128) { const int d = h * 128 + tid; float z = bl[d];
            for (int r = 0; r < 16; ++r) z += small[m * 48 + dir * 16 + r] * wl[r * 512 + d];
            sa[tid] = __expf(logsigmoidf_(z) * (1.f / 16.f)); sq[tid] = bf2f(gq[m * 512 + d]) * 0.08838834764831845f; sk[tid] = bf2f(gk[m * 512 + d]); }
        __syncthreads();
        const float v = bf2f(vt[(size_t)(h * 256 + e) * MTOK + m]);
        float acc = 0.f;
#pragma unroll
        for (int d = 0; d < 64; ++d) { S[d] = sa[half * 64 + d] * S[d] + sk[half * 64 + d] * v; acc += sq[half * 64 + d] * S[d]; }
        part[tid] = acc;
        __syncthreads();
        if (tid < 256) o[m * 1024 + h * 256 + tid] = f2bf(part[tid] + part[tid + 256]);
    }
}
DI void naive_mlstm(const Params& P, float* lds, int item) {
    float* sq = lds; float* sk = lds + 256; float* sn = lds + 512; float* part = lds + 768; float* sden = lds + 1280;
    const int dir = item & 1, h = (item >> 1) & 3, b = item >> 3, tid = threadIdx.x, e = tid & 255, half = tid >> 8;
    float C[128];
#pragma unroll
    for (int d = 0; d < 128; ++d) C[d] = 0.f;
    if (tid < 256) sn[tid] = 0.f;
    const float* small = WSP(float, WS_SMALL);
    const bf16_t* qm = WSP(bf16_t, WS_QM); const bf16_t* km = WSP(bf16_t, WS_KM); const bf16_t* vt = WSP(bf16_t, WS_VMT);
    bf16_t* o = obuf(P, 2 + dir);
    const float bi = P.in[I_MGB][(dir * 2 + 0) * 4 + h], bfz = P.in[I_MGB][(dir * 2 + 1) * 4 + h];
    for (int step = 0; step < SEQ; ++step) {
        const int s = dir ? SEQ - 1 - step : step; const size_t m = (size_t)b * SEQ + s;
        const float ig = __expf(small[m * 48 + 32 + (dir * 2 + 0) * 4 + h] + bi);
        const float fg = sigmoidf_(small[m * 48 + 32 + (dir * 2 + 1) * 4 + h] + bfz);
        __syncthreads();
        if (tid < 256) { sq[tid] = bf2f(qm[m * 1024 + h * 256 + tid]); const float k = bf2f(km[m * 1024 + h * 256 + tid]); sk[tid] = k; sn[tid] = fg * sn[tid] + ig * k; }
        __syncthreads();
        const float v = bf2f(vt[(size_t)(h * 256 + e) * MTOK + m]) * ig;
        float acc = 0.f;
#pragma unroll
        for (int d = 0; d < 128; ++d) { C[d] = fg * C[d] + sk[half * 128 + d] * v; acc += sq[half * 128 + d] * C[d]; }
        part[tid] = acc;
        if (tid < 64) { float dsum = 0.f; for (int d = tid; d < 256; d += 64) dsum += sq[d] * sn[d]; dsum = wave_sum(dsum); if (tid == 0) sden[0] = dsum; }
        __syncthreads();
        if (tid < 256) { const float num = part[tid] + part[tid + 256]; o[m * 1024 + h * 256 + tid] = f2bf(num / fmaxf(fabsf(sden[0]), 1.f)); }
    }
}
typedef float f32x16 __attribute__((ext_vector_type(16)));
typedef __bf16 bf16x2_t __attribute__((ext_vector_type(2)));
DI unsigned cvtpk(float lo, float hi) { f32x2 v = {lo, hi}; bf16x2_t b = __builtin_convertvector(v, bf16x2_t); return __builtin_bit_cast(unsigned, b); }
DI f32x16 mfma32(bf16x8 a, bf16x8 b, f32x16 c) { return __builtin_amdgcn_mfma_f32_32x32x16_bf16(a, b, c, 0, 0, 0); }
DI int crow(int reg, int hh) { return (reg & 3) + 8 * (reg >> 2) + 4 * hh; }
DI bf16x8 pack8(const f32x16& x, int s) { u32x4 p; p.x = cvtpk(x[8 * s], x[8 * s + 1]); p.y = cvtpk(x[8 * s + 2], x[8 * s + 3]); p.z = cvtpk(x[8 * s + 4], x[8 * s + 5]); p.w = cvtpk(x[8 * s + 6], x[8 * s + 7]); return __builtin_bit_cast(bf16x8, p); }
#define LRD(T, base, off) (*(const LAS T*)((base) + (off)))
#define LWR(T, base, off) (*(LAS T*)((base) + (off)))
template <int DK, bool ML>
DI void scan_fast(const Params& P, float* ldsf, int item) {
    constexpr int NDT = DK / 32, QLD = DK + 8, TLD = 72, FT = ML ? 1024 : 512;
    constexpr int QB_ = QLD * 2, TB_ = TLD * 2;
    LAS unsigned char* L0 = (LAS unsigned char*)ldsf;
    LAS unsigned char* Qs = L0; LAS unsigned char* Ks = Qs + 64 * QB_; LAS unsigned char* KTs = Ks + 64 * QB_; LAS unsigned char* Ps = KTs + DK * TB_;
    LAS unsigned char* tab = Ps + 64 * TB_;
    constexpr int T_A = 0, T_CM = 256, T_B = 512, T_W = 768, T_WI = 1024, T_FL = 1280, T_D1 = 1536, T_DS = 1792, T_G = 2304, T_N = 2816;
    const int dir = item & 1, h = (item >> 1) & 3, b = item >> 3;
    const bf16_t* qg = (ML ? WSP(bf16_t, WS_QM) : (dir ? WSP(bf16_t, WS_QB) : WSP(bf16_t, WS_QF))) + h * DK;
    const bf16_t* kg = (ML ? WSP(bf16_t, WS_KM) : (dir ? WSP(bf16_t, WS_KB) : WSP(bf16_t, WS_KF))) + h * DK;
    const bf16_t* ktg = (ML ? WSP(bf16_t, WS_KMT) : (dir ? WSP(bf16_t, WS_KTB) : WSP(bf16_t, WS_KTF))) + (size_t)h * DK * MTOK;
    const bf16_t* vtg0 = (ML ? WSP(bf16_t, WS_VMT) : WSP(bf16_t, WS_VTG)) + (size_t)(h * 256) * MTOK;
    bf16_t* og0 = obuf(P, (ML ? 2 : 0) + dir) + h * 256;
    const float* msc = WSP(float, WS_MSC) + (size_t)(dir * 4 + h) * MTOK; const float* mch = WSP(float, WS_MCH) + ((dir * 4 + b) * 4 + h) * 64;
    f32x16 S[NDT];
#pragma unroll
    for (int dt = 0; dt < NDT; ++dt)
#pragma unroll
        for (int i = 0; i < 16; ++i) S[dt][i] = 0.f;
    if (ML && threadIdx.x < 256) LWR(float, tab, T_N + threadIdx.x * 4) = 0.f;
    float m_prev = 0.f;
    for (int ci = 0; ci < NCH; ++ci) {
        const int c = dir ? NCH - 1 - ci : ci; const size_t m0 = (size_t)b * SEQ + (size_t)c * CH;
        int tid = threadIdx.x; asm volatile("" : "+v"(tid));
        const int lane = tid & 63, w = __builtin_amdgcn_readfirstlane(tid >> 6), r = lane & 31, hh = lane >> 5;
        const bf16_t* vtg = vtg0 + (size_t)(32 * w + r) * MTOK + 8 * hh;
        bf16_t* og = og0 + 32 * w + r;
        LAS unsigned char* qfrag = Qs + r * QB_ + hh * 8;
        LAS unsigned char* pfrag = Ps + r * TB_ + hh * 16;
        LAS unsigned char* ktfrag = KTs + r * TB_ + hh * 16;
        LAS unsigned char* tabh = tab + hh * 16;
        __syncthreads();
        for (int p = tid; p < 64 * DK / 8; p += NTHR) { const int row = p / (DK / 8), c8 = p % (DK / 8);
            LWR(u32x4, Qs, row * QB_ + c8 * 16) = *(const u32x4*)(qg + (m0 + row) * FT + c8 * 8);
            LWR(u32x4, Ks, row * QB_ + c8 * 16) = *(const u32x4*)(kg + (m0 + row) * FT + c8 * 8); }
        for (int p = tid; p < DK * 8; p += NTHR) { const int d = p >> 3, c8 = p & 7; LWR(u32x4, KTs, d * TB_ + c8 * 16) = *(const u32x4*)(ktg + (size_t)d * MTOK + m0 + c8 * 8); }
        bf16x8 Bv[4];
#pragma unroll
        for (int ks = 0; ks < 4; ++ks) Bv[ks] = *(const bf16x8*)(vtg + m0 + 16 * ks);
        float Mx = 0.f, w_old = 1.f, Btot = 0.f;
        if (ML) {
            if (tid < 64) { LWR(float, tab, T_B + tid * 4) = msc[m0 + tid]; LWR(float, tab, T_A + tid * 4) = msc[(size_t)8 * MTOK + m0 + tid]; LWR(float, tab, T_CM + tid * 4) = msc[(size_t)16 * MTOK + m0 + tid]; }
            Btot = mch[c]; const float cml = mch[2048 + c]; Mx = fmaxf(m_prev, cml); w_old = __expf(m_prev - Mx);
        } else {
            if (tid < 128) LWR(float, tab, T_G + tid * 4) = WSP(float, WS_GDEC)[((size_t)(dir * NB + b) * NCH + c) * 512 + h * 128 + tid];
        }
        __syncthreads();
        if (w < 4) {
            const int si = w >> 1, ti = w & 1;
            LAS unsigned char* ka = Ks + (32 * si + r) * QB_ + hh * 16; LAS unsigned char* qa = Qs + (32 * ti + r) * QB_ + hh * 16;
            f32x16 X;
#pragma unroll
            for (int i = 0; i < 16; ++i) X[i] = 0.f;
#pragma unroll
            for (int ks = 0; ks < DK / 16; ++ks) { X = mfma32(LRD(bf16x8, ka, ks * 32), LRD(bf16x8, qa, ks * 32), X); if (ML && (ks & 3) == 3) __builtin_amdgcn_sched_barrier(0); }
            const int t = 32 * ti + r;
            float cmt = 0.f; if (ML) cmt = fmaxf(m_prev, LRD(float, tab, T_CM + t * 4));
            float rs = 0.f;
            LAS unsigned char* prow = Ps + t * TB_ + (32 * si + 4 * hh) * 2;
            LAS unsigned char* arow = tab + T_A + (32 * si + 4 * hh) * 4;
#pragma unroll
            for (int g = 0; g < 4; ++g) {
                float v[4]; f32x4 av = {0.f, 0.f, 0.f, 0.f}; if (ML) av = LRD(f32x4, arow, g * 32);
#pragma unroll
                for (int i = 0; i < 4; ++i) { const int s = 32 * si + 8 * g + 4 * hh + i; const bool keep = dir ? (s >= t) : (s <= t);
                    float x = X[4 * g + i]; if (ML) x *= __expf(av[i] - cmt); v[i] = keep ? x : 0.f; rs += v[i]; }
                u32x2 pk; pk.x = cvtpk(v[0], v[1]); pk.y = cvtpk(v[2], v[3]);
                LWR(u32x2, prow, g * 16) = pk;
            }
            if (ML) { rs += __shfl_xor(rs, 32); if (hh == 0) LWR(float, tab, T_DS + (si * 64 + t) * 4) = rs; }
        } else if (ML) {
            const int j = tid - 256, t = j >> 2, part = j & 3;
            LAS unsigned char* qrow = Qs + t * QB_ + part * (DK / 4) * 2; LAS unsigned char* nrow = tab + T_N + part * (DK / 4) * 4;
            float a = 0.f;
#pragma unroll
            for (int d8 = 0; d8 < DK / 32; ++d8) { const u32x4 qv = LRD(u32x4, qrow, d8 * 16); const f32x4 n0 = LRD(f32x4, nrow, d8 * 32), n1 = LRD(f32x4, nrow, d8 * 32 + 16);
                a += __uint_as_float(qv.x << 16) * n0.x + __uint_as_float(qv.x & 0xffff0000u) * n0.y + __uint_as_float(qv.y << 16) * n0.z + __uint_as_float(qv.y & 0xffff0000u) * n0.w
                   + __uint_as_float(qv.z << 16) * n1.x + __uint_as_float(qv.z & 0xffff0000u) * n1.y + __uint_as_float(qv.w << 16) * n1.z + __uint_as_float(qv.w & 0xffff0000u) * n1.w; }
            a += __shfl_xor(a, 1); a += __shfl_xor(a, 2);
            if (part == 0) LWR(float, tab, T_D1 + t * 4) = a;
            if (j < 64) { const float cmt = fmaxf(m_prev, LRD(float, tab, T_CM + j * 4));
                LWR(float, tab, T_WI + j * 4) = __expf(m_prev - cmt); LWR(float, tab, T_FL + j * 4) = __expf(-(LRD(float, tab, T_B + j * 4) + cmt)); LWR(float, tab, T_W + j * 4) = __expf(LRD(float, tab, T_A + j * 4) - Mx); }
        }
        __syncthreads();
#pragma unroll
        for (int tt = 0; tt < 2; ++tt) {
            f32x16 O;
#pragma unroll
            for (int i = 0; i < 16; ++i) O[i] = 0.f;
#pragma unroll
            for (int dt = 0; dt < NDT; ++dt)
#pragma unroll
                for (int sp = 0; sp < 2; ++sp) {
                    const bf16x8 bs = pack8(S[dt], sp);
                    const u32x2 lo = LRD(u32x2, qfrag, tt * 32 * QB_ + dt * 64 + sp * 32), hi = LRD(u32x2, qfrag, tt * 32 * QB_ + dt * 64 + sp * 32 + 16);
                    const u32x4 av = {lo.x, lo.y, hi.x, hi.y};
                    O = mfma32(__builtin_bit_cast(bf16x8, av), bs, O);
                    if (ML) __builtin_amdgcn_sched_barrier(0);
                }
            if (ML) {
#pragma unroll
                for (int g = 0; g < 4; ++g) { const f32x4 wi = LRD(f32x4, tabh, T_WI + (32 * tt + 8 * g) * 4);
                    O[4 * g] *= wi.x; O[4 * g + 1] *= wi.y; O[4 * g + 2] *= wi.z; O[4 * g + 3] *= wi.w; }
            }
#pragma unroll
            for (int ks = 0; ks < 4; ++ks) O = mfma32(LRD(bf16x8, pfrag, tt * 32 * TB_ + ks * 32), Bv[ks], O);
            bf16_t* orow = og + (m0 + 32 * tt + 4 * hh) * 1024;
#pragma unroll
            for (int g = 0; g < 4; ++g) {
                f32x4 rd = {1.f, 1.f, 1.f, 1.f};
                if (ML) { const int to = (32 * tt + 8 * g) * 4;
                    const f32x4 wi = LRD(f32x4, tabh, T_WI + to), d1 = LRD(f32x4, tabh, T_D1 + to), ds0 = LRD(f32x4, tabh, T_DS + to), ds1 = LRD(f32x4, tabh, T_DS + 256 + to), fl = LRD(f32x4, tabh, T_FL + to);
                    const f32x4 den = wi * d1 + ds0 + ds1;
                    rd.x = 1.f / fmaxf(fabsf(den.x), fl.x); rd.y = 1.f / fmaxf(fabsf(den.y), fl.y); rd.z = 1.f / fmaxf(fabsf(den.z), fl.z); rd.w = 1.f / fmaxf(fabsf(den.w), fl.w); }
#pragma unroll
                for (int i = 0; i < 4; ++i) orow[(8 * g + i) * 1024] = f2bf(O[4 * g + i] * rd[i]);
            }
            __builtin_amdgcn_sched_barrier(0);
        }
        if (ML) {
#pragma unroll
            for (int ks = 0; ks < 4; ++ks) {
                const f32x4 w0 = LRD(f32x4, tab, T_W + (16 * ks + 8 * hh) * 4), w1 = LRD(f32x4, tab, T_W + (16 * ks + 8 * hh + 4) * 4);
                const u32x4 bv = __builtin_bit_cast(u32x4, Bv[ks]); u32x4 o;
                o.x = cvtpk(__uint_as_float(bv.x << 16) * w0.x, __uint_as_float(bv.x & 0xffff0000u) * w0.y);
                o.y = cvtpk(__uint_as_float(bv.y << 16) * w0.z, __uint_as_float(bv.y & 0xffff0000u) * w0.w);
                o.z = cvtpk(__uint_as_float(bv.z << 16) * w1.x, __uint_as_float(bv.z & 0xffff0000u) * w1.y);
                o.w = cvtpk(__uint_as_float(bv.w << 16) * w1.z, __uint_as_float(bv.w & 0xffff0000u) * w1.w);
                Bv[ks] = __builtin_bit_cast(bf16x8, o);
            }
        }
#pragma unroll
        for (int dt = 0; dt < NDT; ++dt) {
            if (ML) {
#pragma unroll
                for (int i = 0; i < 16; ++i) S[dt][i] *= w_old;
            }
#pragma unroll
            for (int ks = 0; ks < 4; ++ks) S[dt] = mfma32(LRD(bf16x8, ktfrag, dt * 32 * TB_ + ks * 32), Bv[ks], S[dt]);
            if (ML) __builtin_amdgcn_sched_barrier(0);
            if (!ML) {
#pragma unroll
                for (int g = 0; g < 4; ++g) { const f32x4 gg = LRD(f32x4, tabh, T_G + (32 * dt + 8 * g) * 4);
                    S[dt][4 * g] *= gg.x; S[dt][4 * g + 1] *= gg.y; S[dt][4 * g + 2] *= gg.z; S[dt][4 * g + 3] *= gg.w; }
            }
        }
        if (ML) {
            if (tid < 256) { float a = 0.f; LAS unsigned char* krow = KTs + tid * TB_;
#pragma unroll
                for (int s8 = 0; s8 < 8; ++s8) { const u32x4 kv = LRD(u32x4, krow, s8 * 16); const f32x4 w0 = LRD(f32x4, tab, T_W + s8 * 32), w1 = LRD(f32x4, tab, T_W + s8 * 32 + 16);
                    a += __uint_as_float(kv.x << 16) * w0.x + __uint_as_float(kv.x & 0xffff0000u) * w0.y + __uint_as_float(kv.y << 16) * w0.z + __uint_as_float(kv.y & 0xffff0000u) * w0.w
                       + __uint_as_float(kv.z << 16) * w1.x + __uint_as_float(kv.z & 0xffff0000u) * w1.y + __uint_as_float(kv.w << 16) * w1.z + __uint_as_float(kv.w & 0xffff0000u) * w1.w; }
                LWR(float, tab, T_N + tid * 4) = w_old * LRD(float, tab, T_N + tid * 4) + a; }
            m_prev = Btot + Mx;
        }
    }
}
DI f32x4 mfma16(bf16x8 a, bf16x8 b, f32x4 c) { return __builtin_amdgcn_mfma_f32_16x16x32_bf16(a, b, c, 0, 0, 0); }
template <int DK, bool ML, bool PRE>
DI void scan16(const Params& P, float* ldsf, int item, int skip = 0) {
    constexpr int NDT = DK / 16, NJ = DK / 32, QLD = DK + 8, TLD = 72, FT = ML ? 1024 : 512;
    constexpr int QB_ = QLD * 2, TB_ = TLD * 2;
    LAS unsigned char* L0 = (LAS unsigned char*)ldsf;
    LAS unsigned char* Qs = L0; LAS unsigned char* Ks = Qs + 64 * QB_; LAS unsigned char* KTs = Ks + 64 * QB_; LAS unsigned char* Ps = KTs + DK * TB_;
    LAS unsigned char* tab = Ps + 64 * TB_;
    constexpr int T_A = 0, T_CM = 256, T_B = 512, T_W = 768, T_WI = 1024, T_FL = 1280, T_D1 = 1536, T_DS = 1792, T_G = 2816, T_N = 3328, T_BT = 4352, T_CL = 4608;
    const int eh = item & 1, dir = (item >> 1) & 1, h = (item >> 2) & 3, b = item >> 4;
    const bf16_t* qg = (ML ? WSP(bf16_t, WS_QM) : (dir ? WSP(bf16_t, WS_QB) : WSP(bf16_t, WS_QF))) + h * DK;
    const bf16_t* kg_ = (ML ? WSP(bf16_t, WS_KM) : (dir ? WSP(bf16_t, WS_KB) : WSP(bf16_t, WS_KF))) + h * DK;
    const bf16_t* ktg = (ML ? WSP(bf16_t, WS_KMT) : (dir ? WSP(bf16_t, WS_KTB) : WSP(bf16_t, WS_KTF))) + (size_t)h * DK * MTOK;
    const bf16_t* vtg0 = (ML ? WSP(bf16_t, WS_VMT) : WSP(bf16_t, WS_VTG)) + (size_t)(h * 256 + 128 * eh) * MTOK;
    bf16_t* og0 = obuf(P, (ML ? 2 : 0) + dir) + h * 256 + 128 * eh;
    const float* msc = WSP(float, WS_MSC) + (size_t)(dir * 4 + h) * MTOK; const float* mch = WSP(float, WS_MCH) + ((dir * 4 + b) * 4 + h) * 64;
    f32x4 S[NDT];
#pragma unroll
    for (int dt = 0; dt < NDT; ++dt) S[dt] = (f32x4){0.f, 0.f, 0.f, 0.f};
    if (ML && threadIdx.x < 256) LWR(float, tab, T_N + threadIdx.x * 4) = 0.f;
    const int sidx = (dir * 4 + b) * 4 + h;
    if (ML && !PRE && threadIdx.x < 64) { LWR(float, tab, T_BT + threadIdx.x * 4) = mch[threadIdx.x]; LWR(float, tab, T_CL + threadIdx.x * 4) = mch[2048 + threadIdx.x]; }
    if (PRE && threadIdx.x < 64) LWR(float, tab, T_BT + threadIdx.x * 4) = WSP(float, WS_PRES)[sidx * 64 + threadIdx.x];
    __syncthreads();
    float m_prev = 0.f;
    constexpr int NQ = 64 * DK / 8 / NTHR, NKT = DK * 8 / NTHR;
    u32x4 rq[NQ], rk[NQ], rkt[NKT]; bf16x8 Bn[2]; float rt0 = 0.f, rt1 = 0.f, rt2 = 0.f;
    constexpr unsigned QSTEP = (unsigned)(NTHR / (DK / 8)) * FT * 2u, KTSTEP = 64u * MTOK * 2u;
#define SCAN16_TID() unsigned t0_ = threadIdx.x; asm volatile("" : "+v"(t0_))
#define SCAN16_VOQ() (((t0_ / (DK / 8)) * FT + (t0_ % (DK / 8)) * 8) * 2u)
#define SCAN16_VOKT() ((t0_ >> 3) * (unsigned)(MTOK * 2) + (t0_ & 7) * 16u)
#define SCAN16_VOV() ((16 * (t0_ >> 6) + (t0_ & 15)) * (unsigned)(MTOK * 2) + ((t0_ & 63) >> 4) * 16u)
#define LDG(T, ubase, voff) (*(const T*)((const char*)(ubase) + (voff)))
#define SCAN16_LOAD(cc) do { const size_t m0n = (size_t)b * SEQ + (size_t)(cc) * CH; SCAN16_TID(); const unsigned voq = SCAN16_VOQ(), vov = SCAN16_VOV(); \
        const char* qb_ = (const char*)(qg + m0n * FT); const char* kb_ = (const char*)(kg_ + m0n * FT); \
        _Pragma("unroll") for (int i = 0; i < NQ; ++i) { rq[i] = LDG(u32x4, qb_ + (size_t)i * QSTEP, voq); if (!PRE) rk[i] = LDG(u32x4, kb_ + (size_t)i * QSTEP, voq); } \
        if (PRE) { rk[0] = LDG(u32x4, (const char*)(WSP(bf16_t, WS_PREP) + (size_t)(sidx * 64 + (cc)) * 4096), t0_ * 16u); } \
        { const char* vb_ = (const char*)(vtg0 + m0n); Bn[0] = LDG(bf16x8, vb_, vov); Bn[1] = LDG(bf16x8, vb_ + 64, vov); } \
        if (PRE) { if (t0_ < 256) rt0 = WSP(float, WS_PRET)[(size_t)(sidx * 64 + (cc)) * 256 + t0_]; } \
        else if (ML) { if (t0_ < 64) { rt0 = msc[m0n + t0_]; rt1 = msc[(size_t)8 * MTOK + m0n + t0_]; rt2 = msc[(size_t)16 * MTOK + m0n + t0_]; } } \
        else { if (t0_ < 128) rt0 = WSP(float, WS_GDEC)[((size_t)(dir * NB + b) * NCH + (cc)) * 512 + h * 128 + t0_]; } } while (0)
#define SCAN16_LOADKT(cc) do { const size_t m0n = (size_t)b * SEQ + (size_t)(cc) * CH; SCAN16_TID(); const unsigned vokt = SCAN16_VOKT(); const char* tb_ = (const char*)(ktg + m0n); \
        _Pragma("unroll") for (int i = 0; i < NKT; ++i) rkt[i] = LDG(u32x4, tb_ + (size_t)i * KTSTEP, vokt); } while (0)
    SCAN16_LOAD(dir ? NCH - 1 : 0); SCAN16_LOADKT(dir ? NCH - 1 : 0);
    for (int ci = 0; ci < NCH; ++ci) {
        const int c = dir ? NCH - 1 - ci : ci; const size_t m0 = (size_t)b * SEQ + (size_t)c * CH;
        int tid = threadIdx.x; asm volatile("" : "+v"(tid));
        const int lane = tid & 63, w = __builtin_amdgcn_readfirstlane(tid >> 6), c16 = lane & 15, kg = lane >> 4;
        LAS unsigned char* qfrag = Qs + c16 * QB_ + kg * 16;
        LAS unsigned char* pfrag = Ps + c16 * TB_ + kg * 16;
        LAS unsigned char* ktfrag = KTs + c16 * TB_ + kg * 16;
        LAS unsigned char* tabk = tab + kg * 16;
        __syncthreads();
#pragma unroll
        for (int i = 0; i < NQ; ++i) { const int p = tid + i * NTHR, row = p / (DK / 8), c8 = p % (DK / 8);
            const int wq = c8 & 3, off = row * QB_ + (c8 >> 2) * 64 + ((wq & 1) * 16 + (wq >> 1) * 4) * 2;
            LWR(u32x2, Qs, off) = (u32x2){rq[i].x, rq[i].y}; LWR(u32x2, Qs, off + 16) = (u32x2){rq[i].z, rq[i].w};
            if (!PRE) { LWR(u32x2, Ks, off) = (u32x2){rk[i].x, rk[i].y}; LWR(u32x2, Ks, off + 16) = (u32x2){rk[i].z, rk[i].w}; } }
        if (PRE) LWR(u32x4, Ps, (tid >> 3) * TB_ + (tid & 7) * 16) = rk[0];
#pragma unroll
        for (int i = 0; i < NKT; ++i) { const int p = tid + i * NTHR, d = p >> 3, c8 = p & 7; LWR(u32x4, KTs, d * TB_ + c8 * 16) = rkt[i]; }
        bf16x8 Bv[2]; Bv[0] = Bn[0]; Bv[1] = Bn[1];
        float Mx = 0.f, w_old = 1.f, Btot = 0.f;
        if (PRE) {
            if (tid < 256) LWR(float, tab, (tid < 192 ? T_W + tid * 4 : T_DS + (tid - 192) * 4)) = rt0;
            w_old = LRD(float, tab, T_BT + c * 4);
        } else if (ML) {
            if (tid < 64) { LWR(float, tab, T_B + tid * 4) = rt0; LWR(float, tab, T_A + tid * 4) = rt1; LWR(float, tab, T_CM + tid * 4) = rt2; }
            Btot = LRD(float, tab, T_BT + c * 4); const float cml = LRD(float, tab, T_CL + c * 4); Mx = fmaxf(m_prev, cml); w_old = __expf(m_prev - Mx);
        } else {
            if (tid < 128) LWR(float, tab, T_G + tid * 4) = rt0;
        }
        __syncthreads();
        if (ci + 1 < NCH) SCAN16_LOAD(dir ? NCH - 2 - ci : ci + 1);
#define SB() __builtin_amdgcn_sched_barrier(0)
        if (!PRE && !(skip & 1)) {
            constexpr int NS = DK / 64;
            const int idx0 = 2 * w, si0 = idx0 >> 2, ti0 = idx0 & 3, si1 = (idx0 + 1) >> 2, ti1 = (idx0 + 1) & 3;
            const bool dead0 = dir ? (si0 < ti0) : (si0 > ti0), dead1 = dir ? (si1 < ti1) : (si1 > ti1);
            LAS unsigned char* ka0 = Ks + (16 * si0 + c16) * QB_ + kg * 16; LAS unsigned char* qa0 = Qs + (16 * ti0 + c16) * QB_ + kg * 16;
            LAS unsigned char* ka1 = Ks + (16 * si1 + c16) * QB_ + kg * 16; LAS unsigned char* qa1 = Qs + (16 * ti1 + c16) * QB_ + kg * 16;
            f32x4 X0 = {0.f, 0.f, 0.f, 0.f}, X1 = {0.f, 0.f, 0.f, 0.f};
            if (!ML) {
                bf16x8 fa[2][2], fb[2][2];
                fa[0][0] = LRD(bf16x8, ka0, 0); fb[0][0] = LRD(bf16x8, qa0, 0); fa[0][1] = LRD(bf16x8, ka0, 64); fb[0][1] = LRD(bf16x8, qa0, 64);
#pragma unroll
                for (int st = 0; st < 2 * NS; ++st) {
                    if (st + 1 < 2 * NS) {
                        const int sn = st + 1, nb_ = sn & 1, ko = (sn % NS) * 2;
                        LAS unsigned char* kan = (sn < NS) ? ka0 : ka1; LAS unsigned char* qan = (sn < NS) ? qa0 : qa1;
                        fa[nb_][0] = LRD(bf16x8, kan, ko * 64); fb[nb_][0] = LRD(bf16x8, qan, ko * 64); fa[nb_][1] = LRD(bf16x8, kan, (ko + 1) * 64); fb[nb_][1] = LRD(bf16x8, qan, (ko + 1) * 64);
                    }
                    SB();
                    if (st < NS) { if (!dead0) { X0 = mfma16(fa[st & 1][0], fb[st & 1][0], X0); X0 = mfma16(fa[st & 1][1], fb[st & 1][1], X0); } }
                    else { if (!dead1) { X1 = mfma16(fa[st & 1][0], fb[st & 1][0], X1); X1 = mfma16(fa[st & 1][1], fb[st & 1][1], X1); } }
                    SB();
                }
            } else {
#pragma unroll
                for (int st = 0; st < 2 * NS; ++st) {
                    const int ko = (st % NS) * 2; LAS unsigned char* kan = (st < NS) ? ka0 : ka1; LAS unsigned char* qan = (st < NS) ? qa0 : qa1;
                    const bool dd = (st < NS) ? dead0 : dead1;
                    if (!dd) {
                        const bf16x8 a0 = LRD(bf16x8, kan, ko * 64), b0 = LRD(bf16x8, qan, ko * 64), a1 = LRD(bf16x8, kan, (ko + 1) * 64), b1 = LRD(bf16x8, qan, (ko + 1) * 64);
                        if (st < NS) { X0 = mfma16(a0, b0, X0); X0 = mfma16(a1, b1, X0); } else { X1 = mfma16(a0, b0, X1); X1 = mfma16(a1, b1, X1); }
                    }
                    SB();
                }
            }
#pragma unroll
            for (int q2 = 0; q2 < 2; ++q2) {
                const int si = q2 ? si1 : si0, ti = q2 ? ti1 : ti0; const f32x4 X = q2 ? X1 : X0;
                const int t = 16 * ti + c16;
                float cmt = 0.f; if (ML) cmt = fmaxf(m_prev, LRD(float, tab, T_CM + t * 4));
                f32x4 av = {0.f, 0.f, 0.f, 0.f}; if (ML) av = LRD(f32x4, tab, T_A + (16 * si + 4 * kg) * 4);
                float v[4], rs = 0.f;
#pragma unroll
                for (int i = 0; i < 4; ++i) { const int s = 16 * si + 4 * kg + i; const bool keep = dir ? (s >= t) : (s <= t);
                    float x = X[i]; if (ML) x *= __expf(av[i] - cmt); v[i] = keep ? x : 0.f; rs += v[i]; }
                u32x2 pk; pk.x = cvtpk(v[0], v[1]); pk.y = cvtpk(v[2], v[3]);
                LWR(u32x2, Ps, t * TB_ + (16 * si + 4 * kg) * 2) = pk;
                if (ML) { rs += __shfl_xor(rs, 16); rs += __shfl_xor(rs, 32); if (kg == 0) LWR(float, tab, T_DS + (si * 64 + t) * 4) = rs; }
            }
        }
        if (ML && !(skip & 1)) {
            const int t = tid >> 3, part = tid & 7;
            LAS unsigned char* qrow = Qs + t * QB_ + part * (DK / 8) * 2; LAS unsigned char* nrow = tab + T_N + part * (DK / 8) * 4;
            u32x4 qv[DK / 64]; f32x4 n0[DK / 64], n1[DK / 64];
#pragma unroll
            for (int d8 = 0; d8 < DK / 64; ++d8) { qv[d8] = LRD(u32x4, qrow, d8 * 16); n0[d8] = LRD(f32x4, nrow, d8 * 32); n1[d8] = LRD(f32x4, nrow, d8 * 32 + 16); }
            float cmv = 0.f, bvv = 0.f, avv = 0.f;
            if (!PRE && tid < 64) { cmv = LRD(float, tab, T_CM + tid * 4); bvv = LRD(float, tab, T_B + tid * 4); avv = LRD(float, tab, T_A + tid * 4); }
            SB();
            float a = 0.f;
#pragma unroll
            for (int d8 = 0; d8 < DK / 64; ++d8) {
                a += __uint_as_float(qv[d8].x << 16) * n0[d8].x + __uint_as_float(qv[d8].x & 0xffff0000u) * n0[d8].y + __uint_as_float(qv[d8].y << 16) * n0[d8].z + __uint_as_float(qv[d8].y & 0xffff0000u) * n0[d8].w
                   + __uint_as_float(qv[d8].z << 16) * n1[d8].x + __uint_as_float(qv[d8].z & 0xffff0000u) * n1[d8].y + __uint_as_float(qv[d8].w << 16) * n1[d8].z + __uint_as_float(qv[d8].w & 0xffff0000u) * n1[d8].w; }
            a += __shfl_xor(a, 1); a += __shfl_xor(a, 2); a += __shfl_xor(a, 4);
            if (part == 0) LWR(float, tab, T_D1 + t * 4) = a;
            if (!PRE && tid < 64) { const float cmt = fmaxf(m_prev, cmv);
                LWR(float, tab, T_WI + tid * 4) = __expf(m_prev - cmt); LWR(float, tab, T_FL + tid * 4) = __expf(-(bvv + cmt)); LWR(float, tab, T_W + tid * 4) = __expf(avv - Mx); }
        }
        __syncthreads();
        bf16x8 qa[2][4];
#pragma unroll
        for (int tt = 0; tt < 4; ++tt) qa[0][tt] = LRD(bf16x8, qfrag, tt * 16 * QB_);
        f32x4 O[4];
#pragma unroll
        for (int tt = 0; tt < 4; ++tt) O[tt] = (f32x4){0.f, 0.f, 0.f, 0.f};
        if (!(skip & 2))
#pragma unroll
        for (int j = 0; j < NJ; ++j) {
            if (j + 1 < NJ) {
#pragma unroll
                for (int tt = 0; tt < 4; ++tt) qa[(j + 1) & 1][tt] = LRD(bf16x8, qfrag, tt * 16 * QB_ + (j + 1) * 64);
            }
            SB();
            u32x4 bp; bp.x = cvtpk(S[2 * j][0], S[2 * j][1]); bp.y = cvtpk(S[2 * j][2], S[2 * j][3]); bp.z = cvtpk(S[2 * j + 1][0], S[2 * j + 1][1]); bp.w = cvtpk(S[2 * j + 1][2], S[2 * j + 1][3]);
            const bf16x8 bs = __builtin_bit_cast(bf16x8, bp);
#pragma unroll
            for (int tt = 0; tt < 4; ++tt) O[tt] = mfma16(bs, qa[j & 1][tt], O[tt]);
        }
        if (ci + 1 < NCH) SCAN16_LOADKT(dir ? NCH - 2 - ci : ci + 1);
        bf16x8 kt[2][2];
        kt[0][0] = LRD(bf16x8, ktfrag, 0); kt[0][1] = LRD(bf16x8, ktfrag, 64);
        unsigned opk[4][2];
#pragma unroll
        for (int tt = 0; tt < 4; ++tt) {
            const bf16x8 p0 = LRD(bf16x8, pfrag, tt * 16 * TB_), p1 = LRD(bf16x8, pfrag, tt * 16 * TB_ + 64);
            float wi = 1.f, d1 = 0.f, fl = 0.f, ds = 0.f;
            if (ML) { const int to = (16 * tt + c16) * 4;
                wi = LRD(float, tab, T_WI + to); d1 = LRD(float, tab, T_D1 + to); fl = LRD(float, tab, T_FL + to);
                ds = LRD(float, tab, T_DS + to); if (!PRE) ds += LRD(float, tab, T_DS + 256 + to) + LRD(float, tab, T_DS + 512 + to) + LRD(float, tab, T_DS + 768 + to); }
            SB();
            float rd = 1.f;
            if (ML) { O[tt] = O[tt] * wi; rd = frcp(fmaxf(fabsf(wi * d1 + ds), fl)); }
            O[tt] = mfma16(Bv[0], p0, O[tt]); O[tt] = mfma16(Bv[1], p1, O[tt]);
            opk[tt][0] = cvtpk(O[tt][0] * rd, O[tt][1] * rd); opk[tt][1] = cvtpk(O[tt][2] * rd, O[tt][3] * rd);
        }
#pragma unroll
        for (int tp = 0; tp < 2; ++tp) {
            const auto r0 = __builtin_amdgcn_permlane16_swap(opk[2 * tp][0], opk[2 * tp + 1][0], false, false); const auto r1 = __builtin_amdgcn_permlane16_swap(opk[2 * tp][1], opk[2 * tp + 1][1], false, false);
            u32x4 o; o.x = r0[0]; o.y = r1[0]; o.z = r0[1]; o.w = r1[1];
            if (!(skip & 8)) *(u32x4*)(og0 + (m0 + 16 * (2 * tp + (kg & 1)) + c16) * 1024 + 16 * w + 8 * (kg >> 1)) = o;
        }
        if (ML) {
            const f32x4 wv0 = LRD(f32x4, tab, T_W + (8 * kg) * 4), wv1 = LRD(f32x4, tab, T_W + (8 * kg + 4) * 4), wv2 = LRD(f32x4, tab, T_W + (32 + 8 * kg) * 4), wv3 = LRD(f32x4, tab, T_W + (32 + 8 * kg + 4) * 4);
            { const u32x4 bv = __builtin_bit_cast(u32x4, Bv[0]); u32x4 o;
              o.x = cvtpk(__uint_as_float(bv.x << 16) * wv0.x, __uint_as_float(bv.x & 0xffff0000u) * wv0.y); o.y = cvtpk(__uint_as_float(bv.y << 16) * wv0.z, __uint_as_float(bv.y & 0xffff0000u) * wv0.w);
              o.z = cvtpk(__uint_as_float(bv.z << 16) * wv1.x, __uint_as_float(bv.z & 0xffff0000u) * wv1.y); o.w = cvtpk(__uint_as_float(bv.w << 16) * wv1.z, __uint_as_float(bv.w & 0xffff0000u) * wv1.w);
              Bv[0] = __builtin_bit_cast(bf16x8, o); }
            { const u32x4 bv = __builtin_bit_cast(u32x4, Bv[1]); u32x4 o;
              o.x = cvtpk(__uint_as_float(bv.x << 16) * wv2.x, __uint_as_float(bv.x & 0xffff0000u) * wv2.y); o.y = cvtpk(__uint_as_float(bv.y << 16) * wv2.z, __uint_as_float(bv.y & 0xffff0000u) * wv2.w);
              o.z = cvtpk(__uint_as_float(bv.z << 16) * wv3.x, __uint_as_float(bv.z & 0xffff0000u) * wv3.y); o.w = cvtpk(__uint_as_float(bv.w << 16) * wv3.z, __uint_as_float(bv.w & 0xffff0000u) * wv3.w);
              Bv[1] = __builtin_bit_cast(bf16x8, o); }
        }
        f32x4 gdec[NDT];
        if (!ML) {
#pragma unroll
            for (int dt = 0; dt < NDT; ++dt) gdec[dt] = LRD(f32x4, tabk, T_G + dt * 64);
        }
        if (!(skip & 4))
#pragma unroll
        for (int dt = 0; dt < NDT; ++dt) {
            if (dt + 1 < NDT) { kt[(dt + 1) & 1][0] = LRD(bf16x8, ktfrag, (dt + 1) * 16 * TB_); kt[(dt + 1) & 1][1] = LRD(bf16x8, ktfrag, (dt + 1) * 16 * TB_ + 64); }
            SB();
            if (ML) S[dt] = S[dt] * w_old;
            S[dt] = mfma16(kt[dt & 1][0], Bv[0], S[dt]); S[dt] = mfma16(kt[dt & 1][1], Bv[1], S[dt]);
            if (!ML) S[dt] = S[dt] * gdec[dt];
        }
        if (ML) {
            if (tid < 256) { float a = 0.f; LAS unsigned char* krow = KTs + tid * TB_;
                const int dd = tid & 31, npos = (tid & ~31) + 8 * ((dd & 15) >> 2) + 4 * (dd >> 4) + (dd & 3);
                u32x4 kv[8]; f32x4 w0[8], w1[8];
#pragma unroll
                for (int s8 = 0; s8 < 8; ++s8) { kv[s8] = LRD(u32x4, krow, s8 * 16); w0[s8] = LRD(f32x4, tab, T_W + s8 * 32); w1[s8] = LRD(f32x4, tab, T_W + s8 * 32 + 16); }
                const float nold = LRD(float, tab, T_N + npos * 4);
                SB();
#pragma unroll
                for (int s8 = 0; s8 < 8; ++s8) {
                    a += __uint_as_float(kv[s8].x << 16) * w0[s8].x + __uint_as_float(kv[s8].x & 0xffff0000u) * w0[s8].y + __uint_as_float(kv[s8].y << 16) * w0[s8].z + __uint_as_float(kv[s8].y & 0xffff0000u) * w0[s8].w
                       + __uint_as_float(kv[s8].z << 16) * w1[s8].x + __uint_as_float(kv[s8].z & 0xffff0000u) * w1[s8].y + __uint_as_float(kv[s8].w << 16) * w1[s8].z + __uint_as_float(kv[s8].w & 0xffff0000u) * w1[s8].w; }
                LWR(float, tab, T_N + npos * 4) = w_old * nold + a; }
            m_prev = Btot + Mx;
        }
    }
#undef SB
}
#undef SCAN16_LOAD
#undef SCAN16_LOADKT
#undef LDG
#undef SCAN16_TID
#undef SCAN16_VOQ
#undef SCAN16_VOKT
#undef SCAN16_VOV
DI void p3b_ml_pre(const Params& P, float* ldsf, int bid, int nb) {
    constexpr int DK = 256, QB_ = (DK + 8) * 2;
    LAS unsigned char* L0 = (LAS unsigned char*)ldsf;
    LAS unsigned char* Qs = L0; LAS unsigned char* Ks = Qs + 64 * QB_; LAS unsigned char* tab0 = Ks + 64 * QB_;
    constexpr int T_A = 0, T_CM = 256, T_B = 512, T_DS = 768, T_BT = 1792, T_CL = 2048, TABSZ = 2304;
    const int tid = threadIdx.x, lane = tid & 63, w = __builtin_amdgcn_readfirstlane(tid >> 6), c16 = lane & 15, kg = lane >> 4;
    const int td = __builtin_amdgcn_readfirstlane((tid >> 6) & 1), tl = tid & 63;
    for (int item = bid; item < 256; item += nb) {
        const int o2 = item & 15, h = (item >> 4) & 3, b = item >> 6, c0 = 4 * o2;
        const bf16_t* qg = WSP(bf16_t, WS_QM) + h * DK; const bf16_t* kg_ = WSP(bf16_t, WS_KM) + h * DK;
        __syncthreads();
        if (tid < 128) { const float* mch = WSP(float, WS_MCH) + ((td * 4 + b) * 4 + h) * 64; LWR(float, tab0 + td * TABSZ, T_BT + tl * 4) = mch[tl]; LWR(float, tab0 + td * TABSZ, T_CL + tl * 4) = mch[2048 + tl]; }
        __syncthreads();
        float mpf = 0.f;
        for (int c = 0; c < c0; ++c) mpf = LRD(float, tab0, T_BT + c * 4) + fmaxf(mpf, LRD(float, tab0, T_CL + c * 4));
        float mpb[4];
        { float m = 0.f;
          for (int c = NCH - 1; c > c0 + 3; --c) m = LRD(float, tab0 + TABSZ, T_BT + c * 4) + fmaxf(m, LRD(float, tab0 + TABSZ, T_CL + c * 4));
#pragma unroll
          for (int j = 3; j >= 0; --j) { mpb[j] = m; m = LRD(float, tab0 + TABSZ, T_BT + (c0 + j) * 4) + fmaxf(m, LRD(float, tab0 + TABSZ, T_CL + (c0 + j) * 4)); } }
        u32x4 rq[4], rk[4]; float r0 = 0.f, r1 = 0.f, r2 = 0.f;
#define PRE_LOAD(cc) do { const size_t m0n = (size_t)b * SEQ + (size_t)(cc) * CH; \
        _Pragma("unroll") for (int i = 0; i < 4; ++i) { const int p = tid + i * NTHR, row = p >> 5, c8 = p & 31; \
            rq[i] = *(const u32x4*)(qg + (m0n + row) * 1024 + c8 * 8); rk[i] = *(const u32x4*)(kg_ + (m0n + row) * 1024 + c8 * 8); } \
        if (tid < 128) { const float* msc = WSP(float, WS_MSC) + (size_t)(td * 4 + h) * MTOK; r0 = msc[m0n + tl]; r1 = msc[(size_t)8 * MTOK + m0n + tl]; r2 = msc[(size_t)16 * MTOK + m0n + tl]; } } while (0)
        PRE_LOAD(c0);
#pragma unroll
        for (int j = 0; j < 4; ++j) {
            const int c = c0 + j;
            __syncthreads();
#pragma unroll
            for (int i = 0; i < 4; ++i) { const int p = tid + i * NTHR, row = p >> 5, c8 = p & 31; LWR(u32x4, Qs, row * QB_ + c8 * 16) = rq[i]; LWR(u32x4, Ks, row * QB_ + c8 * 16) = rk[i]; }
            if (tid < 128) { LWR(float, tab0 + td * TABSZ, T_B + tl * 4) = r0; LWR(float, tab0 + td * TABSZ, T_A + tl * 4) = r1; LWR(float, tab0 + td * TABSZ, T_CM + tl * 4) = r2; }
            float mp[2], Mx[2];
            mp[0] = mpf; mp[1] = mpb[j];
#pragma unroll
            for (int d = 0; d < 2; ++d) Mx[d] = fmaxf(mp[d], LRD(float, tab0 + d * TABSZ, T_CL + c * 4));
            __syncthreads();
            if (j + 1 < 4) PRE_LOAD(c + 1);
#pragma unroll
            for (int q2 = 0; q2 < 2; ++q2) {
                const int idx = 2 * w + q2, si = idx >> 2, ti = idx & 3;
                f32x4 X = {0.f, 0.f, 0.f, 0.f};
                { LAS unsigned char* ka = Ks + (16 * si + c16) * QB_ + kg * 16; LAS unsigned char* qa = Qs + (16 * ti + c16) * QB_ + kg * 16;
#pragma unroll
                  for (int ks = 0; ks < DK / 32; ++ks) X = mfma16(LRD(bf16x8, ka, ks * 64), LRD(bf16x8, qa, ks * 64), X); }
                const int t = 16 * ti + c16;
#pragma unroll
                for (int d = 0; d < 2; ++d) {
                    LAS unsigned char* tab = tab0 + d * TABSZ;
                    const bool dead = d ? (si < ti) : (si > ti);
                    const float cmt = fmaxf(mp[d], LRD(float, tab, T_CM + t * 4));
                    const f32x4 av = LRD(f32x4, tab, T_A + (16 * si + 4 * kg) * 4);
                    float v[4], rs = 0.f;
#pragma unroll
                    for (int i = 0; i < 4; ++i) { const int s = 16 * si + 4 * kg + i; const bool keep = !dead && (d ? (s >= t) : (s <= t));
                        const float x = X[i] * __expf(av[i] - cmt); v[i] = keep ? x : 0.f; rs += v[i]; }
                    u32x2 pk; pk.x = cvtpk(v[0], v[1]); pk.y = cvtpk(v[2], v[3]);
                    bf16_t* pg = WSP(bf16_t, WS_PREP) + (size_t)((((d * 4 + b) * 4 + h)) * 64 + c) * 4096;
                    *(u32x2*)(pg + t * 64 + 16 * si + 4 * kg) = pk;
                    rs += __shfl_xor(rs, 16); rs += __shfl_xor(rs, 32);
                    if (kg == 0) LWR(float, tab, T_DS + (si * 64 + t) * 4) = rs;
                }
            }
            __syncthreads();
            if (tid < 128) {
                LAS unsigned char* tab = tab0 + td * TABSZ; const int sidx = (td * 4 + b) * 4 + h;
                const float mpd = td ? mp[1] : mp[0], Mxd = td ? Mx[1] : Mx[0];
                const float cmt = fmaxf(mpd, LRD(float, tab, T_CM + tl * 4));
                float* tg = WSP(float, WS_PRET) + (size_t)(sidx * 64 + c) * 256;
                tg[tl] = __expf(LRD(float, tab, T_A + tl * 4) - Mxd);
                tg[64 + tl] = __expf(mpd - cmt);
                tg[128 + tl] = __expf(-(LRD(float, tab, T_B + tl * 4) + cmt));
                tg[192 + tl] = (LRD(float, tab, T_DS + tl * 4) + LRD(float, tab, T_DS + 256 + tl * 4)) + (LRD(float, tab, T_DS + 512 + tl * 4) + LRD(float, tab, T_DS + 768 + tl * 4));
                if (tl == 0) WSP(float, WS_PRES)[sidx * 64 + c] = __expf(mpd - Mxd);
            }
            mpf = LRD(float, tab0, T_BT + c * 4) + Mx[0];
        }
#undef PRE_LOAD
    }
}

#ifndef FAST_GLA
#define FAST_GLA 1
#endif
#ifndef FAST_ML
#define FAST_ML 0
#endif
DI void p4_scans(const Params& P, float* lds, int bid, int nb, int skip = 0) {
    if (nb >= 256 && bid >= 128) {
        if (!skip) { { SchedKV S{&P, bid - 128}; EpiP1 E{&P}; gemm_run(lds, DM, DM, DM, S, E); } __syncthreads(); p0_prologue(P, lds, bid - 128, nb - 128, 1); }
        return; }
    for (int it = bid; it < 128; it += nb) {
        __syncthreads();
        if (it & 1) scan16<256, true, true>(P, lds, it >> 1, skip);
        else { scan16<128, false, false>(P, lds, it >> 1, skip); if (!skip) { __syncthreads(); p0_prologue(P, lds, it >> 1, 64, 2); } }
    }
    if (nb < 256) { for (int l = bid; l < 64; l += nb) { SchedKV S{&P, l}; EpiP1 E{&P}; gemm_run(lds, DM, DM, DM, S, E); __syncthreads(); } p0_prologue(P, lds, bid, nb, 1); }
}

DI void p5_combine(const Params& P, int bid, int nb) {
    const int lane = threadIdx.x & 63, gw = bid * 8 + (threadIdx.x >> 6), ngw = nb * 8;
    for (int m = gw; m < MTOK; m += ngw) {
        u32x2 a[2][4], bq[2][4], gt[2][4];
#pragma unroll
        for (int mixer = 0; mixer < 2; ++mixer)
#pragma unroll
            for (int h = 0; h < 4; ++h) { const size_t off = (size_t)m * 1024 + h * 256 + lane * 4;
                a[mixer][h] = *(const u32x2*)(obuf(P, mixer * 2) + off); bq[mixer][h] = *(const u32x2*)(obuf(P, mixer * 2 + 1) + off);
                gt[mixer][h] = *(const u32x2*)((mixer ? WSP(bf16_t, WS_MZ) : WSP(bf16_t, WS_GG)) + off); }
#pragma unroll
        for (int mixer = 0; mixer < 2; ++mixer) {
            bf16_t* y = (mixer ? WSP(bf16_t, WS_YB) : WSP(bf16_t, WS_YA)) + (size_t)m * 1024;
#pragma unroll
            for (int h = 0; h < 4; ++h) {
                const int c0 = h * 256 + lane * 4; const u32x2 av = a[mixer][h], bv = bq[mixer][h], gv = gt[mixer][h];
                float v[4], g[4];
                v[0] = bf2f(av.x & 0xffff) + bf2f(bv.x & 0xffff); v[1] = bf2f(av.x >> 16) + bf2f(bv.x >> 16); v[2] = bf2f(av.y & 0xffff) + bf2f(bv.y & 0xffff); v[3] = bf2f(av.y >> 16) + bf2f(bv.y >> 16);
                g[0] = bf2f(gv.x & 0xffff); g[1] = bf2f(gv.x >> 16); g[2] = bf2f(gv.y & 0xffff); g[3] = bf2f(gv.y >> 16);
                const float ss = wave_sum(v[0] * v[0] + v[1] * v[1] + v[2] * v[2] + v[3] * v[3]);
                const float rstd = rsqrtf(ss * (1.f / 256.f) + EPS);
                f32x4 o;
                o.x = v[0] * rstd * (mixer ? sigmoidf_(g[0]) : siluf_(g[0])); o.y = v[1] * rstd * (mixer ? sigmoidf_(g[1]) : siluf_(g[1]));
                o.z = v[2] * rstd * (mixer ? sigmoidf_(g[2]) : siluf_(g[2])); o.w = v[3] * rstd * (mixer ? sigmoidf_(g[3]) : siluf_(g[3]));
                st_bf4(y + c0, o);
            }
        }
    }
}

struct SchedP6 {
    const Params* P; int bid, nb;
    DI bool next(int i, Unit& u) const {
        const int L2 = (i >> 1) * nb + bid; if (L2 >= 512) return false;
        const int part = i & 1; u.pm = L2 >> 3; u.pn = L2 & 7; u.kind = part; u.keep = (part == 0); u.aux = 0; u.lda = 1024; u.ldb = 1024;
        u.A = (const bf16_t*)(P->ws + (part ? WS_YB : WS_YA)) + (size_t)u.pm * 256 * 1024;
        u.B = (const bf16_t*)(P->ws + (part ? WS_WB : WS_WA)) + (size_t)u.pn * 256 * 1024;
        return true;
    }
};
struct EpiP6 {
    const Params* Pp;
    DI void operator()(Acc& acc, const Unit& u, int wr, int wc, int fr, int fq) const {
        const Params& P = *Pp;
        const bf16_t* ga = WSP(bf16_t, WS_GA); const bf16_t* gb = WSP(bf16_t, WS_GB); bf16_t* mg = WSP(bf16_t, WS_MERGED);
        ACC_FOREACH3(ai, bj, m) {
            const size_t offw = (size_t)(u.pm * 256 + ACC_ROW(ai, m)) * DM + u.pn * 256 + ACC_COLW(bj);
            if (u.kind == 0) {
                u32x2 aa[2]; ld_bf8(ga + offw, aa[0], aa[1]);
#pragma unroll
                for (int n = 0; n < 2; ++n) { f32x4& v = acc[ai][bj][m][n]; v.x *= bf2f(aa[n].x & 0xffff); v.y *= bf2f(aa[n].x >> 16); v.z *= bf2f(aa[n].y & 0xffff); v.w *= bf2f(aa[n].y >> 16); }
            } else {
                u32x2 bb[2]; ld_bf8(gb + offw, bb[0], bb[1]);
                f32x4 v[2];
#pragma unroll
                for (int n = 0; n < 2; ++n) { v[n] = acc[ai][bj][m][n]; v[n].x *= bf2f(bb[n].x & 0xffff); v[n].y *= bf2f(bb[n].x >> 16); v[n].z *= bf2f(bb[n].y & 0xffff); v[n].w *= bf2f(bb[n].y >> 16); }
                st_f8x8((unsigned char*)mg + (size_t)(u.pm * 256 + ACC_ROW(ai, m)) * P8 + u.pn * 256 + ACC_COLW(bj), v[0] * 8.f, v[1] * 8.f);
            }
        }
    }
};

struct SchedRes {
    const Params* P; int bid, nb; size_t a_off, w_off;
    DI bool next(int i, Unit& u) const {
        const int L = i * nb + bid; if (L >= 512) return false;
        u.pm = L >> 3; u.pn = L & 7; u.kind = 0; u.keep = false; u.aux = 0; u.lda = DM; u.ldb = DM;
        u.A = (const bf16_t*)(P->ws + a_off) + (size_t)u.pm * 256 * DM; u.B = (const bf16_t*)(P->ws + w_off) + (size_t)u.pn * 256 * DM;
        return true;
    }
};
template <bool F8AN>
struct EpiResT {
    const Params* Pp; const float* base; const float* gnext; size_t ss_off; float ascale;
    DI void operator()(Acc& acc, const Unit& u, int wr, int wc, int fr, int fq) const {
        const Params& P = *Pp; bf16_t* hb = WSP(bf16_t, WS_H); bf16_t* an = WSP(bf16_t, WS_XN); float* ss = WSP(float, ss_off);
        f32x4 gw[2][2];
#pragma unroll
        for (int bj = 0; bj < 2; ++bj)
#pragma unroll
            for (int n = 0; n < 2; ++n) gw[bj][n] = *(const f32x4*)(gnext + u.pn * 256 + ACC_COL(bj, n));
#pragma unroll
        for (int ai = 0; ai < 2; ++ai)
#pragma unroll
            for (int m = 0; m < 4; ++m) {
                const int row = u.pm * 256 + ACC_ROW(ai, m); float sq = 0.f;
#pragma unroll
                for (int bj = 0; bj < 2; ++bj) {
                    const size_t offw = (size_t)row * DM + u.pn * 256 + ACC_COLW(bj);
                    f32x4 h0, h1;
                    if (F8AN) { h0 = *(const f32x4*)(base + (size_t)row * DM + u.pn * 256 + ACC_COL(bj, 0)); h1 = *(const f32x4*)(base + (size_t)row * DM + u.pn * 256 + ACC_COL(bj, 1)); }
                    else { u32x2 p0, p1; ld_bf8(hb + offw, p0, p1);
                        h0 = (f32x4){bf2f(p0.x & 0xffff), bf2f(p0.x >> 16), bf2f(p0.y & 0xffff), bf2f(p0.y >> 16)}; h1 = (f32x4){bf2f(p1.x & 0xffff), bf2f(p1.x >> 16), bf2f(p1.y & 0xffff), bf2f(p1.y >> 16)}; }
                    h0 += acc[ai][bj][m][0] * ascale; h1 += acc[ai][bj][m][1] * ascale;
                    sq += h0.x * h0.x + h0.y * h0.y + h0.z * h0.z + h0.w * h0.w; sq += h1.x * h1.x + h1.y * h1.y + h1.z * h1.z + h1.w * h1.w;
                    const f32x4 a0 = h0 * gw[bj][0], a1 = h1 * gw[bj][1];
                    if (F8AN) st_f8x8((unsigned char*)an + offw, a0, a1);
                    st_bf8(hb + offw, h0, h1);
                }
                sq += __shfl_xor(sq, 16); sq += __shfl_xor(sq, 32);
                if (fq == 0) ss[(size_t)row * 32 + u.pn * 4 + wc] = sq;
            }
    }
};
DI float row_rstd(const float* ss, int row) {
    float s = 0.f;
#pragma unroll
    for (int i = 0; i < 32; i += 4) { const f32x4 v = *(const f32x4*)(ss + (size_t)row * 32 + i); s += (v.x + v.y) + (v.z + v.w); }
    return rsqrtf(s * (1.f / DM) + EPS);
}

struct EpiQ {
    const Params* Pp;
    DI void operator()(Acc& acc, const Unit& u, int wr, int wc, int fr, int fq) const {
        const Params& P = *Pp; bf16_t* q = WSP(bf16_t, WS_ATTQ); const float* ss = WSP(float, WS_SS1);
#pragma unroll
        for (int ai = 0; ai < 2; ++ai)
#pragma unroll
            for (int m = 0; m < 4; ++m) {
                const int row = u.pm * 256 + ACC_ROW(ai, m); const float sc = row_rstd(ss, row) * 0.04419417382415922f;
#pragma unroll
                for (int bj = 0; bj < 2; ++bj)
#pragma unroll
                    for (int n = 0; n < 2; ++n) st_bf4(q + (size_t)row * DM + u.pn * 256 + ACC_COL(bj, n), acc[ai][bj][m][n] * sc);
            }
    }
};
struct SchedSc {
    const Params* P; int bid, nb;
    DI bool next(int i, Unit& u) const {
        const int L = i * nb + bid; if (L >= 256) return false;
        u.pm = L >> 2; u.pn = L & 3; u.kind = 0; u.keep = false; u.aux = L; u.lda = DM; u.ldb = DM;
        u.A = (const bf16_t*)(P->ws + WS_ATTQ) + (size_t)u.pm * 256 * DM + u.pn * 512;
        u.B = (const bf16_t*)(P->ws + WS_KMEM) + (size_t)(u.pm >> 4) * 256 * DM + u.pn * 512;
        return true;
    }
};
struct EpiSc {
    const Params* Pp;
    DI void operator()(Acc& acc, const Unit& u, int wr, int wc, int fr, int fq) const {
        const Params& P = *Pp; float* sc = WSP(float, WS_SC) + (size_t)u.aux * 65536;
        ACC_FOREACH(ai, bj, m, n) *(f32x4*)(sc + (size_t)ACC_ROW(ai, m) * 256 + ACC_COL(bj, n)) = acc[ai][bj][m][n];
    }
};
DI void p10_softmax(const Params& P, int bid, int nb) {
    const int lane = threadIdx.x & 63, gw = bid * 8 + (threadIdx.x >> 6), ngw = nb * 8;
    for (int r = gw; r < 65536; r += ngw) {
        const f32x4 v = *(const f32x4*)(WSP(float, WS_SC) + (size_t)r * 256 + lane * 4);
        float mx = fmaxf(fmaxf(v.x, v.y), fmaxf(v.z, v.w));
#pragma unroll
        for (int o = 1; o < 64; o <<= 1) mx = fmaxf(mx, __shfl_xor(mx, o));
        f32x4 e; e.x = __expf(v.x - mx); e.y = __expf(v.y - mx); e.z = __expf(v.z - mx); e.w = __expf(v.w - mx);
        const float inv = frcp(wave_sum(e.x + e.y + e.z + e.w));
        st_bf4(WSP(bf16_t, WS_P) + (size_t)r * 256 + lane * 4, e * inv);
    }
}
struct SchedPV {
    const Params* P; int bid, nb;
    DI bool next(int i, Unit& u) const {
        const int L = i * nb + bid; if (L >= 512) return false;
        const int su = L >> 1, nt = L & 1; u.pm = su >> 2; u.pn = (su & 3) * 2 + nt; u.kind = 0; u.keep = false; u.aux = 0; u.lda = 256; u.ldb = 256;
        u.A = (const bf16_t*)(P->ws + WS_P) + (size_t)su * 65536;
        u.B = (const bf16_t*)(P->ws + WS_VTMEM) + (size_t)(u.pm >> 4) * DM * 256 + (size_t)u.pn * 256 * 256;
        return true;
    }
};
struct EpiPV {
    const Params* Pp;
    DI void operator()(Acc& acc, const Unit& u, int wr, int wc, int fr, int fq) const {
        const Params& P = *Pp; bf16_t* o = WSP(bf16_t, WS_ATTO);
        ACC_FOREACH(ai, bj, m, n) st_bf4(o + (size_t)(u.pm * 256 + ACC_ROW(ai, m)) * DM + u.pn * 256 + ACC_COL(bj, n), acc[ai][bj][m][n]);
    }
};

struct SchedFold {
    const Params* P; int bid, nb;
    DI bool next(int i, Unit& u) const {
        const int L = i * nb + bid; if (L >= 256) return false;
        u.keep = false; u.lda = DM; u.ldb = DM; u.aux = 0;
        if (L < 128) { const int b = L >> 5, h = (L >> 3) & 3, kt = L & 7; u.kind = 0; u.pm = b * 4 + h; u.pn = kt;
            u.A = (const bf16_t*)(P->ws + WS_KMEM) + (size_t)(b * 256) * DM + h * 512; u.B = (const bf16_t*)(P->ws + WS_WXQ) + (size_t)(kt * 256) * DM + h * 512; }
        else { const int l = L - 128, b = l >> 5, dt = (l >> 2) & 7, h = l & 3; u.kind = 1; u.pm = b * 8 + dt; u.pn = h;
            u.A = (const bf16_t*)(P->ws + WS_WXO) + (size_t)(dt * 256) * DM + h * 512; u.B = (const bf16_t*)(P->ws + WS_VTMEM) + (size_t)(b * 256) * DM + h * 512; }
        return true;
    }
};
struct EpiFold {
    const Params* Pp;
    DI void operator()(Acc& acc, const Unit& u, int wr, int wc, int fr, int fq) const {
        const Params& P = *Pp;
        if (u.kind == 0) { unsigned char* d = WSP(unsigned char, WS_WKT) + (size_t)u.pm * 256 * DM + u.pn * 256;
            ACC_FOREACH3(ai, bj, m) st_f8x8(d + (size_t)ACC_ROW(ai, m) * DM + ACC_COLW(bj), acc[ai][bj][m][0], acc[ai][bj][m][1]); }
        else { unsigned char* d = WSP(unsigned char, WS_VWT) + (size_t)u.pm * 256 * 1024 + u.pn * 256;
            ACC_FOREACH3(ai, bj, m) st_f8x8(d + (size_t)ACC_ROW(ai, m) * 1024 + ACC_COLW(bj), acc[ai][bj][m][0], acc[ai][bj][m][1]); }
    }
};
struct SchedSc2 {
    const Params* P; int bid, nb;
    DI bool next(int i, Unit& u) const {
        const int L = i * nb + bid; if (L >= 256) return false;
        u.pm = L >> 2; u.pn = L & 3; u.kind = 0; u.keep = false; u.aux = L; u.lda = DM; u.ldb = DM;
        u.A = (const bf16_t*)(P->ws + WS_XN) + (size_t)u.pm * 256 * DM;
        u.B = (const bf16_t*)(P->ws + WS_WKT) + (size_t)((u.pm >> 4) * 4 + u.pn) * 256 * DM;
        return true;
    }
};
struct EpiSc2 {
    const Params* Pp;
    DI void operator()(Acc& acc, const Unit& u, int wr, int wc, int fr, int fq) const {
        const Params& P = *Pp; float* sc = WSP(float, WS_SC) + (size_t)u.aux * 65536; const float* ss = WSP(float, WS_SS1);
#pragma unroll
        for (int ai = 0; ai < 2; ++ai)
#pragma unroll
            for (int m = 0; m < 4; ++m) {
                const int r = ACC_ROW(ai, m); const float s = row_rstd(ss, u.pm * 256 + r) * 0.04419417382415922f;
#pragma unroll
                for (int bj = 0; bj < 2; ++bj)
#pragma unroll
                    for (int n = 0; n < 2; ++n) *(f32x4*)(sc + (size_t)r * 256 + ACC_COL(bj, n)) = acc[ai][bj][m][n] * s;
            }
    }
};
struct SchedSc1u { const Params* P; int su;
    DI bool next(int i, Unit& u) const {
        if (i > 0) return false;
        u.pm = su >> 2; u.pn = su & 3; u.kind = 0; u.keep = false; u.aux = su; u.lda = DM; u.ldb = DM;
        u.A = (const bf16_t*)(P->ws + WS_XN + (size_t)u.pm * 256 * DM);
        u.B = (const bf16_t*)(P->ws + WS_WKT + (size_t)((u.pm >> 4) * 4 + u.pn) * 256 * DM);
        return true; } };
struct EpiScSoftmax {
    const Params* Pp;
    DI void operator()(Acc&, const Unit&, int, int, int, int) const {}
    DI void fused(Acc& acc, const Unit& u, int wr, int wc, int fr, int fq, LAS unsigned char* lds) const {
        const Params& P = *Pp; const float* ss = WSP(float, WS_SS1);
        LAS float* X = (LAS float*)lds;
        LAS float* R = (LAS float*)(lds + 4096);
        { const int t = threadIdx.x; const float* p = ss + (size_t)(u.pm * 256 + (t >> 1)) * 32 + (t & 1) * 16;
          const f32x4 a = *(const f32x4*)p, b = *(const f32x4*)(p + 4), c = *(const f32x4*)(p + 8), d = *(const f32x4*)(p + 12);
          float s = ((a.x + a.y) + (a.z + a.w)) + ((b.x + b.y) + (b.z + b.w)) + ((c.x + c.y) + (c.z + c.w)) + ((d.x + d.y) + (d.z + d.w));
          s += __shfl_xor(s, 1);
          if (!(t & 1)) R[t >> 1] = rsqrtf(s * (1.f / DM) + EPS) * 0.04419417382415922f; }
        asm volatile("s_waitcnt lgkmcnt(0)" ::: "memory"); __builtin_amdgcn_s_barrier(); asm volatile("" ::: "memory");
        float rmax[2][4];
#pragma unroll
        for (int ai = 0; ai < 2; ++ai)
#pragma unroll
            for (int m = 0; m < 4; ++m) {
                const int r = ACC_ROW(ai, m); const float s = R[r];
                float mx = -INFINITY;
#pragma unroll
                for (int bj = 0; bj < 2; ++bj)
#pragma unroll
                    for (int n = 0; n < 2; ++n) { f32x4& v = acc[ai][bj][m][n]; v = v * s; mx = fmaxf(mx, fmaxf(fmaxf(v.x, v.y), fmaxf(v.z, v.w))); }
                mx = fmaxf(mx, __shfl_xor(mx, 16)); mx = fmaxf(mx, __shfl_xor(mx, 32));
                if (fq == 0) X[r * 4 + wc] = mx;
                rmax[ai][m] = mx;
            }
        asm volatile("s_waitcnt lgkmcnt(0)" ::: "memory"); __builtin_amdgcn_s_barrier(); asm volatile("" ::: "memory");
        float rsum[2][4];
#pragma unroll
        for (int ai = 0; ai < 2; ++ai)
#pragma unroll
            for (int m = 0; m < 4; ++m) {
                const int r = ACC_ROW(ai, m); const f32x4 q = *(const LAS f32x4*)(X + r * 4); const float mx = fmaxf(fmaxf(q.x, q.y), fmaxf(q.z, q.w));
                float sm = 0.f;
#pragma unroll
                for (int bj = 0; bj < 2; ++bj)
#pragma unroll
                    for (int n = 0; n < 2; ++n) { f32x4& v = acc[ai][bj][m][n]; v.x = __expf(v.x - mx); v.y = __expf(v.y - mx); v.z = __expf(v.z - mx); v.w = __expf(v.w - mx); sm += (v.x + v.y) + (v.z + v.w); }
                sm += __shfl_xor(sm, 16); sm += __shfl_xor(sm, 32);
                rsum[ai][m] = sm;
            }
        asm volatile("s_waitcnt lgkmcnt(0)" ::: "memory"); __builtin_amdgcn_s_barrier(); asm volatile("" ::: "memory");
#pragma unroll
        for (int ai = 0; ai < 2; ++ai)
#pragma unroll
            for (int m = 0; m < 4; ++m) if (fq == 0) X[ACC_ROW(ai, m) * 4 + wc] = rsum[ai][m];
        asm volatile("s_waitcnt lgkmcnt(0)" ::: "memory"); __builtin_amdgcn_s_barrier(); asm volatile("" ::: "memory");
        unsigned char* pc = WSP(unsigned char, WS_P) + (size_t)(u.pm * 256) * 1024 + u.pn * 256;
#pragma unroll
        for (int ai = 0; ai < 2; ++ai)
#pragma unroll
            for (int m = 0; m < 4; ++m) {
                const int r = ACC_ROW(ai, m); const f32x4 q = *(const LAS f32x4*)(X + r * 4); const float inv = 256.f * frcp((q.x + q.y) + (q.z + q.w));
#pragma unroll
                for (int bj = 0; bj < 2; ++bj)
                    st_f8x8(pc + (size_t)r * 1024 + ACC_COLW(bj), acc[ai][bj][m][0] * inv, acc[ai][bj][m][1] * inv);
            }
        asm volatile("s_waitcnt lgkmcnt(0)" ::: "memory"); __builtin_amdgcn_s_barrier(); asm volatile("" ::: "memory");
    }
};
DI void p10_softmax_cat(const Params& P, int bid, int nb) {
    const int lane = threadIdx.x & 63, gw = bid * 8 + (threadIdx.x >> 6), ngw = nb * 8;
    for (int r = gw; r < 65536; r += ngw) {
        const int su = r >> 8, rr = r & 255, pm = su >> 2, h = su & 3;
        const f32x4 v = *(const f32x4*)(WSP(float, WS_SC) + (size_t)r * 256 + lane * 4);
        float mx = fmaxf(fmaxf(v.x, v.y), fmaxf(v.z, v.w));
#pragma unroll
        for (int o = 1; o < 64; o <<= 1) mx = fmaxf(mx, __shfl_xor(mx, o));
        f32x4 e; e.x = __expf(v.x - mx); e.y = __expf(v.y - mx); e.z = __expf(v.z - mx); e.w = __expf(v.w - mx);
        const float inv = frcp(wave_sum(e.x + e.y + e.z + e.w));
        st_bf4(WSP(bf16_t, WS_P) + (size_t)(pm * 256 + rr) * 1024 + h * 256 + lane * 4, e * inv);
    }
}
struct SchedMix {
    const Params* P; int bid, nb;
    DI bool next(int i, Unit& u) const {
        const int L = i * nb + bid; if (L >= 512) return false;
        u.pm = L >> 3; u.pn = L & 7; u.kind = 0; u.keep = false; u.aux = 0; u.lda = P8; u.ldb = P8;
        u.A = (const bf16_t*)(P->ws + WS_MERGED + (size_t)u.pm * 256 * P8); u.B = (const bf16_t*)(P->ws + WS_WMIX + (size_t)u.pn * 256 * P8);
        return true;
    }
};
struct SchedO {
    const Params* P; int bid, nb;
    DI bool next(int i, Unit& u) const {
        const int L = i * nb + bid; if (L >= 512) return false;
        u.pm = L >> 3; u.pn = L & 7; u.kind = 0; u.keep = false; u.aux = 0; u.lda = 1024; u.ldb = 1024;
        u.A = (const bf16_t*)(P->ws + WS_P + (size_t)u.pm * 256 * 1024);
        u.B = (const bf16_t*)(P->ws + WS_VWT + ((size_t)(u.pm >> 4) * DM + (size_t)u.pn * 256) * 1024);
        return true;
    }
};

struct SchedRt {
    const Params* P; int bid, nb;
    DI bool next(int i, Unit& u) const {
        const int L = i * nb + bid; if (L >= 256) return false;
        u.pm = L >> 2; u.pn = 0; u.kind = 0; u.keep = false; u.aux = L & 3; u.lda = DM; u.ldb = DM;
        u.A = (const bf16_t*)(P->ws + WS_XN) + (size_t)u.pm * 256 * DM + u.aux * 512; u.B = (const bf16_t*)(P->ws + WS_WR) + u.aux * 512;
        return true;
    }
};
struct EpiRt {
    const Params* Pp;
    DI void operator()(Acc& acc, const Unit& u, int wr, int wc, int fr, int fq) const {
        const Params& P = *Pp; float* lg = WSP(float, WS_SC) + (size_t)u.aux * MTOK * 64; const float* ss = WSP(float, WS_SS2);
#pragma unroll
        for (int ai = 0; ai < 2; ++ai)
#pragma unroll
            for (int m = 0; m < 4; ++m) {
                const int row = u.pm * 256 + ACC_ROW(ai, m); const float rs = row_rstd(ss, row);
#pragma unroll
                for (int n = 0; n < 2; ++n) { const int c = ACC_COL(0, n); if (c < 64) *(f32x4*)(lg + (size_t)row * 64 + c) = acc[ai][0][m][n] * rs; }
            }
    }
};
DI void p13_route_fused(const Params& P, float* lds, int bid, int nb) {
    const int tid = threadIdx.x, lane = tid & 63, wave = tid >> 6, c16 = lane & 15, kg = lane >> 4;
    float* part = lds; float* lg = lds + 8 * 64 * 48;
    unsigned* lcnt = (unsigned*)(lds + 8 * 64 * 48 + 64 * 48); unsigned* lbase = lcnt + 32; float* rsl = (float*)(lbase + 32);
    unsigned* cnt = WSP(unsigned, WS_CTL) + CW_CNT;
    int* toke = WSP(int, WS_ROUTE) + RT_TOKE; int* toki = WSP(int, WS_ROUTE) + RT_TOKI; float* tokw = WSP(float, WS_ROUTE) + RT_TOKW;
    for (int ib = bid; ib < MTOK / 64; ib += nb) {
        const size_t m0 = (size_t)ib * 64;
        __syncthreads();
        if (tid < 32) lcnt[tid] = 0u;
        if (tid < 128) {
            const float* p = WSP(float, WS_SS2) + (m0 + (tid >> 1)) * 32 + (tid & 1) * 16;
            const f32x4 a = *(const f32x4*)p, b = *(const f32x4*)(p + 4), c = *(const f32x4*)(p + 8), d = *(const f32x4*)(p + 12);
            float s = ((a.x + a.y) + (a.z + a.w)) + ((b.x + b.y) + (b.z + b.w)) + ((c.x + c.y) + (c.z + c.w)) + ((d.x + d.y) + (d.z + d.w));
            s += __shfl_xor(s, 1);
            if (!(tid & 1)) { const float r = rsqrtf(s * (1.f / DM) + EPS); rsl[tid >> 1] = r; WSP(float, WS_ROUTE)[RT_TOKRS + m0 + (tid >> 1)] = r; } }
        {
            const bf16_t* xa = WSP(bf16_t, WS_H) + (m0 + c16) * DM + wave * 256 + 8 * kg;
            const bf16_t* wb = WSP(bf16_t, WS_WR) + (size_t)c16 * DM + wave * 256 + 8 * kg;
            f32x4 acc[4][3];
#pragma unroll
            for (int mt = 0; mt < 4; ++mt)
#pragma unroll
                for (int nt = 0; nt < 3; ++nt) acc[mt][nt] = (f32x4){0.f, 0.f, 0.f, 0.f};
#pragma unroll
            for (int k2 = 0; k2 < 4; ++k2) {
                bf16x8 fa[2][4], fb[2][3];
#pragma unroll
                for (int q = 0; q < 2; ++q) {
#pragma unroll
                    for (int mt = 0; mt < 4; ++mt) fa[q][mt] = *(const bf16x8*)(xa + (size_t)(16 * mt) * DM + (2 * k2 + q) * 32);
#pragma unroll
                    for (int nt = 0; nt < 3; ++nt) fb[q][nt] = *(const bf16x8*)(wb + (size_t)(16 * nt) * DM + (2 * k2 + q) * 32);
                }
#pragma unroll
                for (int q = 0; q < 2; ++q)
#pragma unroll
                    for (int mt = 0; mt < 4; ++mt)
#pragma unroll
                        for (int nt = 0; nt < 3; ++nt) acc[mt][nt] = __builtin_amdgcn_mfma_f32_16x16x32_bf16(fa[q][mt], fb[q][nt], acc[mt][nt], 0, 0, 0);
            }
#pragma unroll
            for (int mt = 0; mt < 4; ++mt)
#pragma unroll
                for (int nt = 0; nt < 3; ++nt)
#pragma unroll
                    for (int i = 0; i < 4; ++i) part[(wave * 64 + 16 * mt + 4 * kg + i) * 48 + 16 * nt + c16] = acc[mt][nt][i];
        }
        __syncthreads();
        for (int i = tid; i < 64 * 48; i += NTHR) { float s = 0.f;
#pragma unroll
            for (int w8 = 0; w8 < 8; ++w8) s += part[w8 * 3072 + i];
            lg[i] = s * rsl[i / 48]; }
        __syncthreads();
        int re0 = 0, re1 = 0; unsigned rk0 = 0u, rk1 = 0u;
        if (tid < 64) {
            const int t = (int)m0 + tid; const float* l = lg + tid * 48;
            float gl[4]; int gs = 0; float gm = -INFINITY;
#pragma unroll
            for (int g = 0; g < 4; ++g) { gl[g] = l[32 + g] + P.in[I_BGRP][g]; if (gl[g] > gm) { gm = gl[g]; gs = g; } }
            float gsum = 0.f;
#pragma unroll
            for (int g = 0; g < 4; ++g) gsum += __expf(gl[g] - gm);
            const float pg = 1.f / gsum;
            float el[8]; float em = -INFINITY;
#pragma unroll
            for (int e = 0; e < 8; ++e) { el[e] = l[gs * 8 + e] + P.in[I_BRT][gs * 8 + e]; em = fmaxf(em, el[e]); }
            int i0 = 0; float p0 = -1.f; float ep[8];
#pragma unroll
            for (int e = 0; e < 8; ++e) ep[e] = __expf(el[e] - em);
#pragma unroll
            for (int e = 0; e < 8; ++e) if (ep[e] > p0) { p0 = ep[e]; i0 = e; }
            int i1 = 0; float p1 = -1.f;
#pragma unroll
            for (int e = 0; e < 8; ++e) if (e != i0 && ep[e] > p1) { p1 = ep[e]; i1 = e; }
            const float w0 = pg * p0 / (p0 + p1), w1 = pg * p1 / (p0 + p1);
            const int e0 = gs * 8 + i0, e1 = gs * 8 + i1;
            toke[t * 2] = e0; toke[t * 2 + 1] = e1; tokw[t * 2] = w0; tokw[t * 2 + 1] = w1;
            re0 = e0; re1 = e1; rk0 = atomicAdd(&lcnt[e0], 1u); rk1 = atomicAdd(&lcnt[e1], 1u);
        }
        __syncthreads();
        if (tid < 32) { const unsigned n = lcnt[tid]; lbase[tid] = n ? atomicAdd(&cnt[tid * 32], n) : 0u; }
        __syncthreads();
        if (tid < 64) { const int t = (int)m0 + tid; toki[t * 2] = (int)(lbase[re0] + rk0); toki[t * 2 + 1] = (int)(lbase[re1] + rk1); }
    }
}
DI void p14_route(const Params& P, int bid, int nb) {
    const int gt = bid * NTHR + threadIdx.x, ngt = nb * NTHR;
    unsigned* cnt = WSP(unsigned, WS_CTL) + CW_CNT;
    int* toke = WSP(int, WS_ROUTE) + RT_TOKE; int* toki = WSP(int, WS_ROUTE) + RT_TOKI; float* tokw = WSP(float, WS_ROUTE) + RT_TOKW;
    for (int t = gt; t < MTOK; t += ngt) {
        const float* lg = WSP(float, WS_SC) + (size_t)t * 64; constexpr size_t LP = (size_t)MTOK * 64;
        float gl[4]; int gs = 0; float gm = -INFINITY;
        { const f32x4 g0 = *(const f32x4*)(lg + 32), g1 = *(const f32x4*)(lg + LP + 32), g2 = *(const f32x4*)(lg + 2 * LP + 32), g3 = *(const f32x4*)(lg + 3 * LP + 32);
          const f32x4 gsum4 = (g0 + g1) + (g2 + g3); gl[0] = gsum4.x; gl[1] = gsum4.y; gl[2] = gsum4.z; gl[3] = gsum4.w; }
#pragma unroll
        for (int g = 0; g < 4; ++g) { gl[g] += P.in[I_BGRP][g]; if (gl[g] > gm) { gm = gl[g]; gs = g; } }
        float gsum = 0.f;
#pragma unroll
        for (int g = 0; g < 4; ++g) gsum += __expf(gl[g] - gm);
        const float pg = 1.f / gsum;
        float el[8]; float em = -INFINITY;
#pragma unroll
        for (int e = 0; e < 8; ++e) { const float* q = lg + gs * 8 + e; el[e] = ((q[0] + q[LP]) + (q[2 * LP] + q[3 * LP])) + P.in[I_BRT][gs * 8 + e]; em = fmaxf(em, el[e]); }
        int i0 = 0; float p0 = -1.f, esum = 0.f; float ep[8];
#pragma unroll
        for (int e = 0; e < 8; ++e) { ep[e] = __expf(el[e] - em); esum += ep[e]; }
#pragma unroll
        for (int e = 0; e < 8; ++e) if (ep[e] > p0) { p0 = ep[e]; i0 = e; }
        int i1 = 0; float p1 = -1.f;
#pragma unroll
        for (int e = 0; e < 8; ++e) if (e != i0 && ep[e] > p1) { p1 = ep[e]; i1 = e; }
        const float w0 = pg * p0 / (p0 + p1), w1 = pg * p1 / (p0 + p1);
        const int e0 = gs * 8 + i0, e1 = gs * 8 + i1;
        toke[t * 2] = e0; toke[t * 2 + 1] = e1; tokw[t * 2] = w0; tokw[t * 2 + 1] = w1;
        toki[t * 2] = (int)atomicAdd(&cnt[e0 * 32], 1u); toki[t * 2 + 1] = (int)atomicAdd(&cnt[e1 * 32], 1u);
    }
}
DI LAS int* tstab(float* lds) { return (LAS int*)((LAS unsigned char*)lds + 131072); }
DI void fill_tstab(const Params& P, float* lds) {
    if (threadIdx.x < 64) { const int lane = threadIdx.x; const unsigned* cnt = WSP(unsigned, WS_CTL) + CW_CNT;
        int v = lane < 32 ? (((int)cnt[lane * 32] + 255) >> 8) : 0;
#pragma unroll
        for (int o = 1; o < 64; o <<= 1) { const int t = __shfl_up(v, o); if (lane >= o) v += t; }
        if (lane < 32) tstab(lds)[lane + 1] = v; if (lane == 0) tstab(lds)[0] = 0; }
    __syncthreads();
}
DI void p15_gather(const Params& P, float* lds, int bid, int nb) {
    fill_tstab(P, lds); const LAS int* ts = tstab(lds);
    const int lane = threadIdx.x & 63, gw = bid * 8 + (threadIdx.x >> 6), ngw = nb * 8;
    const unsigned* cnt = WSP(unsigned, WS_CTL) + CW_CNT;
    const int* toke = WSP(int, WS_ROUTE) + RT_TOKE; const int* toki = WSP(int, WS_ROUTE) + RT_TOKI; const float* tokw = WSP(float, WS_ROUTE) + RT_TOKW;
    float* rowrs = WSP(float, WS_ROUTE) + RT_ROWRS; float* roww = WSP(float, WS_ROUTE) + RT_ROWW;
    for (int a = gw; a < MTOK * 2; a += ngw) {
        const int t = a >> 1, e = toke[a];
        const int row = ts[e] * 256 + toki[a];
        const u32x4* src = (const u32x4*)(WSP(bf16_t, WS_H) + (size_t)t * DM); u32x2* dst = (u32x2*)(WSP(unsigned char, WS_XROWS) + (size_t)row * DM);
        u32x4 v[4];
#pragma unroll
        for (int j = 0; j < 4; ++j) v[j] = src[lane + 64 * j];
#pragma unroll
        for (int j = 0; j < 4; ++j) { u32x2 o;
            o.x = pk4_f8(__uint_as_float(v[j].x << 16), __uint_as_float(v[j].x & 0xffff0000u), __uint_as_float(v[j].y << 16), __uint_as_float(v[j].y & 0xffff0000u));
            o.y = pk4_f8(__uint_as_float(v[j].z << 16), __uint_as_float(v[j].z & 0xffff0000u), __uint_as_float(v[j].w << 16), __uint_as_float(v[j].w & 0xffff0000u));
            dst[lane + 64 * j] = o; }
        if (lane == 0) { rowrs[row] = WSP(float, WS_ROUTE)[RT_TOKRS + t]; roww[row] = tokw[a]; }
    }
}
struct SchedExp {
    const Params* P; int bid, nb; int down; const LAS int* ts;
    DI bool next(int i, Unit& u) const {
        const int npn = down ? 8 : 4; const int L = i * nb + bid; const int T = L / npn; u.pn = L % npn;
        if (T >= ts[32]) return false;
        int e = 0;
#pragma unroll
        for (int s = 16; s > 0; s >>= 1) if (ts[e + s] <= T) e += s;
        while (ts[e + 1] <= T) ++e;
        u.pm = T; u.kind = 0; u.keep = false; u.aux = e;
        if (!down) { u.lda = DM; u.ldb = DM; u.A = (const bf16_t*)(P->ws + WS_XROWS + (size_t)T * 256 * DM); u.B = (const bf16_t*)(P->ws + WS_WGU + ((size_t)e * 1024 + u.pn * 256) * DM); }
        else { u.lda = DEXP; u.ldb = DEXP; u.A = (const bf16_t*)(P->ws + WS_HID + (size_t)T * 256 * DEXP); u.B = (const bf16_t*)(P->ws + WS_WD + ((size_t)e * DM + u.pn * 256) * DEXP); }
        return true;
    }
};
struct EpiGU {
    const Params* Pp;
    DI void operator()(Acc& acc, const Unit& u, int wr, int wc, int fr, int fq) const {
        const Params& P = *Pp; bf16_t* hid = WSP(bf16_t, WS_HID); const float* rowrs = WSP(float, WS_ROUTE) + RT_ROWRS;
#pragma unroll
        for (int ai = 0; ai < 2; ++ai)
#pragma unroll
            for (int m = 0; m < 4; ++m) {
                const int row = u.pm * 256 + ACC_ROW(ai, m); const float rs = rowrs[row];
                f32x4 o[2];
#pragma unroll
                for (int n = 0; n < 2; ++n) {
                    const f32x4 g = acc[ai][0][m][n] * (rs * (1.f / 64.f)), up = acc[ai][1][m][n] * (rs * (1.f / 64.f));
                    o[n].x = siluf_(g.x) * up.x; o[n].y = siluf_(g.y) * up.y; o[n].z = siluf_(g.z) * up.z; o[n].w = siluf_(g.w) * up.w;
                }
                st_f8x8((unsigned char*)hid + (size_t)row * DEXP + u.pn * 128 + ACC_COLW(0), o[0], o[1]);
            }
    }
};
struct EpiDown {
    const Params* Pp;
    DI void operator()(Acc& acc, const Unit& u, int wr, int wc, int fr, int fq) const {
        const Params& P = *Pp; bf16_t* y = WSP(bf16_t, WS_YROWS); const float* roww = WSP(float, WS_ROUTE) + RT_ROWW;
#pragma unroll
        for (int ai = 0; ai < 2; ++ai)
#pragma unroll
            for (int m = 0; m < 4; ++m) {
                const int row = u.pm * 256 + ACC_ROW(ai, m); const float w = roww[row] * (1.f / 32.f);
#pragma unroll
                for (int bj = 0; bj < 2; ++bj)
                    st_bf8(y + (size_t)row * DM + u.pn * 256 + ACC_COLW(bj), acc[ai][bj][m][0] * w, acc[ai][bj][m][1] * w);
            }
    }
};
DI void p18_final(const Params& P, float* lds, int bid, int nb) {
    fill_tstab(P, lds); const LAS int* ts = tstab(lds);
    const int lane = threadIdx.x & 63, gw = bid * 8 + (threadIdx.x >> 6), ngw = nb * 8;
    const unsigned* cnt = WSP(unsigned, WS_CTL) + CW_CNT;
    const int* toke = WSP(int, WS_ROUTE) + RT_TOKE; const int* toki = WSP(int, WS_ROUTE) + RT_TOKI;
    f32x4 g[4][2];
#pragma unroll
    for (int j = 0; j < 4; ++j) { g[j][0] = *(const f32x4*)(P.in[I_NFIN] + 512 * j + 8 * lane); g[j][1] = *(const f32x4*)(P.in[I_NFIN] + 512 * j + 8 * lane + 4); }
    for (int t = gw; t < MTOK; t += ngw) {
        const int r0 = ts[toke[2 * t]] * 256 + toki[2 * t], r1 = ts[toke[2 * t + 1]] * 256 + toki[2 * t + 1];
        const bf16_t* y0 = WSP(bf16_t, WS_YROWS) + (size_t)r0 * DM; const bf16_t* y1 = WSP(bf16_t, WS_YROWS) + (size_t)r1 * DM;
        float* o = P.out + (size_t)t * DM; const bf16_t* hb = WSP(bf16_t, WS_H) + (size_t)t * DM;
        f32x4 v[4][2]; float s = 0.f;
#pragma unroll
        for (int j = 0; j < 4; ++j) { const int c = 512 * j + 8 * lane; const u32x4 a = *(const u32x4*)(y0 + c), b = *(const u32x4*)(y1 + c), hh = *(const u32x4*)(hb + c);
            f32x4 h0, h1;
            h0.x = bf2f(hh.x & 0xffff) + bf2f(a.x & 0xffff) + bf2f(b.x & 0xffff); h0.y = bf2f(hh.x >> 16) + bf2f(a.x >> 16) + bf2f(b.x >> 16);
            h0.z = bf2f(hh.y & 0xffff) + bf2f(a.y & 0xffff) + bf2f(b.y & 0xffff); h0.w = bf2f(hh.y >> 16) + bf2f(a.y >> 16) + bf2f(b.y >> 16);
            h1.x = bf2f(hh.z & 0xffff) + bf2f(a.z & 0xffff) + bf2f(b.z & 0xffff); h1.y = bf2f(hh.z >> 16) + bf2f(a.z >> 16) + bf2f(b.z >> 16);
            h1.z = bf2f(hh.w & 0xffff) + bf2f(a.w & 0xffff) + bf2f(b.w & 0xffff); h1.w = bf2f(hh.w >> 16) + bf2f(a.w >> 16) + bf2f(b.w >> 16);
            v[j][0] = h0; v[j][1] = h1; s += h0.x * h0.x + h0.y * h0.y + h0.z * h0.z + h0.w * h0.w + h1.x * h1.x + h1.y * h1.y + h1.z * h1.z + h1.w * h1.w; }
        const float rstd = rsqrtf(wave_sum(s) * (1.f / DM) + EPS);
#pragma unroll
        for (int j = 0; j < 4; ++j) { const int c = 512 * j + 8 * lane; *(f32x4*)(o + c) = v[j][0] * rstd * g[j][0]; *(f32x4*)(o + c + 4) = v[j][1] * rstd * g[j][1]; }
    }
}

constexpr int N_PHASES = 19;
#define XB_TMO      128
#define XB_XCNT(j)  (256  + 64 * (j))
#define XB_XSUB(j)  (1280 + 64 * (j))
#define XB_XGEN(j)  (2304 + 64 * (j))
#define XB_TOP      3328
#define XB_TOPGEN   3392
#define XB_SPIN_CAP (1u << 18)
constexpr int CW_BAR = 4096;
DI unsigned xb_ld(unsigned* p)              { return __hip_atomic_load(p, __ATOMIC_RELAXED, __HIP_MEMORY_SCOPE_AGENT); }
DI unsigned xb_add(unsigned* p, unsigned v) { return __hip_atomic_fetch_add(p, v, __ATOMIC_RELAXED, __HIP_MEMORY_SCOPE_AGENT); }
DI unsigned xb_xcc_id() { return (unsigned)__builtin_amdgcn_s_getreg((3 << 11) | 20) & 0xFu; }
#define XB_SPIN(cond, bar) do { unsigned _sp = 0; while (cond) { __builtin_amdgcn_s_sleep(1); \
    if ((++_sp & 255u) == 0u) { if (xb_ld(&(bar)[XB_TMO])) break; if (_sp > XB_SPIN_CAP) { atomicAdd(&(bar)[XB_TMO], 1u); break; } } } } while (0)
struct XcdBarrier { unsigned* bar; unsigned x; volatile LAS unsigned* st; };
DI XcdBarrier xcd_barrier_post(unsigned* bar, volatile LAS unsigned* st) {
    XcdBarrier b; b.bar = bar; b.x = xb_xcc_id(); b.st = st;
    if (threadIdx.x == 0) (void)xb_add(&bar[XB_XCNT(b.x)], 1u);
    return b;
}
DI void xcd_barrier_complete(unsigned* bar, unsigned x, unsigned& nloc, unsigned& nx) {
    const unsigned G = gridDim.x * gridDim.y * gridDim.z;
    unsigned sum, cnt, mine, sp = 0u;
    for (;;) {
        sum = 0u; cnt = 0u; mine = 0u;
#pragma unroll
        for (unsigned j = 0; j < 16; ++j) { const unsigned c = xb_ld(&bar[XB_XCNT(j)]); sum += c; cnt += (c > 0u) ? 1u : 0u; mine = (j == x) ? c : mine; }
        if (sum == G) break;
        __builtin_amdgcn_s_sleep(1);
        if ((++sp & 255u) == 0u) { if (xb_ld(&bar[XB_TMO])) break; if (sp > XB_SPIN_CAP) { atomicAdd(&bar[XB_TMO], 1u); break; } }
    }
    nloc = mine > 0u ? mine : 1u; nx = cnt > 0u ? cnt : 1u;
}
DI void xcd_barrier(const XcdBarrier& b) {
    asm volatile("s_waitcnt vmcnt(0)" ::: "memory");
    __syncthreads();
    if (threadIdx.x == 0) {
        unsigned* bar = b.bar;
        __builtin_amdgcn_s_waitcnt(0);
        unsigned nloc = b.st[0], nx = b.st[1];
        if (nloc == 0u) { xcd_barrier_complete(bar, b.x, nloc, nx); b.st[0] = nloc; b.st[1] = nx; }
        const unsigned old = xb_add(&bar[XB_XSUB(b.x)], 1u);
        const unsigned gen = old / nloc;
        if (old + 1u == (gen + 1u) * nloc) {
            __builtin_amdgcn_fence(__ATOMIC_RELEASE, "agent");
            asm volatile("s_waitcnt vmcnt(0)" ::: "memory");
            const unsigned og = xb_add(&bar[XB_TOP], 1u);
            const unsigned tg = og / nx;
            if (og + 1u == (tg + 1u) * nx) xb_add(&bar[XB_TOPGEN], 1u);
            else XB_SPIN(xb_ld(&bar[XB_TOPGEN]) == tg, bar);
            __builtin_amdgcn_fence(__ATOMIC_ACQUIRE, "agent");
            xb_add(&bar[XB_XGEN(b.x)], 1u);
            asm volatile("s_waitcnt vmcnt(0)" ::: "memory");
        } else {
            XB_SPIN(xb_ld(&bar[XB_XGEN(b.x)]) == gen, bar);
            __builtin_amdgcn_fence(__ATOMIC_ACQUIRE, "agent");
            asm volatile("s_waitcnt vmcnt(0)" ::: "memory");
        }
    }
    __syncthreads();
}
#ifndef DUP_PHASE

#define DUP_PHASE -1
#endif
#define PHASE(k, ...) if (ph_lo <= (k) && (k) < ph_hi) { if ((k) > ph_lo) { xcd_barrier(xbar); } \
    { __VA_ARGS__ } __syncthreads(); if (DUP_PHASE == (k)) { xcd_barrier(xbar); { __VA_ARGS__ } __syncthreads(); } }
__global__ void __launch_bounds__(NTHR, 2) mega(Params P, int ph_lo, int ph_hi) {
    extern __shared__ __attribute__((aligned(16))) float lds[];
    const int bid = blockIdx.x, nb = gridDim.x;
    volatile LAS unsigned* xst = (volatile LAS unsigned*)((LAS unsigned char*)lds + 131072 + 512);
    if (threadIdx.x < 4) xst[threadIdx.x] = 0u;
    __syncthreads();
    const XcdBarrier xbar = xcd_barrier_post(WSP(unsigned, WS_CTL) + CW_BAR, xst);
    PHASE(0, p0_prologue(P, lds, bid, nb, 0);)
    PHASE(1, { SchedP1 S{&P, bid, nb}; EpiP1 E{&P}; gemm_run(lds, DM, PX, PX, S, E); SchedP1g S2{&P, bid, nb}; pg8::gemm_phase<EpiP1, SchedP1g, false, true>((LAS unsigned char*)lds, DM, P8, P8, S2, E); })
    PHASE(2, p2_prep(P, lds, bid, nb);)
    PHASE(3, { SchedP3 S{&P, bid, nb, 0}; EpiP3<0> E{&P}; gemm_run(lds, 256, 1024, 256, S, E); SchedP3 S2{&P, bid, nb, 1}; EpiP3<1> E2{&P}; gemm_run(lds, 256, 256, 1024, S2, E2); })
    if (ph_lo <= 3 && 3 < ph_hi) { xcd_barrier(xbar); p3b_ml_pre(P, lds, bid, nb); __syncthreads(); }
#ifdef DUP4_SKIP
    { xcd_barrier(xbar); int sk = DUP4_SKIP; asm volatile("" : "+s"(sk)); p4_scans(P, lds, bid, nb, sk); __syncthreads(); }
#endif
    PHASE(4, p4_scans(P, lds, bid, nb);)
    PHASE(5, { SchedFold S{&P, bid, nb}; EpiFold E{&P}; gemm_run(lds, 512, DM, DM, S, E); } __syncthreads(); p5_combine(P, bid, nb);)
    PHASE(6, { SchedP6 S{&P, bid, nb}; EpiP6 E{&P}; gemm_run(lds, 1024, 1024, 1024, S, E); })
    PHASE(7, { SchedMix S{&P, bid, nb}; EpiResT<true> E{&P, P.in[I_X], P.in[I_NXA], WS_SS1, 1.f / 512.f}; pg8::gemm_phase<EpiResT<true>, SchedMix, false, true>((LAS unsigned char*)lds, DM, P8, P8, S, E); })
    PHASE(8, { for (int su = bid; su < 256; su += nb) { SchedSc1u S{&P, su}; EpiScSoftmax E{&P}; pg8::gemm_phase<EpiScSoftmax, SchedSc1u, true, true>((LAS unsigned char*)lds, DM, DM, DM, S, E); } })
    PHASE(12, { SchedO S{&P, bid, nb}; EpiResT<false> E{&P, nullptr, P.in[I_NFFN], WS_SS2, 1.f / 256.f}; pg8::gemm_phase<EpiResT<false>, SchedO, false, true>((LAS unsigned char*)lds, 1024, 1024, 1024, S, E); })
    PHASE(13, p13_route_fused(P, lds, bid, nb);)
    PHASE(15, p15_gather(P, lds, bid, nb);)
    PHASE(16, { fill_tstab(P, lds); const int n_units = tstab(lds)[32] * 4; { SchedExp S{&P, bid, nb, 0, tstab(lds)}; EpiGU E{&P}; pg8::gemm_phase<EpiGU, SchedExp, false, true>((LAS unsigned char*)lds, DM, DM, DM, S, E); }
    })
    PHASE(17, { fill_tstab(P, lds); SchedExp S{&P, bid, nb, 1, tstab(lds)}; EpiDown E{&P}; pg8::gemm_phase<EpiDown, SchedExp, false, true>((LAS unsigned char*)lds, DEXP, DEXP, DEXP, S, E); })
    PHASE(18, p18_final(P, lds, bid, nb);)
}

#ifndef N_LAUNCH_PER_PHASE
#define N_LAUNCH_PER_PHASE 0
#endif
extern "C" void kernel_launch(void* const* d_in, const int* in_sizes, int n_in, void* d_out, int out_size, void* d_ws, size_t ws_size, hipStream_t stream) {
    Params P{};
    for (int i = 0; i < 33; ++i) P.in[i] = (const float*)d_in[i];
    P.out = (float*)d_out; P.ws = (unsigned char*)d_ws;
    constexpr int LDS_BYTES = 131072 + 1024;
    static int grid = 0;
    if (!grid) {
        (void)hipFuncSetAttribute((const void*)mega, hipFuncAttributeMaxDynamicSharedMemorySize, LDS_BYTES);
        int dev = 0, cus = 0, per_cu = 0;
        (void)hipGetDevice(&dev); (void)hipDeviceGetAttribute(&cus, hipDeviceAttributeMultiprocessorCount, dev);
        (void)hipOccupancyMaxActiveBlocksPerMultiprocessor(&per_cu, (const void*)mega, NTHR, LDS_BYTES);
        if (per_cu < 1) per_cu = 1;
        grid = cus;
        if (grid > cus * per_cu) grid = cus * per_cu;
    }
    (void)hipMemsetAsync((char*)d_ws + WS_CTL, 0, 32768, stream);
#if N_LAUNCH_PER_PHASE
    for (int ph = 0; ph < N_PHASES; ++ph) hipLaunchKernelGGL(mega, dim3(grid), dim3(NTHR), LDS_BYTES, stream, P, ph, ph + 1);
#else
    int lo = 0, hi = N_PHASES;
    void* args[] = {&P, &lo, &hi};
    hipError_t e = hipLaunchCooperativeKernel((const void*)mega, dim3(grid), dim3(NTHR), args, LDS_BYTES, stream);
    if (e != hipSuccess) fprintf(stderr, "cooperative launch failed: %s (grid %d)\n", hipGetErrorString(e), grid);
#endif
}
```
